# Optimizing an MI355X kernel written in HIP

```python
import math
import jax
import jax.numpy as jnp
from jax import lax
import numpy as np

D_MODEL = 1024
BATCH = 16
SEQ = 256
DEPTH = 2
DEC_BATCH = 2
DEC_SEQ = 1024
PAST_LEN = 256

GRID_W = 64
N_EVEN = (DEPTH + 1) // 2
N_ODD = DEPTH // 2

ATTN_HEADS = 8
ATTN_KV_HEADS = 2
HEAD_DIM = 64
ROPE_THETA = 10000.0
Q_BLOCK = 128
ATTN_Q_DIM = ATTN_HEADS * HEAD_DIM
ATTN_KV_DIM = ATTN_KV_HEADS * HEAD_DIM

SSD_HEADS = 8
SSD_HEAD_DIM = 64
SSD_D_INNER = SSD_HEADS * SSD_HEAD_DIM
SSD_GROUPS = 2
SSD_STATE = 64
SSD_CONV_K = 5
SSD_CHUNK = 128
SSD_CONV_DIM = SSD_D_INNER + 2 * SSD_GROUPS * SSD_STATE

AB_IN_DIM = ATTN_Q_DIM + 2 * ATTN_KV_DIM + SSD_D_INNER + SSD_CONV_DIM + 2 * SSD_HEADS
AB_SPLITS = (ATTN_Q_DIM, ATTN_Q_DIM + ATTN_KV_DIM, ATTN_Q_DIM + 2 * ATTN_KV_DIM,
             ATTN_Q_DIM + 2 * ATTN_KV_DIM + SSD_D_INNER,
             ATTN_Q_DIM + 2 * ATTN_KV_DIM + SSD_D_INNER + SSD_CONV_DIM)
AB_MIX_DIM = ATTN_Q_DIM + SSD_D_INNER

RWKV_HEAD_DIM = 64
RWKV_HEADS = D_MODEL // RWKV_HEAD_DIM
R_DECAY = 64
R_AAA = 64
R_GATE = 128

FFN_DIM = (((8 * D_MODEL + 2) // 3 + 255) // 256) * 256

RMS_EPS = 1e-6
GN_EPS = 64e-5
L2_EPS = 1e-12
F32 = jnp.float32

kernel_name = 'hybrid_diffusion_gqa_ssd_rwkv7_step'


def rmsnorm(x, g, eps=RMS_EPS):
    xf = x.astype(F32)
    y = xf * lax.rsqrt(jnp.mean(xf * xf, axis=-1, keepdims=True) + eps)
    return (y * g.astype(F32)).astype(x.dtype)


def ada_params(cvec, w, b):
    m = jnp.einsum('...d,de->...e', jax.nn.silu(cvec), w) + b
    return jnp.split(m[..., None, :], 6, axis=-1)


def modulate(h, shift, scale):
    return h * (1 + scale) + shift


def swiglu(h, w_gate, w_up, w_down):
    hid = jax.nn.silu(jnp.einsum('btd,df->btf', h, w_gate)) * jnp.einsum('btd,df->btf', h, w_up)
    return jnp.einsum('btf,fd->btd', hid, w_down)


def grid_rope(n_tokens):
    rows = n_tokens // GRID_W
    row = jnp.repeat(jnp.arange(rows, dtype=F32), GRID_W)
    col = jnp.tile(jnp.arange(GRID_W, dtype=F32), rows)
    n_freq = HEAD_DIM // 4
    inv_freq = ROPE_THETA ** (-jnp.arange(n_freq, dtype=F32) / n_freq)
    ang = jnp.concatenate([row[:, None] * inv_freq, col[:, None] * inv_freq], axis=-1)
    return jnp.cos(ang), jnp.sin(ang)


def apply_rope(x, cos, sin):
    xf = x.astype(F32)
    x1, x2 = jnp.split(xf, 2, axis=-1)
    c = cos[None, :, None, :]
    s = sin[None, :, None, :]
    return jnp.concatenate([x1 * c - x2 * s, x1 * s + x2 * c], axis=-1).astype(x.dtype)


def block_attention(q, k, v):
    b, n, nh, d = q.shape
    kvh = k.shape[2]
    grp = nh // kvh
    nb = n // Q_BLOCK
    qb = jnp.moveaxis(q.reshape(b, nb, Q_BLOCK, kvh, grp, d), 1, 0)
    scale = d ** -0.5

    def one_block(qblk):
        s = jnp.einsum('bqkgd,bskd->bkgqs', qblk, k).astype(F32) * scale
        p = jax.nn.softmax(s, axis=-1).astype(v.dtype)
        return jnp.einsum('bkgqs,bskd->bqkgd', p, v)

    o = lax.map(one_block, qb)
    return jnp.moveaxis(o, 0, 1).reshape(b, n, nh * d)


def centred_dwconv(x, w, b):
    pad = SSD_CONV_K // 2
    n = x.shape[1]
    xp = jnp.pad(x, ((0, 0), (pad, pad), (0, 0)))
    y = b
    for i in range(SSD_CONV_K):
        y = y + xp[:, i:i + n] * w[i]
    return y


def ssd_chunked(x, dt, A, bm, cm, h0):
    b, n, nh, hp = x.shape
    ng, ns = bm.shape[2], bm.shape[3]
    L = SSD_CHUNK
    nc = n // L
    bh = jnp.repeat(bm.astype(F32), nh // ng, axis=2).reshape(b, nc, L, nh, ns)
    ch = jnp.repeat(cm.astype(F32), nh // ng, axis=2).reshape(b, nc, L, nh, ns)
    xdt = (x.astype(F32) * dt[..., None]).reshape(b, nc, L, nh, hp)
    a_cs = jnp.cumsum((dt * A).reshape(b, nc, L, nh), axis=2)
    lower = jnp.tril(jnp.ones((L, L), dtype=bool))[None, None, :, :, None]
    seg = jnp.exp(jnp.where(lower, a_cs[:, :, :, None, :] - a_cs[:, :, None, :, :], -jnp.inf))
    scores = jnp.einsum('bclhn,bcshn->bclsh', ch, bh) * seg
    y_diag = jnp.einsum('bclsh,bcshp->bclhp', scores, xdt)
    decay_end = jnp.exp(a_cs[:, :, -1:, :] - a_cs)
    chunk_states = jnp.einsum('bclhn,bclhp->bchpn', bh * decay_end[..., None], xdt)
    chunk_decay = jnp.exp(a_cs[:, :, -1, :])

    def carry_step(h, inp):
        st, dec = inp
        return h * dec[:, :, None, None] + st, h

    h_final, h_in = lax.scan(carry_step, h0.astype(F32),
                             (jnp.moveaxis(chunk_states, 1, 0), jnp.moveaxis(chunk_decay, 1, 0)))
    h_in = jnp.moveaxis(h_in, 0, 1)
    y_off = jnp.einsum('bclhn,bchpn->bclhp', ch * jnp.exp(a_cs)[..., None], h_in)
    return (y_diag + y_off).reshape(b, n, nh, hp), h_final


def mixer_ab(h, w_in, w_out, q_g, k_g, conv_w, conv_b, dt_bias, a_log, d_skip, ssd_g,
             rope, ctx_k, ctx_v, h0_f, h0_b):
    b, n, _ = h.shape
    proj = jnp.einsum('btd,de->bte', h, w_in)
    q, k, v, z, xbc, dt = jnp.split(proj, AB_SPLITS, axis=-1)
    q = rmsnorm(q.reshape(b, n, ATTN_HEADS, HEAD_DIM), q_g)
    k = rmsnorm(k.reshape(b, n, ATTN_KV_HEADS, HEAD_DIM), k_g)
    v = v.reshape(b, n, ATTN_KV_HEADS, HEAD_DIM)
    if rope is not None:
        q = apply_rope(q, rope[0], rope[1])
        k = apply_rope(k, rope[0], rope[1])
    if ctx_k is None:
        keys, vals = k, v
    else:
        keys = jnp.concatenate([ctx_k.astype(k.dtype), k], axis=1)
        vals = jnp.concatenate([ctx_v.astype(v.dtype), v], axis=1)
    attn = block_attention(q, keys, vals)
    xbc = jax.nn.silu(centred_dwconv(xbc, conv_w, conv_b))
    xs, bm, cm = jnp.split(xbc, [SSD_D_INNER, SSD_D_INNER + SSD_GROUPS * SSD_STATE], axis=-1)
    xs = xs.reshape(b, n, SSD_HEADS, SSD_HEAD_DIM)
    bm = bm.reshape(b, n, SSD_GROUPS, SSD_STATE)
    cm = cm.reshape(b, n, SSD_GROUPS, SSD_STATE)
    dt = jax.nn.softplus(dt.astype(F32).reshape(b, n, 2, SSD_HEADS) + dt_bias.astype(F32))
    A = -jnp.exp(a_log.astype(F32))
    y_f, hf = ssd_chunked(xs, dt[:, :, 0], A[0], bm, cm, h0_f)
    y_b, hb = ssd_chunked(xs[:, ::-1], dt[:, ::-1, 1], A[1], bm[:, ::-1], cm[:, ::-1], h0_b)
    y = y_f + y_b[:, ::-1] + d_skip.astype(F32)[:, None] * xs.astype(F32)
    y = rmsnorm(y.reshape(b, n, SSD_D_INNER) * jax.nn.silu(z.astype(F32)), ssd_g).astype(h.dtype)
    out = jnp.einsum('bte,ed->btd', jnp.concatenate([attn.astype(h.dtype), y], axis=-1), w_out)
    return out, k, v, hf, hb


def centred_shift(x):
    prev = jnp.pad(x, ((0, 0), (1, 0), (0, 0)))[:, :-1]
    nxt = jnp.pad(x, ((0, 0), (0, 1), (0, 0)))[:, 1:]
    return prev - x, nxt - x


def split_heads(t):
    return t.reshape(t.shape[:-1] + (RWKV_HEADS, RWKV_HEAD_DIM))


def rwkv7_scan(r, w, k, v, kk, a, s0):
    def step(S, inp):
        r_t, w_t, k_t, v_t, kk_t, a_t = inp
        sa = jnp.einsum('bhvk,bhk->bhv', S, kk_t)
        S = (S * w_t[:, :, None, :] - sa[..., None] * (kk_t * a_t)[:, :, None, :]
             + v_t[..., None] * k_t[:, :, None, :])
        return S, jnp.einsum('bhvk,bhk->bhv', S, r_t)

    xs = tuple(jnp.moveaxis(t, 1, 0) for t in (r, w, k, v, kk, a))
    s_final, y = lax.scan(step, s0.astype(F32), xs)
    return jnp.moveaxis(y, 0, 1), s_final


def mixer_rwkv(h, mu, w_r, w_k, w_v, w0, w1, w2, a0, a1, a2, g1, g2, k_k, k_a, r_k, ln_g, ln_b, w_o,
               s0_f, s0_b):
    b, n, _ = h.shape
    dp, dn = centred_shift(h)
    xmix = h[:, :, None, :] + dp[:, :, None, :] * mu[0] + dn[:, :, None, :] * mu[1]
    xr, xw, xk, xv, xa, xg = (xmix[:, :, i] for i in range(6))
    r = jnp.einsum('btd,de->bte', xr, w_r).astype(F32)
    k = jnp.einsum('btd,de->bte', xk, w_k).astype(F32)
    v = jnp.einsum('btd,de->bte', xv, w_v).astype(F32)
    wl = w0[:, None, None, :] + jnp.einsum('jbtr,jrd->jbtd', jnp.tanh(jnp.einsum('btd,jdr->jbtr', xw, w1)), w2)
    decay = jnp.exp(-jnp.exp(-jax.nn.softplus(-wl.astype(F32)) - 0.5))
    a = jax.nn.sigmoid((a0[:, None, None, :]
                        + jnp.einsum('jbtr,jrd->jbtd', jnp.einsum('btd,jdr->jbtr', xa, a1), a2)).astype(F32))
    g = jnp.einsum('btr,rd->btd', jax.nn.sigmoid(jnp.einsum('btd,dr->btr', xg, g1)), g2).astype(F32)
    kk = split_heads(k * k_k.astype(F32))
    kk = kk * lax.rsqrt(jnp.sum(kk * kk, axis=-1, keepdims=True) + L2_EPS)
    k_dir = split_heads(k[None] * (1 + (a - 1) * k_a.astype(F32)))
    rh, vh, a_h, w_h = split_heads(r), split_heads(v), split_heads(a), split_heads(decay)
    y_f, s_f = rwkv7_scan(rh, w_h[0], k_dir[0], vh, kk, a_h[0], s0_f)
    y_b, s_b = rwkv7_scan(rh[:, ::-1], w_h[1][:, ::-1], k_dir[1][:, ::-1], vh[:, ::-1], kk[:, ::-1],
                          a_h[1][:, ::-1], s0_b)
    y = y_f + y_b[:, ::-1]
    mean = jnp.mean(y, axis=-1, keepdims=True)
    var = jnp.mean(jnp.square(y - mean), axis=-1, keepdims=True)
    y = ((y - mean) * lax.rsqrt(var + GN_EPS)).reshape(b, n, D_MODEL) * ln_g.astype(F32) + ln_b.astype(F32)
    bonus = jnp.sum(rh[None] * k_dir * r_k.astype(F32), axis=(0, -1))[..., None] * vh
    out = ((y + bonus.reshape(b, n, D_MODEL)) * g).astype(h.dtype)
    return jnp.einsum('btd,de->bte', out, w_o), s_f, s_b


def trunk(x, cvec, rope, ctx, P):
    collected = {'k': [], 'v': [], 'ssd_f': [], 'ssd_b': [], 'rwkv_f': [], 'rwkv_b': []}
    b = x.shape[0]
    for layer in range(DEPTH):
        j = layer // 2
        sh1, sc1, gt1, sh2, sc2, gt2 = ada_params(cvec, P['mod_w'][layer], P['mod_b'][layer])
        h = modulate(rmsnorm(x, P['norm_mix_g'][layer]), sh1, sc1)
        if layer % 2 == 0:
            if ctx is None:
                ck = cv = None
                h0f = h0b = jnp.zeros((b, SSD_HEADS, SSD_HEAD_DIM, SSD_STATE), F32)
            else:
                ck, cv = ctx['k'][:, j], ctx['v'][:, j]
                h0f, h0b = ctx['ssd_f'][:, j], ctx['ssd_b'][:, j]
            out, k, v, hf, hb = mixer_ab(h, P['ab_w_in'][j], P['ab_w_out'][j], P['attn_q_g'][j], P['attn_k_g'][j],
                                         P['ssd_conv_w'][j], P['ssd_conv_b'][j], P['ssd_dt_bias'][j],
                                         P['ssd_a_log'][j], P['ssd_d'][j], P['ssd_norm_g'][j],
                                         rope, ck, cv, h0f, h0b)
            produced = {'k': k, 'v': v, 'ssd_f': hf, 'ssd_b': hb}
        else:
            if ctx is None:
                s0f = s0b = jnp.zeros((b, RWKV_HEADS, RWKV_HEAD_DIM, RWKV_HEAD_DIM), F32)
            else:
                s0f, s0b = ctx['rwkv_f'][:, j], ctx['rwkv_b'][:, j]
            out, sf, sb = mixer_rwkv(h, P['rwkv_mu'][j], P['rwkv_w_r'][j], P['rwkv_w_k'][j], P['rwkv_w_v'][j],
                                     P['rwkv_w0'][j], P['rwkv_w1'][j], P['rwkv_w2'][j],
                                     P['rwkv_a0'][j], P['rwkv_a1'][j], P['rwkv_a2'][j],
                                     P['rwkv_g1'][j], P['rwkv_g2'][j], P['rwkv_k_k'][j], P['rwkv_k_a'][j],
                                     P['rwkv_r_k'][j], P['rwkv_ln_g'][j], P['rwkv_ln_b'][j], P['rwkv_w_o'][j],
                                     s0f, s0b)
            produced = {'rwkv_f': sf, 'rwkv_b': sb}
        if ctx is None:
            for name, t in produced.items():
                collected[name].append(t.astype(x.dtype))
        x = x + gt1 * out
        h = modulate(rmsnorm(x, P['norm_ffn_g'][layer]), sh2, sc2)
        x = x + gt2 * swiglu(h, P['ffn_w_gate'][layer], P['ffn_w_up'][layer], P['ffn_w_down'][layer])
    return rmsnorm(x, P['final_norm_g']), collected


def setup_inputs(seed: int = 0) -> dict:
    key = jax.random.key(seed)
    keys = iter(jax.random.split(key, 64))

    def nrm(shape, scale):
        return jax.random.normal(next(keys), shape, F32) * scale

    def unif(shape, lo, hi):
        return jax.random.uniform(next(keys), shape, F32, lo, hi)

    D = D_MODEL
    dt0 = jnp.exp(unif((N_EVEN, 2, SSD_HEADS), math.log(1e-3), math.log(1e-1)))
    return {
        'x_prompt': nrm((BATCH, SEQ, D), 1.0),
        'x_sample': nrm((DEC_BATCH, DEC_SEQ, D), 1.0),
        'cache_attn_k': nrm((DEC_BATCH, N_EVEN, PAST_LEN, ATTN_KV_HEADS, HEAD_DIM), 1.0),
        'cache_attn_v': nrm((DEC_BATCH, N_EVEN, PAST_LEN, ATTN_KV_HEADS, HEAD_DIM), 1.0),
        'state_ssd_fwd': nrm((DEC_BATCH, N_EVEN, SSD_HEADS, SSD_HEAD_DIM, SSD_STATE), 0.1),
        'state_ssd_bwd': nrm((DEC_BATCH, N_EVEN, SSD_HEADS, SSD_HEAD_DIM, SSD_STATE), 0.1),
        'state_rwkv_fwd': nrm((DEC_BATCH, N_ODD, RWKV_HEADS, RWKV_HEAD_DIM, RWKV_HEAD_DIM), 0.3),
        'state_rwkv_bwd': nrm((DEC_BATCH, N_ODD, RWKV_HEADS, RWKV_HEAD_DIM, RWKV_HEAD_DIM), 0.3),
        'c': nrm((DEC_BATCH, D), 1.0),
        'c_ctx': nrm((D,), 1.0),
        'mod_w': nrm((DEPTH, D, 6 * D), 0.3 * D ** -0.5),
        'mod_b': nrm((DEPTH, 6 * D), 0.02),
        'norm_mix_g': 1.0 + nrm((DEPTH, D), 0.05),
        'norm_ffn_g': 1.0 + nrm((DEPTH, D), 0.05),
        'ffn_w_gate': nrm((DEPTH, D, FFN_DIM), D ** -0.5),
        'ffn_w_up': nrm((DEPTH, D, FFN_DIM), D ** -0.5),
        'ffn_w_down': nrm((DEPTH, FFN_DIM, D), FFN_DIM ** -0.5),
        'ab_w_in': nrm((N_EVEN, D, AB_IN_DIM), D ** -0.5),
        'ab_w_out': nrm((N_EVEN, AB_MIX_DIM, D), AB_MIX_DIM ** -0.5),
        'attn_q_g': 1.0 + nrm((N_EVEN, HEAD_DIM), 0.05),
        'attn_k_g': 1.0 + nrm((N_EVEN, HEAD_DIM), 0.05),
        'ssd_conv_w': nrm((N_EVEN, SSD_CONV_K, SSD_CONV_DIM), SSD_CONV_K ** -0.5),
        'ssd_conv_b': nrm((N_EVEN, SSD_CONV_DIM), 0.02),
        'ssd_dt_bias': dt0 + jnp.log(-jnp.expm1(-dt0)),
        'ssd_a_log': jnp.log(unif((N_EVEN, 2, SSD_HEADS), 1.0, 16.0)),
        'ssd_d': 1.0 + nrm((N_EVEN, SSD_HEADS), 0.1),
        'ssd_norm_g': 1.0 + nrm((N_EVEN, SSD_D_INNER), 0.05),
        'rwkv_mu': unif((N_ODD, 2, 6, D), 0.0, 0.5),
        'rwkv_w_r': nrm((N_ODD, D, D), D ** -0.5),
        'rwkv_w_k': nrm((N_ODD, D, D), D ** -0.5),
        'rwkv_w_v': nrm((N_ODD, D, D), D ** -0.5),
        'rwkv_w0': unif((N_ODD, 2, D), -6.0, 1.0),
        'rwkv_w1': nrm((N_ODD, 2, D, R_DECAY), D ** -0.5),
        'rwkv_w2': nrm((N_ODD, 2, R_DECAY, D), 0.3 * R_DECAY ** -0.5),
        'rwkv_a0': nrm((N_ODD, 2, D), 0.3),
        'rwkv_a1': nrm((N_ODD, 2, D, R_AAA), D ** -0.5),
        'rwkv_a2': nrm((N_ODD, 2, R_AAA, D), 0.3 * R_AAA ** -0.5),
        'rwkv_g1': nrm((N_ODD, D, R_GATE), D ** -0.5),
        'rwkv_g2': nrm((N_ODD, R_GATE, D), R_GATE ** -0.5),
        'rwkv_k_k': 0.85 + nrm((N_ODD, D), 0.05),
        'rwkv_k_a': 1.0 + nrm((N_ODD, D), 0.05),
        'rwkv_r_k': nrm((N_ODD, RWKV_HEADS, RWKV_HEAD_DIM), 0.1),
        'rwkv_ln_g': 1.0 + nrm((N_ODD, D), 0.05),
        'rwkv_ln_b': nrm((N_ODD, D), 0.02),
        'rwkv_w_o': nrm((N_ODD, D, D), D ** -0.5),
        'final_norm_g': 1.0 + nrm((D,), 0.05),
    }


def reference(x_prompt, x_sample, cache_attn_k, cache_attn_v, state_ssd_fwd, state_ssd_bwd,
              state_rwkv_fwd, state_rwkv_bwd, c, c_ctx, mod_w, mod_b, norm_mix_g, norm_ffn_g,
              ffn_w_gate, ffn_w_up, ffn_w_down, ab_w_in, ab_w_out, attn_q_g, attn_k_g,
              ssd_conv_w, ssd_conv_b, ssd_dt_bias, ssd_a_log, ssd_d, ssd_norm_g,
              rwkv_mu, rwkv_w_r, rwkv_w_k, rwkv_w_v, rwkv_w0, rwkv_w1, rwkv_w2,
              rwkv_a0, rwkv_a1, rwkv_a2, rwkv_g1, rwkv_g2, rwkv_k_k, rwkv_k_a, rwkv_r_k,
              rwkv_ln_g, rwkv_ln_b, rwkv_w_o, final_norm_g):
    P = dict(mod_w=mod_w, mod_b=mod_b, norm_mix_g=norm_mix_g, norm_ffn_g=norm_ffn_g,
             ffn_w_gate=ffn_w_gate, ffn_w_up=ffn_w_up, ffn_w_down=ffn_w_down,
             ab_w_in=ab_w_in, ab_w_out=ab_w_out, attn_q_g=attn_q_g, attn_k_g=attn_k_g,
             ssd_conv_w=ssd_conv_w, ssd_conv_b=ssd_conv_b, ssd_dt_bias=ssd_dt_bias,
             ssd_a_log=ssd_a_log, ssd_d=ssd_d, ssd_norm_g=ssd_norm_g,
             rwkv_mu=rwkv_mu, rwkv_w_r=rwkv_w_r, rwkv_w_k=rwkv_w_k, rwkv_w_v=rwkv_w_v,
             rwkv_w0=rwkv_w0, rwkv_w1=rwkv_w1, rwkv_w2=rwkv_w2,
             rwkv_a0=rwkv_a0, rwkv_a1=rwkv_a1, rwkv_a2=rwkv_a2, rwkv_g1=rwkv_g1, rwkv_g2=rwkv_g2,
             rwkv_k_k=rwkv_k_k, rwkv_k_a=rwkv_k_a, rwkv_r_k=rwkv_r_k,
             rwkv_ln_g=rwkv_ln_g, rwkv_ln_b=rwkv_ln_b, rwkv_w_o=rwkv_w_o, final_norm_g=final_norm_g)
    y_prompt, st = trunk(x_prompt, c_ctx, None, None, P)
    ctx = dict(k=cache_attn_k, v=cache_attn_v, ssd_f=state_ssd_fwd, ssd_b=state_ssd_bwd,
               rwkv_f=state_rwkv_fwd, rwkv_b=state_rwkv_bwd)
    y_sample, _ = trunk(x_sample, c, grid_rope(x_sample.shape[1]), ctx, P)
    new_attn_k = jnp.stack(st['k'], axis=1)
    new_attn_v = jnp.stack(st['v'], axis=1)
    new_ssd_fwd = jnp.stack(st['ssd_f'], axis=1)
    new_ssd_bwd = jnp.stack(st['ssd_b'], axis=1)
    new_rwkv_fwd = jnp.stack(st['rwkv_f'], axis=1)
    new_rwkv_bwd = jnp.stack(st['rwkv_b'], axis=1)
    return (y_prompt, y_sample, new_attn_k, new_attn_v, new_ssd_fwd, new_ssd_bwd, new_rwkv_fwd, new_rwkv_bwd)
```

```cpp
#include <hip/hip_runtime.h>
#include <cstdio>
#include <cstdint>

#ifndef MK_N_LAUNCHES
#define MK_N_LAUNCHES 1
#endif

#define LAS __attribute__((address_space(3)))
#define GAS __attribute__((address_space(1)))
typedef _Float16 h16;
typedef _Float16 h16x2 __attribute__((ext_vector_type(2)));
typedef _Float16 h16x4 __attribute__((ext_vector_type(4)));
typedef _Float16 h16x8 __attribute__((ext_vector_type(8)));
typedef float f32x4 __attribute__((ext_vector_type(4)));
typedef float f32x2 __attribute__((ext_vector_type(2)));
typedef unsigned u32x4 __attribute__((ext_vector_type(4)));

constexpr int D = 1024, NTOK = 6144, NCTX = 4096, FF = 2816;
constexpr int PROJ_LD = 2176;
constexpr int NPH = 21;
constexpr int NWAVES = 8, NTHREADS = 512;

constexpr size_t MiB = 1u << 20;
constexpr size_t WS_CTL = 0, CTL_ZERO_BYTES = 32768;
constexpr size_t WS_WIN = 1 * MiB;
constexpr size_t WS_WOUT = 6 * MiB;
constexpr size_t WS_WGU = 8 * MiB;
constexpr size_t WS_WDN = 30 * MiB;
constexpr size_t WS_WRKV = 41 * MiB;
constexpr size_t WS_WO = 48 * MiB;
constexpr size_t WS_W2T = 50 * MiB;
constexpr size_t WS_A2T = WS_W2T + 262144;
constexpr size_t WS_G2T = WS_A2T + 262144;
constexpr size_t WS_ADA = 51 * MiB;
constexpr size_t WS_ROPE = WS_ADA + 262144;
constexpr size_t WS_ROWSS = WS_ADA + 524288;
constexpr size_t WS_FBIAS = WS_ADA + 589824;
constexpr size_t WS_X = 52 * MiB;
constexpr size_t WS_HA = 76 * MiB;
constexpr size_t WS_HID = 88 * MiB;
constexpr size_t WS_PROJ = 121 * MiB;
constexpr size_t WS_Q16 = 172 * MiB;
constexpr size_t WS_K16C = 178 * MiB;
constexpr size_t WS_VT16C = 179 * MiB;
constexpr size_t WS_K16L = 180 * MiB;
constexpr size_t WS_VT16L = 181 * MiB;
constexpr size_t WS_CAT = 182 * MiB;
constexpr size_t WS_XBC = 194 * MiB;
constexpr size_t WS_DT = 212 * MiB;
constexpr size_t WS_DA = WS_DT + 6144 * 16 * 4;
constexpr size_t WS_SSDY = 213 * MiB;
constexpr size_t WS_G16 = 1 * MiB;
constexpr size_t WS_BONUS = 13 * MiB;
constexpr size_t WS_LORA16 = 76 * MiB;
constexpr size_t WS_R16 = 88 * MiB;
constexpr size_t WS_K16 = 100 * MiB;
constexpr size_t WS_Y16 = 88 * MiB;
constexpr size_t WS_V16 = 112 * MiB;
constexpr size_t WS_XMIX = 124 * MiB;
constexpr size_t WS_DEC16 = 124 * MiB;
constexpr size_t WS_A16 = 148 * MiB;
constexpr size_t WS_OPS2 = 172 * MiB;
constexpr size_t OPS2_ITEM = 6400;
constexpr size_t WS_END = 256 * MiB;

constexpr size_t O_Y = 0, O_K = 6291456, O_V = 6815744, O_SSDF = 7340032, O_SSDB = 7864320, O_RWF = 8388608, O_RWB = 9437184;

constexpr int LDS_BYTES = 148480;
constexpr int LDS_MISC = 147456;

struct Params {
    const float* in[46];
    float* out;
    unsigned char* ws;
    int ph_lo, ph_hi;
};
enum { I_XP = 0, I_XS, I_CK, I_CV, I_SSDF, I_SSDB, I_RWF, I_RWB, I_C, I_CCTX, I_MODW, I_MODB, I_NMG, I_NFG, I_WG, I_WU, I_WD,
       I_WIN, I_WOUT, I_QG, I_KG, I_CONVW, I_CONVB, I_DTB, I_ALOG, I_SSDD, I_SSDG, I_MU, I_WR, I_WK, I_WV, I_W0, I_W1, I_W2,
       I_A0, I_A1, I_A2, I_G1, I_G2, I_KKW, I_KA, I_RK, I_LNG, I_LNB, I_WO, I_FNG };

struct Ctx { int tid, lane, wave, bid, G; LAS unsigned char* lds; };

__device__ __forceinline__ float wave_sum(float v) {
#pragma unroll
    for (int o = 1; o < 64; o <<= 1) v += __shfl_xor(v, o);
    return v;
}
__device__ __forceinline__ float sigmoid_f(float x) { return __builtin_amdgcn_rcpf(1.f + __expf(-x)); }
__device__ __forceinline__ float silu_f(float x) { return x * sigmoid_f(x); }
__device__ __forceinline__ float softplus_f(float x) { return fmaxf(x, 0.f) + log1pf(__expf(-fabsf(x))); }
__device__ __forceinline__ int stream_of(int row) { return row < NCTX ? 0 : 1 + ((row - NCTX) >> 10); }
__device__ __forceinline__ h16x4 cvt4(f32x4 v) { h16x4 o; o.x = (h16)v.x; o.y = (h16)v.y; o.z = (h16)v.z; o.w = (h16)v.w; return o; }

template <int M> __device__ __forceinline__ void fmac_bc(float& d, float a, float b) {
    asm("v_fmac_f32_dpp %0, %1, %2 row_newbcast:%3 row_mask:0xf bank_mask:0xf" : "+v"(d) : "v"(a), "v"(b), "n"(M));
}
template <int M> __device__ __forceinline__ void fmac_bc_safe(float& d, float a, float b) {
    asm volatile("s_nop 1\n\tv_fmac_f32_dpp %0, %1, %2 row_newbcast:%3 row_mask:0xf bank_mask:0xf\n\ts_nop 1" : "+v"(d) : "v"(a), "v"(b), "n"(M));
}
template <int M> __device__ __forceinline__ void mul_bc(float& d, float a) {
    asm("v_mul_f32_dpp %0, %1, %0 row_newbcast:%2 row_mask:0xf bank_mask:0xf" : "+v"(d) : "v"(a), "n"(M));
}
__device__ __forceinline__ float rowsum4(float x) {
    float a = x, b = x;
    asm volatile("s_nop 1\n\tv_permlane16_swap_b32 %0, %1\n\ts_nop 1" : "+v"(a), "+v"(b));
    x = a + b; a = x; b = x;
    asm volatile("s_nop 1\n\tv_permlane32_swap_b32 %0, %1\n\ts_nop 1" : "+v"(a), "+v"(b));
    return a + b;
}

#define XB_TMO      128
#define XB_XCNT(j)  (256  + 64 * (j))
#define XB_XSUB(j)  (1280 + 64 * (j))
#define XB_XGEN(j)  (2304 + 64 * (j))
#define XB_TOP      3328
#define XB_TOPGEN   3392
#define XCD_BAR_WORDS 3456
#define XB_SPIN_CAP (1u << 22)
__device__ __forceinline__ unsigned xb_ld(unsigned* p)              { return __hip_atomic_load(p, __ATOMIC_RELAXED, __HIP_MEMORY_SCOPE_AGENT); }
__device__ __forceinline__ unsigned xb_add(unsigned* p, unsigned v) { return __hip_atomic_fetch_add(p, v, __ATOMIC_RELAXED, __HIP_MEMORY_SCOPE_AGENT); }
__device__ __forceinline__ unsigned xb_xcc_id() { return (unsigned)__builtin_amdgcn_s_getreg((3 << 11) | 20) & 0xFu; }
#define XB_SPIN(cond, bar) do { unsigned _sp = 0; while (cond) { __builtin_amdgcn_s_sleep(1); \
    if ((++_sp & 255u) == 0u) { if (xb_ld(&(bar)[XB_TMO])) break; if (_sp > XB_SPIN_CAP) { atomicAdd(&(bar)[XB_TMO], 1u); break; } } } } while (0)
struct XcdBarrier { unsigned* bar; unsigned x; volatile LAS unsigned* st; };
__device__ __forceinline__ XcdBarrier xcd_barrier_post(unsigned* bar, volatile LAS unsigned* st) {
    XcdBarrier b; b.bar = bar; b.x = xb_xcc_id(); b.st = st;
    if (threadIdx.x == 0) (void)xb_add(&bar[XB_XCNT(b.x)], 1u);
    return b;
}
__device__ __forceinline__ void xcd_barrier_complete(unsigned* bar, unsigned x, unsigned& nloc, unsigned& nx) {
    const unsigned G = gridDim.x * gridDim.y * gridDim.z;
    unsigned sum, cnt, mine, sp = 0u;
    for (;;) {
        sum = 0u; cnt = 0u; mine = 0u;
#pragma unroll
        for (unsigned j = 0; j < 16; ++j) { const unsigned c = xb_ld(&bar[XB_XCNT(j)]); sum += c; cnt += (c > 0u) ? 1u : 0u; mine = (j == x) ? c : mine; }
        if (sum == G) break;
        __builtin_amdgcn_s_sleep(1);
        if ((++sp & 255u) == 0u) { if (xb_ld(&bar[XB_TMO])) break; if (sp > XB_SPIN_CAP) { atomicAdd(&bar[XB_TMO], 1u); break; } }
    }
    nloc = mine > 0u ? mine : 1u; nx = cnt > 0u ? cnt : 1u;
}
__device__ __forceinline__ void xcd_barrier(const XcdBarrier& b) {
    asm volatile("s_waitcnt vmcnt(0)" ::: "memory");
    __syncthreads();
    if (threadIdx.x == 0) {
        unsigned* bar = b.bar;
        __builtin_amdgcn_s_waitcnt(0);
        unsigned nloc = b.st[0], nx = b.st[1];
        if (nloc == 0u) { xcd_barrier_complete(bar, b.x, nloc, nx); b.st[0] = nloc; b.st[1] = nx; }
        const unsigned old = xb_add(&bar[XB_XSUB(b.x)], 1u);
        const unsigned gen = old / nloc;
        if (old + 1u == (gen + 1u) * nloc) {
            __builtin_amdgcn_fence(__ATOMIC_RELEASE, "agent");
            asm volatile("s_waitcnt vmcnt(0)" ::: "memory");
            const unsigned og = xb_add(&bar[XB_TOP], 1u);
            const unsigned tg = og / nx;
            if (og + 1u == (tg + 1u) * nx) xb_add(&bar[XB_TOPGEN], 1u);
            else XB_SPIN(xb_ld(&bar[XB_TOPGEN]) == tg, bar);
            __builtin_amdgcn_fence(__ATOMIC_ACQUIRE, "agent");
            xb_add(&bar[XB_XGEN(b.x)], 1u);
            asm volatile("s_waitcnt vmcnt(0)" ::: "memory");
        } else {
            XB_SPIN(xb_ld(&bar[XB_XGEN(b.x)]) == gen, bar);
            __builtin_amdgcn_fence(__ATOMIC_ACQUIRE, "agent");
            asm volatile("s_waitcnt vmcnt(0)" ::: "memory");
        }
    }
    __syncthreads();
}

struct GemmTile { const h16* A; int lda; const h16* Bt; int ldb; int K; int m0, n0; };
constexpr int GEMM_STAGE_BYTES = 49152;

template <int BM>
__device__ __forceinline__ void gemm_tile(const Ctx& c, const GemmTile& g, f32x4 (&acc)[BM / 64][4]) {
    constexpr int MF = BM / 64, WM = BM / 4;
    LAS unsigned char* lds = c.lds;
    const int tid = c.tid, lane = c.lane, wave = c.wave;
    const int wm = wave >> 1, wn = wave & 1;
    const bool h1 = wave >= 4;
    const int srow = tid >> 3, schunk = (tid & 7) ^ (srow & 7);
    const h16* gA = g.A + (size_t)(g.m0 + srow) * g.lda + schunk * 8;
    const h16* gB = g.Bt + (size_t)(g.n0 + srow) * g.ldb + schunk * 8;
    const size_t stepA = (size_t)64 * g.lda, stepB = (size_t)64 * g.ldb;
    const unsigned ldsw = (unsigned)wave * 1024u;
    const int fr = lane & 15, fq = lane >> 4;
    int offA[2], offB[2];
#pragma unroll
    for (int s = 0; s < 2; ++s) {
        offA[s] = (wm * WM + fr) * 128 + (((s * 4 + fq) ^ (fr & 7)) << 4);
        offB[s] = 32768 + (wn * 64 + fr) * 128 + (((s * 4 + fq) ^ (fr & 7)) << 4);
    }
#pragma unroll
    for (int i = 0; i < MF; ++i)
#pragma unroll
        for (int j = 0; j < 4; ++j) acc[i][j] = (f32x4){0.f, 0.f, 0.f, 0.f};
    const int nk = g.K >> 6;
#define G_LDSA(kt, buf, p_) __builtin_amdgcn_global_load_lds((const unsigned*)(gA + (p_) * stepA + (size_t)(kt) * 64), (LAS unsigned*)(lds + (buf) * GEMM_STAGE_BYTES + (p_) * 8192 + ldsw), 16, 0, 0)
#define G_LDSB(kt, buf, p_) __builtin_amdgcn_global_load_lds((const unsigned*)(gB + (p_) * stepB + (size_t)(kt) * 64), (LAS unsigned*)(lds + (buf) * GEMM_STAGE_BYTES + 32768 + (p_) * 8192 + ldsw), 16, 0, 0)
#define G_PART0(kt, buf) do { G_LDSA(kt, buf, 0); G_LDSA(kt, buf, 1); G_LDSA(kt, buf, 2); } while (0)
#define G_PART1(kt, buf) do { if (MF == 4) G_LDSA(kt, buf, 3); G_LDSB(kt, buf, 0); G_LDSB(kt, buf, 1); } while (0)
#define G_BAR() do { asm volatile("s_waitcnt lgkmcnt(0)" ::: "memory"); __builtin_amdgcn_s_barrier(); asm volatile("" ::: "memory"); } while (0)
    G_PART0(0, 0); G_PART1(0, 0);
    if (nk > 1) { G_PART0(1, 1); G_PART1(1, 1); if (MF == 4) asm volatile("s_waitcnt vmcnt(6)" ::: "memory"); else asm volatile("s_waitcnt vmcnt(5)" ::: "memory"); }
    else asm volatile("s_waitcnt vmcnt(0)" ::: "memory");
    G_BAR();
    if (h1) G_BAR();
    int cur = 0;
    for (int kt = 0; kt < nk; ++kt) {
        const int nb = cur >= 1 ? cur - 1 : 2;
        const LAS unsigned char* lb = lds + cur * GEMM_STAGE_BYTES;
        const bool more = kt + 2 < nk;
        h16x8 af[MF], bf[4];
        if (more) G_PART0(kt + 2, nb);
#pragma unroll
        for (int i = 0; i < MF; ++i) af[i] = *(const LAS h16x8*)(lb + offA[0] + i * 2048);
#pragma unroll
        for (int j = 0; j < 4; ++j) bf[j] = *(const LAS h16x8*)(lb + offB[0] + j * 2048);
        G_BAR();
        __builtin_amdgcn_s_setprio(1);
#pragma unroll
        for (int i = 0; i < MF; ++i)
#pragma unroll
            for (int j = 0; j < 4; ++j) acc[i][j] = __builtin_amdgcn_mfma_f32_16x16x32_f16(bf[j], af[i], acc[i][j], 0, 0, 0);
        __builtin_amdgcn_s_setprio(0);
        G_BAR();
        if (kt + 1 < nk) { if (more) asm volatile("s_waitcnt vmcnt(3)" ::: "memory"); else asm volatile("s_waitcnt vmcnt(0)" ::: "memory"); }
        if (more) G_PART1(kt + 2, nb);
#pragma unroll
        for (int i = 0; i < MF; ++i) af[i] = *(const LAS h16x8*)(lb + offA[1] + i * 2048);
#pragma unroll
        for (int j = 0; j < 4; ++j) bf[j] = *(const LAS h16x8*)(lb + offB[1] + j * 2048);
        G_BAR();
        __builtin_amdgcn_s_setprio(1);
#pragma unroll
        for (int i = 0; i < MF; ++i)
#pragma unroll
            for (int j = 0; j < 4; ++j) acc[i][j] = __builtin_amdgcn_mfma_f32_16x16x32_f16(bf[j], af[i], acc[i][j], 0, 0, 0);
        __builtin_amdgcn_s_setprio(0);
        G_BAR();
        cur = cur == 2 ? 0 : cur + 1;
    }
    if (!h1) G_BAR();
#undef G_LDSA
#undef G_LDSB
#undef G_PART0
#undef G_PART1
#undef G_BAR
}

__device__ __forceinline__ void tr_item(const float* W, int ldw, int nvalid, int k0, int n0, h16* dst, int ldd, int drow0, LAS float* scr, int lane) {
    const int c4 = lane & 7, kr = lane >> 3;
    const bool ok = (n0 + 4 * c4) < nvalid;
#pragma unroll
    for (int i = 0; i < 8; ++i) {
        const int kk = kr + 8 * i;
        const f32x4 v = ok ? *(const f32x4*)(W + (size_t)(k0 + kk) * ldw + n0 + 4 * c4) : (f32x4){0.f, 0.f, 0.f, 0.f};
        LAS float* s = scr + kk * 33 + 4 * c4;
        s[0] = v[0]; s[1] = v[1]; s[2] = v[2]; s[3] = v[3];
    }
    asm volatile("s_waitcnt lgkmcnt(0)" ::: "memory");
    const int cch = lane & 7;
#pragma unroll
    for (int j = 0; j < 4; ++j) {
        const int n = (lane >> 3) + 8 * j; const LAS float* s = scr + (8 * cch) * 33 + n;
        h16x8 o;
#pragma unroll
        for (int e = 0; e < 8; ++e) o[e] = (h16)s[e * 33];
        *(h16x8*)(dst + (size_t)(drow0 + n) * ldd + k0 + 8 * cch) = o;
    }
    asm volatile("s_waitcnt lgkmcnt(0)" ::: "memory");
}
struct TrJob { const float* src; int K, N, ldw, nvalid; h16* dst; int ldd, kind, base; };
__device__ __forceinline__ int tr_job(const Params& p, int j, TrJob& J) {
    unsigned char* ws = p.ws;
    switch (j) {
    case 0: J = {p.in[I_WIN], 1024, 2176, 2064, 2064, (h16*)(ws + WS_WIN), 1024, 0, 0}; break;
    case 1: J = {p.in[I_WOUT], 1024, 1024, 1024, 1024, (h16*)(ws + WS_WOUT), 1024, 0, 0}; break;
    case 2: case 3: J = {p.in[I_WG] + (size_t)(j - 2) * 1024 * 2816, 1024, 2816, 2816, 2816, (h16*)(ws + WS_WGU) + (size_t)(j - 2) * 5632 * 1024, 1024, 1, 0}; break;
    case 4: case 5: J = {p.in[I_WU] + (size_t)(j - 4) * 1024 * 2816, 1024, 2816, 2816, 2816, (h16*)(ws + WS_WGU) + (size_t)(j - 4) * 5632 * 1024, 1024, 2, 0}; break;
    case 6: case 7: J = {p.in[I_WD] + (size_t)(j - 6) * 2816 * 1024, 2816, 1024, 1024, 1024, (h16*)(ws + WS_WDN) + (size_t)(j - 6) * 1024 * 2816, 2816, 0, 0}; break;
    case 8: J = {p.in[I_WR], 1024, 1024, 1024, 1024, (h16*)(ws + WS_WRKV), 1024, 0, 0}; break;
    case 9: J = {p.in[I_WK], 1024, 1024, 1024, 1024, (h16*)(ws + WS_WRKV), 1024, 0, 1024}; break;
    case 10: J = {p.in[I_WV], 1024, 1024, 1024, 1024, (h16*)(ws + WS_WRKV), 1024, 0, 2048}; break;
    case 11: case 12: J = {p.in[I_W1] + (size_t)(j - 11) * 1024 * 64, 1024, 64, 64, 64, (h16*)(ws + WS_WRKV), 1024, 0, 3072 + 64 * (j - 11)}; break;
    case 13: case 14: J = {p.in[I_A1] + (size_t)(j - 13) * 1024 * 64, 1024, 64, 64, 64, (h16*)(ws + WS_WRKV), 1024, 0, 3072 + 128 + 64 * (j - 13)}; break;
    case 15: J = {p.in[I_G1], 1024, 128, 128, 128, (h16*)(ws + WS_WRKV), 1024, 0, 3072 + 256}; break;
    case 16: J = {p.in[I_WO], 1024, 1024, 1024, 1024, (h16*)(ws + WS_WO), 1024, 0, 0}; break;
    case 17: case 18: J = {p.in[I_W2] + (size_t)(j - 17) * 64 * 1024, 64, 1024, 1024, 1024, (h16*)(ws + WS_W2T) + (size_t)(j - 17) * 1024 * 64, 64, 0, 0}; break;
    case 19: case 20: J = {p.in[I_A2] + (size_t)(j - 19) * 64 * 1024, 64, 1024, 1024, 1024, (h16*)(ws + WS_A2T) + (size_t)(j - 19) * 1024 * 64, 64, 0, 0}; break;
    default: J = {p.in[I_G2], 128, 1024, 1024, 1024, (h16*)(ws + WS_G2T), 128, 0, 0}; break;
    }
    return (J.K / 64) * (J.N / 32);
}
constexpr int N_TRJOBS = 22;

__device__ __forceinline__ void ada_unit(const Params& p, const Ctx& c, int u) {
    LAS float* sc = (LAS float*)c.lds;
    LAS float* red = (LAS float*)(c.lds + 16384);
    const int layer = u / 96, cb = u % 96;
    __syncthreads();
    for (int i = c.tid; i < 3072; i += NTHREADS) {
        const int k = i >> 10, d = i & 1023;
        const float v = (k == 0) ? p.in[I_CCTX][d] : p.in[I_C][(k - 1) * 1024 + d];
        sc[i] = silu_f(v);
    }
    __syncthreads();
    const int tx = c.tid & 15, dg = c.tid >> 4;
    const float* w = p.in[I_MODW] + (size_t)layer * 1024 * 6144 + (size_t)(dg * 32) * 6144 + cb * 64 + tx * 4;
    f32x4 a0 = {0, 0, 0, 0}, a1 = a0, a2 = a0;
#pragma unroll 8
    for (int d = 0; d < 32; ++d) {
        const f32x4 wv = *(const f32x4*)(w + (size_t)d * 6144);
        const int dd = dg * 32 + d;
        a0 += wv * sc[dd]; a1 += wv * sc[1024 + dd]; a2 += wv * sc[2048 + dd];
    }
    *(LAS f32x4*)(red + (dg * 3 + 0) * 64 + tx * 4) = a0;
    *(LAS f32x4*)(red + (dg * 3 + 1) * 64 + tx * 4) = a1;
    *(LAS f32x4*)(red + (dg * 3 + 2) * 64 + tx * 4) = a2;
    __syncthreads();
    if (c.tid < 192) {
        const int k = c.tid >> 6, col = c.tid & 63;
        float s = p.in[I_MODB][layer * 6144 + cb * 64 + col];
#pragma unroll 8
        for (int g = 0; g < 32; ++g) s += red[(g * 3 + k) * 64 + col];
        ((float*)(p.ws + WS_ADA))[(layer * 3 + k) * 6144 + cb * 64 + col] = s;
    }
}

constexpr int N_CONV_ITEMS = 11392, N_CONV_UNITS = N_CONV_ITEMS / 64;
__device__ __forceinline__ void conv_unit(const Params& p, const Ctx& c, int u) {
    LAS float* scr = (LAS float*)(c.lds + c.wave * 16384);
    __syncthreads();
    for (int e = 0; e < 8; ++e) {
        int it = u * 64 + c.wave * 8 + e;
        int j = 1; TrJob J; int cnt = tr_job(p, j, J);
        while (it >= cnt) { it -= cnt; ++j; cnt = tr_job(p, j, J); }
        const int nblk = J.N / 32, kb = it / nblk, nb = it % nblk, n0 = nb * 32;
        const int drow0 = J.kind == 0 ? J.base + n0 : (J.kind == 1 ? 2 * n0 : 2 * n0 + 32);
        tr_item(J.src, J.ldw, J.nvalid, kb * 64, n0, J.dst, J.ldd, drow0, scr, c.lane);
    }
    __syncthreads();
}
__device__ __forceinline__ void phase0(const Params& p, const Ctx& c) {
    for (int u = c.bid; u < 192; u += c.G) ada_unit(p, c, u);
    __syncthreads();
    {
        LAS float* scr = (LAS float*)(c.lds + c.wave * 16384);
        const int gw = c.bid * NWAVES + c.wave, NGW = c.G * NWAVES;
        TrJob J; const int cnt = tr_job(p, 0, J);
        const int nblk = J.N / 32;
        for (int it = gw; it < cnt; it += NGW) {
            const int kb = it / nblk, nb = it % nblk, n0 = nb * 32;
            tr_item(J.src, J.ldw, J.nvalid, kb * 64, n0, J.dst, J.ldd, J.base + n0, scr, c.lane);
        }
    }
    { float* rs_ = (float*)(p.ws + WS_ROWSS); for (int i = c.bid * NTHREADS + c.tid; i < 2 * NTOK; i += c.G * NTHREADS) rs_[i] = 0.f; }
    const int gt = c.bid * NTHREADS + c.tid, NGT = c.G * NTHREADS;
    float* rc = (float*)(p.ws + WS_ROPE); float* rs = rc + 32768;
    for (int i = gt; i < 32768; i += NGT) {
        const int tok = i >> 5, f = i & 31;
        const float pos = (float)((f < 16) ? (tok >> 6) : (tok & 63));
        const float inv = powf(10000.f, -(float)(f & 15) / 16.f);
        const float ang = pos * inv;
        rc[i] = cosf(ang); rs[i] = sinf(ang);
    }
    h16* k16l = (h16*)(p.ws + WS_K16L); h16* vt16l = (h16*)(p.ws + WS_VT16L);
    for (int i = gt; i < 65536; i += NGT) {
        const int d = i & 63, kvh = (i >> 6) & 1, key = (i >> 7) & 255, b = i >> 15;
        k16l[((size_t)(b * 2 + kvh) * 1280 + key) * 64 + d] = (h16)p.in[I_CK][i];
        vt16l[((size_t)(b * 2 + kvh) * 64 + d) * 1280 + key] = (h16)p.in[I_CV][i];
    }
}

__device__ __forceinline__ void load_row(const float* r, int lane, f32x4 (&v)[4]) {
#pragma unroll
    for (int j = 0; j < 4; ++j) v[j] = *(const f32x4*)(r + 256 * j + 4 * lane);
}
__device__ __forceinline__ float row_rstd(const f32x4 (&v)[4]) {
    float s = 0.f;
#pragma unroll
    for (int j = 0; j < 4; ++j) s += v[j].x * v[j].x + v[j].y * v[j].y + v[j].z * v[j].z + v[j].w * v[j].w;
    return rsqrtf(wave_sum(s) * (1.f / 1024.f) + 1e-6f);
}
__device__ __forceinline__ const float* xin_row(const Params& p, int row) {
    return row < NCTX ? p.in[I_XP] + (size_t)row * D : p.in[I_XS] + (size_t)(row - NCTX) * D;
}
__device__ __forceinline__ void phase_normmod(const Params& p, const Ctx& c, bool from_input, const float* g, int layer, int ch_sh, int ch_sc) {
    const int gw = c.bid * NWAVES + c.wave, NGW = c.G * NWAVES;
    const float* ada = (const float*)(p.ws + WS_ADA);
    h16* hA = (h16*)(p.ws + WS_HA);
    for (int row = gw; row < NTOK; row += NGW) {
        const float* xr = from_input ? xin_row(p, row) : (const float*)(p.ws + WS_X) + (size_t)row * D;
        f32x4 v[4]; load_row(xr, c.lane, v);
        const float rstd = row_rstd(v);
        const float* a = ada + (size_t)(layer * 3 + stream_of(row)) * 6144;
#pragma unroll
        for (int j = 0; j < 4; ++j) {
            const int col = 256 * j + 4 * c.lane;
            const f32x4 gg = *(const f32x4*)(g + col), sh = *(const f32x4*)(a + ch_sh * 1024 + col), sc = *(const f32x4*)(a + ch_sc * 1024 + col);
            const f32x4 o = v[j] * rstd * gg * (sc + 1.f) + sh;
            *(h16x4*)(hA + (size_t)row * D + col) = cvt4(o);
        }
    }
}

__device__ __forceinline__ void phase_postproj(const Params& p, const Ctx& c) {
    const int gw = c.bid * NWAVES + c.wave, NGW = c.G * NWAVES, lane = c.lane;
    const float* proj = (const float*)(p.ws + WS_PROJ);
    float* xbc = (float*)(p.ws + WS_XBC);
    float* dtv = (float*)(p.ws + WS_DT);
    for (int it = gw; it < 384 * 3; it += NGW) {
        const int seg = it / 3, cb = it % 3, row0 = seg * 16, ch = cb * 256 + lane * 4;
        const int T = row0 >= NCTX ? 1024 : 256, t0 = (row0 >= NCTX ? row0 - NCTX : row0) & (T - 1);
        f32x4 x[20];
#pragma unroll
        for (int r = 0; r < 20; ++r) {
            const int tt = t0 + r - 2;
            x[r] = (tt >= 0 && tt < T) ? *(const f32x4*)(proj + (size_t)(row0 + r - 2) * PROJ_LD + 1280 + ch) : (f32x4){0.f, 0.f, 0.f, 0.f};
        }
        f32x4 w[5];
#pragma unroll
        for (int i = 0; i < 5; ++i) w[i] = *(const f32x4*)(p.in[I_CONVW] + i * 768 + ch);
        const f32x4 bias = *(const f32x4*)(p.in[I_CONVB] + ch);
#pragma unroll
        for (int r = 0; r < 16; ++r) {
            f32x4 a = bias;
#pragma unroll
            for (int i = 0; i < 5; ++i) a += w[i] * x[r + i];
            f32x4 o; o[0] = silu_f(a[0]); o[1] = silu_f(a[1]); o[2] = silu_f(a[2]); o[3] = silu_f(a[3]);
            *(f32x4*)(xbc + (size_t)(row0 + r) * 768 + ch) = o;
        }
    }
    for (int it = gw; it < NTOK / 4; it += NGW) {
        const int row = it * 4 + (lane >> 4), e = lane & 15;
        dtv[row * 16 + e] = softplus_f(proj[(size_t)row * PROJ_LD + 2048 + e] + p.in[I_DTB][e]);
    }
}

__device__ __forceinline__ void phase_ssdcombine(const Params& p, const Ctx& c) {
    const int gw = c.bid * NWAVES + c.wave, NGW = c.G * NWAVES, lane = c.lane;
    {
        const float* ada = (const float*)(p.ws + WS_ADA); float* fb = (float*)(p.ws + WS_FBIAS);
        for (int it = gw; it < 2 * 5632; it += NGW) {
            const int l = it / 5632, n = it % 5632;
            const h16* wr = (const h16*)(p.ws + WS_WGU) + ((size_t)l * 5632 + n) * 1024 + lane * 16;
            const h16x8 w0 = *(const h16x8*)wr, w1 = *(const h16x8*)(wr + 8);
            float a0 = 0.f, a1 = 0.f, a2 = 0.f;
#pragma unroll
            for (int e = 0; e < 16; ++e) {
                const float w = (float)(e < 8 ? w0[e & 7] : w1[e & 7]); const int k = lane * 16 + e;
                a0 += w * ada[(size_t)(l * 3 + 0) * 6144 + 3072 + k]; a1 += w * ada[(size_t)(l * 3 + 1) * 6144 + 3072 + k]; a2 += w * ada[(size_t)(l * 3 + 2) * 6144 + 3072 + k];
            }
            a0 = wave_sum(a0); a1 = wave_sum(a1); a2 = wave_sum(a2);
            if (lane == 0) { fb[(size_t)(l * 3 + 0) * 5632 + n] = a0; fb[(size_t)(l * 3 + 1) * 5632 + n] = a1; fb[(size_t)(l * 3 + 2) * 5632 + n] = a2; }
        }
    }
    const float* ssdy = (const float*)(p.ws + WS_SSDY);
    const float* xbc = (const float*)(p.ws + WS_XBC);
    const float* proj = (const float*)(p.ws + WS_PROJ);
    h16* cat = (h16*)(p.ws + WS_CAT);
    for (int row = gw; row < NTOK; row += NGW) {
        const int c0 = lane * 8, h = lane >> 3;
        const float dsk = p.in[I_SSDD][h];
        float y[8]; float ss = 0.f;
#pragma unroll
        for (int e = 0; e < 2; ++e) {
            const f32x4 yf = *(const f32x4*)(ssdy + (size_t)row * 512 + c0 + 4 * e), yb = *(const f32x4*)(ssdy + (size_t)(NTOK + row) * 512 + c0 + 4 * e);
            const f32x4 xs = *(const f32x4*)(xbc + (size_t)row * 768 + c0 + 4 * e), z = *(const f32x4*)(proj + (size_t)row * PROJ_LD + 768 + c0 + 4 * e);
#pragma unroll
            for (int q = 0; q < 4; ++q) { const float v = (yf[q] + yb[q] + dsk * xs[q]) * silu_f(z[q]); y[4 * e + q] = v; ss += v * v; }
        }
        const float rstd = rsqrtf(wave_sum(ss) * (1.f / 512.f) + 1e-6f);
        h16x8 o;
#pragma unroll
        for (int e = 0; e < 8; ++e) o[e] = (h16)(y[e] * rstd * p.in[I_SSDG][c0 + e]);
        *(h16x8*)(cat + (size_t)row * D + 512 + c0) = o;
    }
}

__device__ __forceinline__ void phase_rwkvmix(const Params& p, const Ctx& c) {
    const int gw = c.bid * NWAVES + c.wave, NGW = c.G * NWAVES, lane = c.lane;
    const float* X = (const float*)(p.ws + WS_X);
    const float* ada = (const float*)(p.ws + WS_ADA);
    const float* g = p.in[I_NMG] + 1024;
    h16* xm = (h16*)(p.ws + WS_XMIX);
    for (int row = gw; row < NTOK; row += NGW) {
        const bool lat = row >= NCTX;
        const int r2 = lat ? row - NCTX : row;
        const int t = lat ? (r2 & 1023) : (r2 & 255), T = lat ? 1024 : 256;
        const float* a = ada + (size_t)(3 + stream_of(row)) * 6144;
        f32x4 h0[4], hp[4], hn[4];
        load_row(X + (size_t)row * D, lane, h0);
        const float r0 = row_rstd(h0);
        const bool hasp = t > 0, hasn = t < T - 1;
        float rp = 0.f, rn = 0.f;
        if (hasp) { load_row(X + (size_t)(row - 1) * D, lane, hp); rp = row_rstd(hp); }
        if (hasn) { load_row(X + (size_t)(row + 1) * D, lane, hn); rn = row_rstd(hn); }
#pragma unroll
        for (int j = 0; j < 4; ++j) {
            const int col = 256 * j + 4 * lane;
            const f32x4 gg = *(const f32x4*)(g + col), sh = *(const f32x4*)(a + col), sc = *(const f32x4*)(a + 1024 + col);
            const f32x4 m = gg * (sc + 1.f);
            const f32x4 hh = h0[j] * r0 * m + sh;
            f32x4 dp = -hh, dn = -hh;
            if (hasp) dp = (hp[j] * rp * m + sh) - hh;
            if (hasn) dn = (hn[j] * rn * m + sh) - hh;
#pragma unroll
            for (int i = 0; i < 6; ++i) {
                const f32x4 m0 = *(const f32x4*)(p.in[I_MU] + i * 1024 + col), m1 = *(const f32x4*)(p.in[I_MU] + (6 + i) * 1024 + col);
                *(h16x4*)(xm + ((size_t)i * NTOK + row) * D + col) = cvt4(hh + dp * m0 + dn * m1);
            }
        }
    }
}

template <int N> __device__ __forceinline__ float dpp_row_shr1(float x) {
    return __builtin_bit_cast(float, __builtin_amdgcn_update_dpp(0x3f800000, __builtin_bit_cast(int, x), 0x110 + N, 0xf, 0xf, false));
}
__device__ __forceinline__ float dpp_bcast15(float x) {
    return __builtin_bit_cast(float, __builtin_amdgcn_update_dpp(0, __builtin_bit_cast(int, x), 0x150 + 15, 0xf, 0xf, false));
}
template <int J> struct TriSolve {
    static __device__ __forceinline__ void run(float (&Tm)[4], const float (&nL)[16]) {
#pragma unroll
        for (int cc = 0; cc < 4; ++cc) { float src_ = Tm[cc]; fmac_bc_safe<J>(Tm[cc], src_, nL[J]); }
        if constexpr (J < 14) TriSolve<J + 1>::run(Tm, nL);
    }
};
__device__ __forceinline__ void phase_rwkvprep(const Params& p, const Ctx& c) {
    const int gw = c.bid * NWAVES + c.wave, NGW = c.G * NWAVES, lane = c.lane;
    const int i = lane & 15, g = lane >> 4;
    LAS unsigned char* scr = c.lds + c.wave * 8192;
    const h16* r16 = (const h16*)(p.ws + WS_R16); const h16* k16 = (const h16*)(p.ws + WS_K16);
    float* bonus = (float*)(p.ws + WS_BONUS);
    for (int item = gw; item < 2 * 384 * 16; item += NGW) {
        const int h = item & 15, rbg = (item >> 4) % 384, dir = item / (16 * 384);
        const int row0 = rbg * 16, row = row0 + (dir ? 15 - i : i);
        h16* dec = (h16*)(p.ws + WS_DEC16) + (size_t)dir * NTOK * D; h16* a16 = (h16*)(p.ws + WS_A16) + (size_t)dir * NTOK * D;
        float kv[16], rv[16], wv[16], av[16];
#pragma unroll
        for (int q = 0; q < 4; ++q) {
            const size_t o = (size_t)row * D + h * 64 + 16 * q + 4 * g;
            const h16x4 k4 = *(const h16x4*)(k16 + o), r4 = *(const h16x4*)(r16 + o), d4 = *(const h16x4*)(dec + o), a4 = *(const h16x4*)(a16 + o);
#pragma unroll
            for (int jj = 0; jj < 4; ++jj) { kv[4 * q + jj] = (float)k4[jj]; rv[4 * q + jj] = (float)r4[jj]; wv[4 * q + jj] = 1.f - (float)d4[jj]; av[4 * q + jj] = (float)a4[jj]; }
        }
        float kap[16], ss = 0.f;
#pragma unroll
        for (int q = 0; q < 4; ++q) {
            const f32x4 kkw = *(const f32x4*)(p.in[I_KKW] + h * 64 + 16 * q + 4 * g);
#pragma unroll
            for (int jj = 0; jj < 4; ++jj) { kap[4 * q + jj] = kv[4 * q + jj] * kkw[jj]; ss += kap[4 * q + jj] * kap[4 * q + jj]; }
        }
        ss = rowsum4(ss);
        const float rn = rsqrtf(ss + 1e-12f);
        float bon = 0.f;
        float beta[16], kt[16];
#pragma unroll
        for (int q = 0; q < 4; ++q) {
            const f32x4 ka4 = *(const f32x4*)(p.in[I_KA] + h * 64 + 16 * q + 4 * g), rk4 = *(const f32x4*)(p.in[I_RK] + h * 64 + 16 * q + 4 * g);
#pragma unroll
            for (int jj = 0; jj < 4; ++jj) {
                const int m = 4 * q + jj;
                kap[m] *= rn; beta[m] = kap[m] * av[m]; kt[m] = kv[m] * (1.f + (av[m] - 1.f) * ka4[jj]);
                bon += rv[m] * kt[m] * rk4[jj];
            }
        }
        bon = rowsum4(bon);
        if (g == 0) bonus[((size_t)dir * NTOK + row) * 16 + h] = bon;
        f32x4 A1 = {0.f, 0.f, 0.f, 0.f}, Lm = A1, N1 = A1, N2 = A1;
        h16 kapo[16], rho[16], kbo[16], bbo[16];
        float gcv[16];
#pragma unroll
        for (int m = 0; m < 16; ++m) {
            float G = wv[m];
            G *= dpp_row_shr1<1>(G); G *= dpp_row_shr1<2>(G); G *= dpp_row_shr1<4>(G); G *= dpp_row_shr1<8>(G);
            const float Gex = dpp_row_shr1<1>(G), GC = dpp_bcast15(G), rG = 1.f / G;
            const float kh = kap[m] * Gex, rh = rv[m] * G, k_h = kt[m] * rG, b_h = beta[m] * rG;
            A1 = __builtin_amdgcn_mfma_f32_16x16x4f32(k_h, kh, A1, 0, 0, 0);
            Lm = __builtin_amdgcn_mfma_f32_16x16x4f32(b_h, kh, Lm, 0, 0, 0);
            N1 = __builtin_amdgcn_mfma_f32_16x16x4f32(k_h, rh, N1, 0, 0, 0);
            N2 = __builtin_amdgcn_mfma_f32_16x16x4f32(b_h, rh, N2, 0, 0, 0);
            kapo[m] = (h16)kh; rho[m] = (h16)rh; kbo[m] = (h16)(k_h * GC); bbo[m] = (h16)(b_h * GC); gcv[m] = GC;
        }
#pragma unroll
        for (int r = 0; r < 4; ++r) { const int j = 4 * g + r; if (!(j < i)) { A1[r] = 0.f; Lm[r] = 0.f; } if (!(j <= i)) { N1[r] = 0.f; N2[r] = 0.f; } }
        LAS float* Lb = (LAS float*)(scr + 4096);
        *(LAS f32x4*)(Lb + i * 16 + 4 * g) = Lm;
        LAS h16* kbT = (LAS h16*)scr;
#pragma unroll
        for (int m = 0; m < 16; ++m) {
            const int f = m >> 2, kc = 4 * g + (m & 3);
            const int u = ((f * 16 + kc) * 4 + (i >> 2)) * 8 + (i & 3);
            kbT[u] = kbo[m]; kbT[u + 4] = bbo[m];
        }
        asm volatile("s_waitcnt lgkmcnt(0)" ::: "memory");
        float nL[16];
#pragma unroll
        for (int q = 0; q < 4; ++q) { const f32x4 v = *(const LAS f32x4*)(Lb + i * 16 + 4 * q); nL[4 * q] = -v[0]; nL[4 * q + 1] = -v[1]; nL[4 * q + 2] = -v[2]; nL[4 * q + 3] = -v[3]; }
        float Tm[4];
#pragma unroll
        for (int cc = 0; cc < 4; ++cc) Tm[cc] = (i == 4 * g + cc) ? 1.f : 0.f;
        asm volatile("s_nop 1" : "+v"(Tm[0]), "+v"(Tm[1]), "+v"(Tm[2]), "+v"(Tm[3]));
        TriSolve<0>::run(Tm, nL);
        unsigned char* item_o = p.ws + WS_OPS2 + (size_t)item * OPS2_ITEM;
        {
            h16x8 o;
#pragma unroll
            for (int s = 0; s < 2; ++s) {
#pragma unroll
                for (int e = 0; e < 8; ++e) o[e] = kapo[8 * s + e];
                *(h16x8*)(dec + (size_t)(row0 + i) * D + h * 64 + (g * 2 + s) * 8) = o;
#pragma unroll
                for (int e = 0; e < 8; ++e) o[e] = rho[8 * s + e];
                *(h16x8*)(a16 + (size_t)(row0 + i) * D + h * 64 + (g * 2 + s) * 8) = o;
            }
        }
#pragma unroll
        for (int q = 0; q < 4; ++q) *(u32x4*)(item_o + (q * 64 + lane) * 16) = *(const LAS u32x4*)(scr + (q * 64 + lane) * 16);
        *(h16x4*)(item_o + 4096 + (i * 4 + g) * 8) = cvt4(A1);
        { f32x4 t4 = {Tm[0], Tm[1], Tm[2], Tm[3]}; *(h16x4*)(item_o + 4608 + (i * 4 + g) * 8) = cvt4(t4); }
        { h16x8 o; for (int r = 0; r < 4; ++r) { o[r] = (h16)N1[r]; o[4 + r] = (h16)N2[r]; } *(h16x8*)(item_o + 5120 + (i * 4 + g) * 16) = o; }
        if (i == 0) {
#pragma unroll
            for (int q = 0; q < 4; ++q) *(f32x4*)(item_o + 6144 + (16 * q + 4 * g) * 4) = (f32x4){gcv[4 * q], gcv[4 * q + 1], gcv[4 * q + 2], gcv[4 * q + 3]};
        }
        asm volatile("s_waitcnt lgkmcnt(0)" ::: "memory");
    }
}

__device__ __forceinline__ void phase_rwkvpost(const Params& p, const Ctx& c) {
    const int gw = c.bid * NWAVES + c.wave, NGW = c.G * NWAVES, lane = c.lane;
    const h16* y16 = (const h16*)(p.ws + WS_Y16); const h16* v16 = (const h16*)(p.ws + WS_V16); const h16* g16 = (const h16*)(p.ws + WS_G16);
    const float* bonus = (const float*)(p.ws + WS_BONUS);
    h16* hA = (h16*)(p.ws + WS_HA);
    for (int row = gw; row < NTOK; row += NGW) {
        const int c0 = lane * 16;
        float y[16]; float s = 0.f;
#pragma unroll
        for (int e = 0; e < 2; ++e) {
            const h16x8 a = *(const h16x8*)(y16 + (size_t)row * D + c0 + 8 * e), b = *(const h16x8*)(y16 + ((size_t)NTOK + row) * D + c0 + 8 * e);
#pragma unroll
            for (int q = 0; q < 8; ++q) { y[8 * e + q] = (float)a[q] + (float)b[q]; s += y[8 * e + q]; }
        }
        s += __shfl_xor(s, 1); s += __shfl_xor(s, 2);
        const float mean = s * (1.f / 64.f);
        float vs = 0.f;
#pragma unroll
        for (int e = 0; e < 16; ++e) { y[e] -= mean; vs += y[e] * y[e]; }
        vs += __shfl_xor(vs, 1); vs += __shfl_xor(vs, 2);
        const float rstd = rsqrtf(vs * (1.f / 64.f) + 64e-5f);
        const float bon = bonus[row * 16 + (lane >> 2)] + bonus[((size_t)NTOK + row) * 16 + (lane >> 2)];
#pragma unroll
        for (int e = 0; e < 2; ++e) {
            const h16x8 vv = *(const h16x8*)(v16 + (size_t)row * D + c0 + 8 * e), gv = *(const h16x8*)(g16 + (size_t)row * D + c0 + 8 * e);
            h16x8 o;
#pragma unroll
            for (int q = 0; q < 8; ++q) {
                const int cc = c0 + 8 * e + q;
                const float yn = y[8 * e + q] * rstd * p.in[I_LNG][cc] + p.in[I_LNB][cc];
                o[q] = (h16)((yn + bon * (float)vv[q]) * (float)gv[q]);
            }
            *(h16x8*)(hA + (size_t)row * D + c0 + 8 * e) = o;
        }
    }
}

__device__ __forceinline__ void phase_final(const Params& p, const Ctx& c) {
    const int gw = c.bid * NWAVES + c.wave, NGW = c.G * NWAVES;
    const float* X = (const float*)(p.ws + WS_X);
    for (int row = gw; row < NTOK; row += NGW) {
        f32x4 v[4]; load_row(X + (size_t)row * D, c.lane, v);
        const float rstd = row_rstd(v);
#pragma unroll
        for (int j = 0; j < 4; ++j) {
            const int col = 256 * j + 4 * c.lane;
            *(f32x4*)(p.out + O_Y + (size_t)row * D + col) = v[j] * rstd * *(const f32x4*)(p.in[I_FNG] + col);
        }
    }
}

__device__ __forceinline__ void attn_unit(const Params& p, const Ctx& c, bool lat, int b, int kvh, int qb) {
    const int lane = c.lane, wave = c.wave, tid = c.tid;
    const int nkeys = lat ? 1280 : 256;
    const h16* Kg = lat ? (const h16*)(p.ws + WS_K16L) + (size_t)(b * 2 + kvh) * 1280 * 64 : (const h16*)(p.ws + WS_K16C) + (size_t)(b * 2 + kvh) * 256 * 64;
    const h16* Vg = lat ? (const h16*)(p.ws + WS_VT16L) + (size_t)(b * 2 + kvh) * 64 * 1280 : (const h16*)(p.ws + WS_VT16C) + (size_t)(b * 2 + kvh) * 64 * 256;
    const int row0 = (lat ? NCTX + b * 1024 : b * 256) + qb * 32 + (wave & 1) * 16;
    const int head = kvh * 4 + (wave >> 1);
    const int fr = lane & 15, fq = lane >> 4;
    const h16* q16 = (const h16*)(p.ws + WS_Q16);
    h16x8 qf[2];
#pragma unroll
    for (int s = 0; s < 2; ++s) qf[s] = *(const h16x8*)(q16 + (size_t)(row0 + fr) * 512 + head * 64 + s * 32 + fq * 8);
    LAS unsigned char* ldsK = c.lds; LAS unsigned char* ldsV = c.lds + 8192;
    float m = -1e30f, l = 0.f;
    f32x4 O[4];
#pragma unroll
    for (int f = 0; f < 4; ++f) O[f] = (f32x4){0.f, 0.f, 0.f, 0.f};
    const int srow = tid >> 3, sch = tid & 7;
    const int sdst = srow * 128 + ((sch ^ (srow & 7)) << 4);
    const int ntile = nkeys / 64;
    u32x4 kv = *(const u32x4*)(Kg + (size_t)srow * 64 + sch * 8);
    u32x4 vv = *(const u32x4*)(Vg + (size_t)srow * nkeys + sch * 8);
    for (int kt = 0; kt < ntile; ++kt) {
        __syncthreads();
        *(LAS u32x4*)(ldsK + sdst) = kv;
        *(LAS u32x4*)(ldsV + sdst) = vv;
        __syncthreads();
        if (kt + 1 < ntile) {
            kv = *(const u32x4*)(Kg + (size_t)((kt + 1) * 64 + srow) * 64 + sch * 8);
            vv = *(const u32x4*)(Vg + (size_t)srow * nkeys + (kt + 1) * 64 + sch * 8);
        }
        f32x4 sacc[4];
#pragma unroll
        for (int f = 0; f < 4; ++f) {
            sacc[f] = (f32x4){0.f, 0.f, 0.f, 0.f};
#pragma unroll
            for (int s = 0; s < 2; ++s) {
                const h16x8 kf = *(const LAS h16x8*)(ldsK + (f * 16 + fr) * 128 + (((s * 4 + fq) ^ (fr & 7)) << 4));
                sacc[f] = __builtin_amdgcn_mfma_f32_16x16x32_f16(kf, qf[s], sacc[f], 0, 0, 0);
            }
        }
        float mx = -1e30f;
#pragma unroll
        for (int f = 0; f < 4; ++f)
#pragma unroll
            for (int r = 0; r < 4; ++r) mx = fmaxf(mx, sacc[f][r]);
        mx = fmaxf(mx, __shfl_xor(mx, 16)); mx = fmaxf(mx, __shfl_xor(mx, 32));
        const float mn = fmaxf(m, mx);
        const float alpha = __expf(m - mn);
        m = mn;
        float ps = 0.f;
#pragma unroll
        for (int f = 0; f < 4; ++f)
#pragma unroll
            for (int r = 0; r < 4; ++r) { const float e = __expf(sacc[f][r] - mn); sacc[f][r] = e; ps += e; }
        l = l * alpha + ps;
#pragma unroll
        for (int f = 0; f < 4; ++f) O[f] *= alpha;
#pragma unroll
        for (int s2 = 0; s2 < 2; ++s2) {
            h16x8 pf;
#pragma unroll
            for (int r = 0; r < 4; ++r) { pf[r] = (h16)sacc[2 * s2][r]; pf[4 + r] = (h16)sacc[2 * s2 + 1][r]; }
#pragma unroll
            for (int fd = 0; fd < 4; ++fd) {
                const int d = fd * 16 + fr;
                const h16x4 lo = *(const LAS h16x4*)(ldsV + d * 128 + (((4 * s2 + (fq >> 1)) ^ (d & 7)) << 4) + (fq & 1) * 8);
                const h16x4 hi = *(const LAS h16x4*)(ldsV + d * 128 + (((4 * s2 + 2 + (fq >> 1)) ^ (d & 7)) << 4) + (fq & 1) * 8);
                h16x8 vf; vf[0] = lo[0]; vf[1] = lo[1]; vf[2] = lo[2]; vf[3] = lo[3]; vf[4] = hi[0]; vf[5] = hi[1]; vf[6] = hi[2]; vf[7] = hi[3];
                O[fd] = __builtin_amdgcn_mfma_f32_16x16x32_f16(vf, pf, O[fd], 0, 0, 0);
            }
        }
    }
    l += __shfl_xor(l, 16); l += __shfl_xor(l, 32);
    const float inv = 1.f / l;
    h16* cat = (h16*)(p.ws + WS_CAT);
#pragma unroll
    for (int fd = 0; fd < 4; ++fd)
        *(h16x4*)(cat + (size_t)(row0 + fr) * D + head * 64 + fd * 16 + 4 * fq) = cvt4(O[fd] * inv);
    __syncthreads();
}

__device__ __forceinline__ void ssd_unit(const Params& p, const Ctx& c, bool lat, int b, int h, int dir) {
    const int lane = c.lane, wave = c.wave, tid = c.tid;
    const int fr = lane & 15, fq = lane >> 4;
    const int T = lat ? 1024 : 256, rowbase = lat ? NCTX + b * 1024 : b * 256, grp = h >> 2;
    const float* xbc = (const float*)(p.ws + WS_XBC);
    const float* dtv = (const float*)(p.ws + WS_DT);
    float* ssdy = (float*)(p.ws + WS_SSDY) + (size_t)dir * NTOK * 512;
    const float Aneg = -__expf(p.in[I_ALOG][dir * 8 + h]);
    LAS unsigned char* Bn = c.lds; LAS unsigned char* Cn = c.lds + 16384; LAS unsigned char* xdtT = c.lds + 32768; LAS unsigned char* BdT = c.lds + 49152;
    LAS unsigned char* himg = c.lds + 65536; LAS float* acs = (LAS float*)(c.lds + 73728); LAS float* dtl = (LAS float*)(c.lds + 74240);
    const int fn = wave & 3, fp0 = 2 * (wave >> 2);
    f32x4 hst[2];
    const size_t sbase = (size_t)(b * 8 + h) * 4096;
#pragma unroll
    for (int e = 0; e < 2; ++e) {
        const int pp = 16 * (fp0 + e) + fr, n0 = 16 * fn + 4 * fq;
        hst[e] = lat ? *(const f32x4*)((dir ? p.in[I_SSDB] : p.in[I_SSDF]) + sbase + pp * 64 + n0) : (f32x4){0.f, 0.f, 0.f, 0.f};
    }
    __syncthreads();
#pragma unroll
    for (int e = 0; e < 2; ++e) {
        const int pp = 16 * (fp0 + e) + fr;
        *(LAS h16x4*)(himg + pp * 128 + (((2 * fn + (fq >> 1)) ^ (pp & 7)) << 4) + (fq & 1) * 8) = cvt4(hst[e]);
    }
    const int nchunk = T / 128;
    f32x4 pB[4], pC[4], pX[4]; float pd0 = 0.f, pd1 = 0.f;
    const int prow = tid >> 2, pq4 = tid & 3, pch = tid & 63, plb = tid >> 6;
    LAS unsigned char* Xn = c.lds + 75776;
#define SSD_PREFETCH(ck_) do { const int r0_ = dir ? rowbase + T - 1 - (ck_) * 128 : rowbase + (ck_) * 128, sg_ = dir ? -1 : 1; \
        const float* g_ = xbc + (size_t)(r0_ + sg_ * prow) * 768 + 16 * pq4; \
        _Pragma("unroll") for (int e_ = 0; e_ < 4; ++e_) { pB[e_] = *(const f32x4*)(g_ + 512 + grp * 64 + 4 * e_); pC[e_] = *(const f32x4*)(g_ + 640 + grp * 64 + 4 * e_); pX[e_] = *(const f32x4*)(g_ + h * 64 + 4 * e_); } \
        if (wave == 0) { pd0 = dtv[(r0_ + sg_ * (2 * lane)) * 16 + dir * 8 + h]; pd1 = dtv[(r0_ + sg_ * (2 * lane + 1)) * 16 + dir * 8 + h]; } } while (0)
    SSD_PREFETCH(0);
    for (int ck = 0; ck < nchunk; ++ck) {
        const int r0 = dir ? rowbase + T - 1 - ck * 128 : rowbase + ck * 128, sg = dir ? -1 : 1;
        if (wave == 0) {
            const float d0 = pd0, d1 = pd1;
            const float a0 = d0 * Aneg, a1 = d1 * Aneg;
            float s = a0 + a1;
#pragma unroll
            for (int o = 1; o < 64; o <<= 1) { const float t = __shfl_up(s, o); if (lane >= o) s += t; }
            const float ex = s - (a0 + a1);
            acs[2 * lane] = ex + a0; acs[2 * lane + 1] = ex + a0 + a1; dtl[2 * lane] = d0; dtl[2 * lane + 1] = d1;
        }
        {
            const int o0_ = prow * 128 + (((2 * pq4) ^ (prow & 7)) << 4), o1_ = prow * 128 + (((2 * pq4 + 1) ^ (prow & 7)) << 4);
            h16x8 o0, o1;
#pragma unroll
            for (int e = 0; e < 4; ++e) { o0[e] = (h16)pB[0][e]; o0[4 + e] = (h16)pB[1][e]; o1[e] = (h16)pB[2][e]; o1[4 + e] = (h16)pB[3][e]; }
            *(LAS h16x8*)(Bn + o0_) = o0; *(LAS h16x8*)(Bn + o1_) = o1;
#pragma unroll
            for (int e = 0; e < 4; ++e) { o0[e] = (h16)pC[0][e]; o0[4 + e] = (h16)pC[1][e]; o1[e] = (h16)pC[2][e]; o1[4 + e] = (h16)pC[3][e]; }
            *(LAS h16x8*)(Cn + o0_) = o0; *(LAS h16x8*)(Cn + o1_) = o1;
#pragma unroll
            for (int e = 0; e < 4; ++e) { o0[e] = (h16)pX[0][e]; o0[4 + e] = (h16)pX[1][e]; o1[e] = (h16)pX[2][e]; o1[4 + e] = (h16)pX[3][e]; }
            *(LAS h16x8*)(Xn + o0_) = o0; *(LAS h16x8*)(Xn + o1_) = o1;
        }
        __syncthreads();
        {
            const float aend = acs[127];
#pragma unroll 1
            for (int j = 0; j < 2; ++j) {
                const int l0 = 8 * plb + 64 * j;
                h16x8 ox, ob;
#pragma unroll
                for (int e = 0; e < 8; ++e) {
                    const int l = l0 + e, ad = l * 128 + (((pch >> 3) ^ (l & 7)) << 4) + (pch & 7) * 2;
                    ox[e] = (h16)((float)*(const LAS h16*)(Xn + ad) * dtl[l]);
                    ob[e] = (h16)((float)*(const LAS h16*)(Bn + ad) * __expf(aend - acs[l]));
                }
                const int off = pch * 256 + (((l0 >> 3) ^ (pch & 15)) << 4);
                *(LAS h16x8*)(xdtT + off) = ox; *(LAS h16x8*)(BdT + off) = ob;
            }
        }
        if (ck + 1 < nchunk) SSD_PREFETCH(ck + 1);
        __syncthreads();
        const int l = 16 * wave + fr;
        const float al = acs[l];
        f32x4 accy[4];
#pragma unroll
        for (int fd = 0; fd < 4; ++fd) accy[fd] = (f32x4){0.f, 0.f, 0.f, 0.f};
        h16x8 cf[2];
#pragma unroll
        for (int s2 = 0; s2 < 2; ++s2) cf[s2] = *(const LAS h16x8*)(Cn + l * 128 + (((4 * s2 + fq) ^ (l & 7)) << 4));
#pragma unroll
        for (int fd = 0; fd < 4; ++fd) {
            const int pp = 16 * fd + fr;
#pragma unroll
            for (int s2 = 0; s2 < 2; ++s2) {
                const h16x8 hf = *(const LAS h16x8*)(himg + pp * 128 + (((4 * s2 + fq) ^ (pp & 7)) << 4));
                accy[fd] = __builtin_amdgcn_mfma_f32_16x16x32_f16(hf, cf[s2], accy[fd], 0, 0, 0);
            }
        }
        {
            const float el = __expf(al);
#pragma unroll
            for (int fd = 0; fd < 4; ++fd) accy[fd] *= el;
        }
        for (int q = 0; 2 * q <= wave; ++q) {
            h16x8 pf;
#pragma unroll
            for (int e = 0; e < 2; ++e) {
                const int f = 2 * q + e;
                f32x4 sa = {0.f, 0.f, 0.f, 0.f};
                if (f <= wave) {
                    const int s = 16 * f + fr;
#pragma unroll
                    for (int s2 = 0; s2 < 2; ++s2) {
                        const h16x8 bf = *(const LAS h16x8*)(Bn + s * 128 + (((4 * s2 + fq) ^ (s & 7)) << 4));
                        sa = __builtin_amdgcn_mfma_f32_16x16x32_f16(bf, cf[s2], sa, 0, 0, 0);
                    }
                    const f32x4 as = *(const LAS f32x4*)(acs + 16 * f + 4 * fq);
#pragma unroll
                    for (int r = 0; r < 4; ++r) { const int ss = 16 * f + 4 * fq + r; sa[r] = (ss <= l) ? sa[r] * __expf(al - as[r]) : 0.f; }
                }
#pragma unroll
                for (int r = 0; r < 4; ++r) pf[4 * e + r] = (h16)sa[r];
            }
#pragma unroll
            for (int fd = 0; fd < 4; ++fd) {
                const int pp = 16 * fd + fr;
                const h16x4 lo = *(const LAS h16x4*)(xdtT + pp * 256 + (((4 * q + (fq >> 1)) ^ (pp & 15)) << 4) + (fq & 1) * 8);
                const h16x4 hi = *(const LAS h16x4*)(xdtT + pp * 256 + (((4 * q + 2 + (fq >> 1)) ^ (pp & 15)) << 4) + (fq & 1) * 8);
                h16x8 xf; xf[0] = lo[0]; xf[1] = lo[1]; xf[2] = lo[2]; xf[3] = lo[3]; xf[4] = hi[0]; xf[5] = hi[1]; xf[6] = hi[2]; xf[7] = hi[3];
                accy[fd] = __builtin_amdgcn_mfma_f32_16x16x32_f16(xf, pf, accy[fd], 0, 0, 0);
            }
        }
        {
            float* yo = ssdy + (size_t)(r0 + sg * l) * 512 + h * 64 + 4 * fq;
#pragma unroll
            for (int fd = 0; fd < 4; ++fd) *(f32x4*)(yo + 16 * fd) = accy[fd];
        }
        {
            const float cd = __expf(acs[127]);
            const int nn = 16 * fn + fr;
#pragma unroll
            for (int e = 0; e < 2; ++e) {
                const int pp = 16 * (fp0 + e) + fr;
                f32x4 st = {0.f, 0.f, 0.f, 0.f};
#pragma unroll
                for (int ks = 0; ks < 4; ++ks) {
                    const h16x8 bf = *(const LAS h16x8*)(BdT + nn * 256 + (((4 * ks + fq) ^ (nn & 15)) << 4));
                    const h16x8 xf = *(const LAS h16x8*)(xdtT + pp * 256 + (((4 * ks + fq) ^ (pp & 15)) << 4));
                    st = __builtin_amdgcn_mfma_f32_16x16x32_f16(bf, xf, st, 0, 0, 0);
                }
                hst[e] = hst[e] * cd + st;
            }
        }
        __syncthreads();
#pragma unroll
        for (int e = 0; e < 2; ++e) {
            const int pp = 16 * (fp0 + e) + fr;
            *(LAS h16x4*)(himg + pp * 128 + (((2 * fn + (fq >> 1)) ^ (pp & 7)) << 4) + (fq & 1) * 8) = cvt4(hst[e]);
        }
    }
#undef SSD_PREFETCH
    if (!lat) {
#pragma unroll
        for (int e = 0; e < 2; ++e) {
            const int pp = 16 * (fp0 + e) + fr, n0 = 16 * fn + 4 * fq;
            *(f32x4*)(p.out + (dir ? O_SSDB : O_SSDF) + sbase + pp * 64 + n0) = hst[e];
        }
    }
    __syncthreads();
}
__device__ __forceinline__ int next_unit(const Params& p, const Ctx& c, int q) {
    volatile LAS int* slot = (volatile LAS int*)(c.lds + LDS_MISC + 64);
    __syncthreads();
    if (c.tid == 0) *slot = (int)atomicAdd((unsigned*)(p.ws + WS_CTL) + 4096 + 64 * q, 1u);
    __syncthreads();
    return *slot;
}
__device__ __forceinline__ void phase_mix0(const Params& p, const Ctx& c, int q) {
    for (int u = next_unit(p, c, q); u < 672 + N_CONV_UNITS; u = next_unit(p, c, q)) {
        if (u >= 672) { if (q == 0) conv_unit(p, c, u - 672); continue; }
        if (u < 32) ssd_unit(p, c, true, u >> 4, (u >> 1) & 7, u & 1);
        else if (u < 160) { const int v = u - 32; attn_unit(p, c, true, v >> 6, (v >> 5) & 1, v & 31); }
        else if (u < 416) { const int v = u - 160; ssd_unit(p, c, false, v >> 4, (v >> 1) & 7, v & 1); }
        else { const int v = u - 416; attn_unit(p, c, false, v >> 4, (v >> 3) & 1, v & 7); }
    }
}

constexpr int RW_SLOT = 12544, RW_NS = 5, RW_PF = 4;
__device__ __forceinline__ void rwkv_unit(const Params& p, const Ctx& c, bool lat, int b, int h) {
    const int lane = c.lane, wave = c.wave;
    const int dir = wave >> 2, q = wave & 3, fr = lane & 15, g = lane >> 4;
    const int T = lat ? 1024 : 256, rowbase = lat ? NCTX + b * 1024 : b * 256, nchunk = T / 16;
    const unsigned char* kapg = p.ws + WS_DEC16 + (size_t)dir * NTOK * D * 2; const unsigned char* rhg = p.ws + WS_A16 + (size_t)dir * NTOK * D * 2;
    const unsigned char* vg = p.ws + WS_V16;
    h16* y16 = (h16*)(p.ws + WS_Y16) + (size_t)dir * NTOK * D;
    LAS unsigned char* ring = c.lds + dir * (RW_NS * RW_SLOT);
    f32x4 St[4];
    const size_t soff = ((size_t)(b * 16 + h) * 64 + 16 * q + fr) * 64 + 4 * g;
#pragma unroll
    for (int f = 0; f < 4; ++f) St[f] = lat ? *(const f32x4*)((dir ? p.in[I_RWB] : p.in[I_RWF]) + soff + 16 * f) : (f32x4){0.f, 0.f, 0.f, 0.f};
    const int e0 = q * 64 + lane;
    auto issue = [&](int ck) {
        const int rbg = (rowbase >> 4) + (dir ? nchunk - 1 - ck : ck), row0 = rbg * 16;
        LAS unsigned char* slot = ring + (ck % RW_NS) * RW_SLOT;
        const unsigned char* item = p.ws + WS_OPS2 + (size_t)((dir * 384 + rbg) * 16 + h) * OPS2_ITEM;
        {
            const int e = e0 & 127, t = e >> 3, pc = e & 7;
            const unsigned char* s_ = (e0 < 128 ? kapg : rhg) + ((size_t)(row0 + t) * D + h * 64) * 2 + pc * 16;
            __builtin_amdgcn_global_load_lds((const unsigned*)s_, (LAS unsigned*)(slot + q * 1024), 16, 0, 0);
        }
        __builtin_amdgcn_global_load_lds((const unsigned*)(item + e0 * 16), (LAS unsigned*)(slot + 4096 + q * 1024), 16, 0, 0);
        {
            const int e = e0;
            const unsigned char* s_;
            if (e < 144) s_ = item + 4096 + e * 16;
            else { const int ve = e - 144, t = ve >> 3, pc = ve & 7; s_ = vg + ((size_t)(row0 + (dir ? 15 - t : t)) * D + h * 64) * 2 + pc * 16; }
            __builtin_amdgcn_global_load_lds((const unsigned*)s_, (LAS unsigned*)(slot + 8192 + q * 1024), 16, 0, 0);
        }
        if (q == 0 && lane < 16) {
            const int ve = 112 + lane, t = ve >> 3, pc = ve & 7;
            const unsigned char* s_ = vg + ((size_t)(row0 + (dir ? 15 - t : t)) * D + h * 64) * 2 + pc * 16;
            __builtin_amdgcn_global_load_lds((const unsigned*)s_, (LAS unsigned*)(slot + 12288), 16, 0, 0);
        }
    };
    __syncthreads();
    for (int ck = 0; ck < RW_PF && ck < nchunk; ++ck) issue(ck);
    for (int ck = 0; ck < nchunk; ++ck) {
        if (ck + RW_PF > nchunk) asm volatile("s_waitcnt vmcnt(0)" ::: "memory");
        else if (q == 0) asm volatile("s_waitcnt vmcnt(12)" ::: "memory");
        else asm volatile("s_waitcnt vmcnt(9)" ::: "memory");
        asm volatile("s_waitcnt lgkmcnt(0)" ::: "memory");
        __builtin_amdgcn_s_barrier();
        asm volatile("" ::: "memory");
        if (ck + RW_PF < nchunk) issue(ck + RW_PF);
        const LAS unsigned char* slot = ring + (ck % RW_NS) * RW_SLOT;
        const int rbg = (rowbase >> 4) + (dir ? nchunk - 1 - ck : ck), row0 = rbg * 16;
        h16x8 Sh[2];
#pragma unroll
        for (int s = 0; s < 2; ++s)
#pragma unroll
            for (int r = 0; r < 4; ++r) { Sh[s][r] = (h16)St[2 * s][r]; Sh[s][4 + r] = (h16)St[2 * s + 1][r]; }
        const h16x8 ka0 = *(const LAS h16x8*)(slot + (fr * 4 + g) * 32), ka1 = *(const LAS h16x8*)(slot + (fr * 4 + g) * 32 + 16);
        const h16x8 rh0 = *(const LAS h16x8*)(slot + 2048 + (fr * 4 + g) * 32), rh1 = *(const LAS h16x8*)(slot + 2048 + (fr * 4 + g) * 32 + 16);
        const h16x4 a1 = *(const LAS h16x4*)(slot + 8192 + (fr * 4 + g) * 8), t4 = *(const LAS h16x4*)(slot + 8704 + (fr * 4 + g) * 8);
        const h16x8 nn = *(const LAS h16x8*)(slot + 9216 + (fr * 4 + g) * 16);
        h16x8 vu, a1op, top;
#pragma unroll
        for (int jj = 0; jj < 4; ++jj) {
            vu[jj] = *(const LAS h16*)(slot + 10496 + (4 * g + jj) * 128 + (16 * q + fr) * 2);
            a1op[jj] = a1[jj]; a1op[4 + jj] = (h16)0.f; top[jj] = t4[jj]; top[4 + jj] = (h16)0.f; vu[4 + jj] = (h16)0.f;
        }
        f32x4 X = {0.f, 0.f, 0.f, 0.f};
        X = __builtin_amdgcn_mfma_f32_16x16x32_f16(ka0, Sh[0], X, 0, 0, 0);
        X = __builtin_amdgcn_mfma_f32_16x16x32_f16(ka1, Sh[1], X, 0, 0, 0);
        X = __builtin_amdgcn_mfma_f32_16x16x32_f16(a1op, vu, X, 0, 0, 0);
        h16x8 xo;
#pragma unroll
        for (int r = 0; r < 4; ++r) { xo[r] = (h16)X[r]; xo[4 + r] = (h16)0.f; }
        f32x4 U = {0.f, 0.f, 0.f, 0.f};
        U = __builtin_amdgcn_mfma_f32_16x16x32_f16(top, xo, U, 0, 0, 0);
#pragma unroll
        for (int r = 0; r < 4; ++r) vu[4 + r] = (h16)(-U[r]);
        f32x4 Y = {0.f, 0.f, 0.f, 0.f};
        Y = __builtin_amdgcn_mfma_f32_16x16x32_f16(rh0, Sh[0], Y, 0, 0, 0);
        Y = __builtin_amdgcn_mfma_f32_16x16x32_f16(rh1, Sh[1], Y, 0, 0, 0);
        Y = __builtin_amdgcn_mfma_f32_16x16x32_f16(nn, vu, Y, 0, 0, 0);
#pragma unroll
        for (int f = 0; f < 4; ++f) {
            const f32x4 gc = *(const LAS f32x4*)(slot + 10240 + (16 * f + 4 * g) * 4);
            const h16x8 kb = *(const LAS h16x8*)(slot + 4096 + ((f * 16 + fr) * 4 + g) * 16);
            St[f] = __builtin_amdgcn_mfma_f32_16x16x32_f16(kb, vu, St[f] * gc, 0, 0, 0);
        }
#pragma unroll
        for (int r = 0; r < 4; ++r) { const int t = 4 * g + r; y16[(size_t)(row0 + (dir ? 15 - t : t)) * D + h * 64 + 16 * q + fr] = (h16)Y[r]; }
    }
    if (!lat) {
#pragma unroll
        for (int f = 0; f < 4; ++f) *(f32x4*)(p.out + (dir ? O_RWB : O_RWF) + soff + 16 * f) = St[f];
    }
    asm volatile("s_waitcnt vmcnt(0) lgkmcnt(0)" ::: "memory");
    __syncthreads();
}
__device__ __forceinline__ void phase_rwkvscan(const Params& p, const Ctx& c, int qn) {
    for (int u = next_unit(p, c, qn); u < 288; u = next_unit(p, c, qn)) {
        if (u < 32) rwkv_unit(p, c, true, u >> 4, u & 15);
        else { const int v = u - 32; rwkv_unit(p, c, false, v >> 4, v & 15); }
    }
}

__device__ __forceinline__ const float* ada_chunk(const Params& p, int layer, int row, int chunk) {
    return (const float*)(p.ws + WS_ADA) + (size_t)(layer * 3 + stream_of(row)) * 6144 + chunk * 1024;
}
__device__ __forceinline__ void phase_gemm_inproj(const Params& p, const Ctx& c) {
    float* proj = (float*)(p.ws + WS_PROJ);
    const float* rc = (const float*)(p.ws + WS_ROPE); const float* rs = rc + 32768;
    const int fr = c.lane & 15, fq = c.lane >> 4, wm = c.wave >> 1, wn = c.wave & 1;
    for (int u = c.bid; u < 24 * 17; u += c.G) {
        const int pm = u % 24, pn = u / 24;
        GemmTile g{(const h16*)(p.ws + WS_HA), D, (const h16*)(p.ws + WS_WIN), D, D, pm * 256, pn * 128};
        f32x4 acc[4][4]; gemm_tile<256>(c, g, acc);
        if (pn >= 6) {
#pragma unroll
            for (int i = 0; i < 4; ++i)
#pragma unroll
                for (int j = 0; j < 4; ++j)
                    *(f32x4*)(proj + (size_t)(g.m0 + wm * 64 + 16 * i + fr) * PROJ_LD + g.n0 + wn * 64 + 16 * j + 4 * fq) = acc[i][j];
            continue;
        }
#pragma unroll
        for (int i = 0; i < 4; ++i) {
            const int row = g.m0 + wm * 64 + 16 * i + fr;
            const bool lat = row >= NCTX;
            const int r2 = lat ? row - NCTX : row;
            const int b = lat ? (r2 >> 10) : (r2 >> 8), t = lat ? (r2 & 1023) : (r2 & 255);
            if (pn < 5) {
                float ss = 0.f;
#pragma unroll
                for (int j = 0; j < 4; ++j) ss += acc[i][j][0] * acc[i][j][0] + acc[i][j][1] * acc[i][j][1] + acc[i][j][2] * acc[i][j][2] + acc[i][j][3] * acc[i][j][3];
                ss = rowsum4(ss);
                const float rstd = rsqrtf(ss * (1.f / 64.f) + 1e-6f);
                const float* gw_ = (pn < 4) ? p.in[I_QG] : p.in[I_KG];
                f32x4 xn[4];
#pragma unroll
                for (int j = 0; j < 4; ++j) xn[j] = acc[i][j] * rstd * *(const f32x4*)(gw_ + 16 * j + 4 * fq);
                if (lat) {
#pragma unroll
                    for (int j = 0; j < 2; ++j) {
                        const f32x4 cs = *(const f32x4*)(rc + t * 32 + 16 * j + 4 * fq), sn = *(const f32x4*)(rs + t * 32 + 16 * j + 4 * fq);
                        const f32x4 x1 = xn[j], x2 = xn[j + 2];
                        xn[j] = x1 * cs - x2 * sn; xn[j + 2] = x1 * sn + x2 * cs;
                    }
                }
                if (pn < 4) {
                    h16* q16 = (h16*)(p.ws + WS_Q16) + (size_t)row * 512 + (2 * pn + wn) * 64 + 4 * fq;
#pragma unroll
                    for (int j = 0; j < 4; ++j) *(h16x4*)(q16 + 16 * j) = cvt4(xn[j] * 0.125f);
                } else {
                    h16* kd = lat ? (h16*)(p.ws + WS_K16L) + ((size_t)(b * 2 + wn) * 1280 + 256 + t) * 64 + 4 * fq
                                  : (h16*)(p.ws + WS_K16C) + ((size_t)(b * 2 + wn) * 256 + t) * 64 + 4 * fq;
#pragma unroll
                    for (int j = 0; j < 4; ++j) {
                        *(h16x4*)(kd + 16 * j) = cvt4(xn[j]);
                        if (!lat) *(f32x4*)(p.out + O_K + (size_t)row * 128 + wn * 64 + 16 * j + 4 * fq) = xn[j];
                    }
                }
            } else {
                h16* vt = lat ? (h16*)(p.ws + WS_VT16L) + (size_t)(b * 2 + wn) * 64 * 1280 + 256 + t
                              : (h16*)(p.ws + WS_VT16C) + (size_t)(b * 2 + wn) * 64 * 256 + t;
                const int ld = lat ? 1280 : 256;
#pragma unroll
                for (int j = 0; j < 4; ++j) {
#pragma unroll
                    for (int r = 0; r < 4; ++r) vt[(size_t)(16 * j + 4 * fq + r) * ld] = (h16)acc[i][j][r];
                    if (!lat) *(f32x4*)(p.out + O_V + (size_t)row * 128 + wn * 64 + 16 * j + 4 * fq) = acc[i][j];
                }
            }
        }
    }
}
__device__ __forceinline__ void phase_gemm_res(const Params& p, const Ctx& c, const h16* A, int lda, const h16* Bt, int K, int layer, int gate_chunk, bool init, bool dry, bool ffn_pre) {
    float* X = (float*)(p.ws + WS_X);
    float* Xw = dry ? (float*)(p.ws + WS_PROJ) : X;
    const int fr = c.lane & 15, fq = c.lane >> 4, wm = c.wave >> 1, wn = c.wave & 1;
    for (int u = c.bid; u < 32 * 8; u += c.G) {
        const int pm = u & 31, pn = u >> 5;
        GemmTile g{A, lda, Bt, K, K, pm * 192, pn * 128};
        f32x4 acc[3][4]; gemm_tile<192>(c, g, acc);
#pragma unroll
        for (int i = 0; i < 3; ++i) {
            const int row = g.m0 + wm * 48 + 16 * i + fr;
            const float* gt = ada_chunk(p, layer, row, gate_chunk);
            const float* base = init ? xin_row(p, row) : X + (size_t)row * D;
            float ss = 0.f;
            const float* scp = ada_chunk(p, layer, row, 4);
#pragma unroll
            for (int j = 0; j < 4; ++j) {
                const int col = g.n0 + wn * 64 + 16 * j + 4 * fq;
                const f32x4 xn = *(const f32x4*)(base + col) + *(const f32x4*)(gt + col) * acc[i][j];
                *(f32x4*)(Xw + (size_t)row * D + col) = xn;
                if (ffn_pre) {
                    ss += xn[0] * xn[0] + xn[1] * xn[1] + xn[2] * xn[2] + xn[3] * xn[3];
                    const f32x4 pre = xn * *(const f32x4*)(p.in[I_NFG] + layer * 1024 + col) * (*(const f32x4*)(scp + col) + 1.f);
                    *(h16x4*)((h16*)(p.ws + (layer ? WS_XMIX : WS_HA)) + (size_t)row * D + col) = cvt4(pre);
                }
            }
            if (ffn_pre) { ss = rowsum4(ss); if (fq == 0 && !dry) atomicAdd((float*)(p.ws + WS_ROWSS) + layer * NTOK + row, ss); }
        }
    }
}
__device__ __forceinline__ void phase_gemm_gu(const Params& p, const Ctx& c, int layer) {
    h16* hid = (h16*)(p.ws + WS_HID);
    const int fr = c.lane & 15, fq = c.lane >> 4, wm = c.wave >> 1, wn = c.wave & 1;
    for (int u = c.bid; u < 24 * 44; u += c.G) {
        const int pm = u % 24, pn = u / 24;
        GemmTile g{(const h16*)(p.ws + (layer ? WS_XMIX : WS_HA)), D, (const h16*)(p.ws + WS_WGU) + (size_t)layer * 5632 * 1024, D, D, pm * 256, pn * 128};
        f32x4 acc[4][4]; gemm_tile<256>(c, g, acc);
        const int hc0 = (g.n0 + wn * 64) / 2 + 4 * fq, nb0 = g.n0 + wn * 64 + 4 * fq;
#pragma unroll
        for (int i = 0; i < 4; ++i) {
            const int row = g.m0 + wm * 64 + 16 * i + fr;
            const float rstd = rsqrtf(((const float*)(p.ws + WS_ROWSS))[layer * NTOK + row] * (1.f / 1024.f) + 1e-6f);
            const float* fb = (const float*)(p.ws + WS_FBIAS) + (size_t)(layer * 3 + stream_of(row)) * 5632 + nb0;
#pragma unroll
            for (int j = 0; j < 2; ++j) {
                const f32x4 bg = *(const f32x4*)(fb + 16 * j), bu = *(const f32x4*)(fb + 16 * (j + 2));
                f32x4 o;
#pragma unroll
                for (int r = 0; r < 4; ++r) o[r] = silu_f(acc[i][j][r] * rstd + bg[r]) * (acc[i][j + 2][r] * rstd + bu[r]);
                *(h16x4*)(hid + (size_t)row * FF + hc0 + 16 * j) = cvt4(o);
            }
        }
    }
}
__device__ __forceinline__ void phase_gemm_rkv(const Params& p, const Ctx& c) {
    h16* lora = (h16*)(p.ws + WS_LORA16);
    const h16* xm = (const h16*)(p.ws + WS_XMIX);
    const int fr = c.lane & 15, fq = c.lane >> 4, wm = c.wave >> 1, wn = c.wave & 1;
    for (int u = c.bid; u < 24 * 27; u += c.G) {
        const int pm = u % 24, pn = u / 24;
        const int ai = pn < 8 ? 0 : pn < 16 ? 2 : pn < 24 ? 3 : pn == 24 ? 1 : pn == 25 ? 4 : 5;
        GemmTile g{xm + (size_t)ai * NTOK * D, D, (const h16*)(p.ws + WS_WRKV), D, D, pm * 256, pn * 128};
        f32x4 acc[4][4]; gemm_tile<256>(c, g, acc);
#pragma unroll
        for (int i = 0; i < 4; ++i) {
            const int row = g.m0 + wm * 64 + 16 * i + fr;
#pragma unroll
            for (int j = 0; j < 4; ++j) {
                const int col = g.n0 + wn * 64 + 16 * j + 4 * fq;
                f32x4 v = acc[i][j];
                if (pn < 24) *(h16x4*)((h16*)(p.ws + (pn < 8 ? WS_R16 : pn < 16 ? WS_K16 : WS_V16)) + (size_t)row * D + (col & 1023)) = cvt4(v);
                else {
                    if (pn == 24) { for (int r = 0; r < 4; ++r) v[r] = 2.f * sigmoid_f(2.f * v[r]) - 1.f; }
                    else if (pn == 26) { for (int r = 0; r < 4; ++r) v[r] = sigmoid_f(v[r]); }
                    *(h16x4*)(lora + (size_t)row * 384 + col - 3072) = cvt4(v);
                }
            }
        }
    }
}
__device__ __forceinline__ void phase_gemm_lora2(const Params& p, const Ctx& c) {
    const h16* lora = (const h16*)(p.ws + WS_LORA16);
    h16* dec16 = (h16*)(p.ws + WS_DEC16); h16* a16 = (h16*)(p.ws + WS_A16); h16* g16 = (h16*)(p.ws + WS_G16);
    const int fr = c.lane & 15, fq = c.lane >> 4, wm = c.wave >> 1, wn = c.wave & 1;
    for (int u = c.bid; u < 24 * 40; u += c.G) {
        const int pm = u % 24, pn = u / 24, gq = pn >> 3, n0 = (pn & 7) * 128;
        const int K = gq < 4 ? 64 : 128;
        const h16* A = lora + (gq < 2 ? 64 * gq : gq < 4 ? 128 + 64 * (gq - 2) : 256);
        const h16* Bt = gq < 2 ? (const h16*)(p.ws + WS_W2T) + (size_t)gq * 65536 : gq < 4 ? (const h16*)(p.ws + WS_A2T) + (size_t)(gq - 2) * 65536 : (const h16*)(p.ws + WS_G2T);
        GemmTile g{A, 384, Bt, K, K, pm * 256, n0};
        f32x4 acc[4][4]; gemm_tile<256>(c, g, acc);
#pragma unroll
        for (int i = 0; i < 4; ++i) {
            const int row = g.m0 + wm * 64 + 16 * i + fr;
#pragma unroll
            for (int j = 0; j < 4; ++j) {
                const int col = n0 + wn * 64 + 16 * j + 4 * fq;
                f32x4 v = acc[i][j];
                if (gq < 2) {
                    const f32x4 w0 = *(const f32x4*)(p.in[I_W0] + gq * 1024 + col);
                    for (int r = 0; r < 4; ++r) { const float wl = w0[r] + v[r]; const float uu = 0.60653066f * sigmoid_f(wl); v[r] = 1.f - __expf(-uu); }
                    *(h16x4*)(dec16 + ((size_t)gq * NTOK + row) * D + col) = cvt4(v);
                } else if (gq < 4) {
                    const f32x4 a0 = *(const f32x4*)(p.in[I_A0] + (gq - 2) * 1024 + col);
                    for (int r = 0; r < 4; ++r) v[r] = sigmoid_f(a0[r] + v[r]);
                    *(h16x4*)(a16 + ((size_t)(gq - 2) * NTOK + row) * D + col) = cvt4(v);
                } else *(h16x4*)(g16 + (size_t)row * D + col) = cvt4(v);
            }
        }
    }
}

#ifdef ONLY_PHASE
#define PH_ON(k) ((k) == ONLY_PHASE)
#else
#define PH_ON(k) true
#endif
#ifndef REP_MASK
#define REP_MASK 0u
#endif
#define NREP(k) (((REP_MASK >> (k)) & 1u) ? 2 : 1)
#define PHASE(k, call) do { if (PH_ON(k) && lo <= (k) && (k) < hi) { _Pragma("unroll") for (int rep = NREP(k) - 1; rep >= 0; --rep) { const bool dry = rep > 0; (void)dry; call; if ((k) + 1 < hi || dry) xcd_barrier(bar); } } } while (0)

__global__ void __launch_bounds__(NTHREADS, 2) mk_fwd(Params p) {
    extern __shared__ __attribute__((aligned(16))) unsigned char lds_raw[];
    Ctx c;
    c.lds = (LAS unsigned char*)lds_raw;
    c.tid = threadIdx.x; c.lane = c.tid & 63; c.wave = __builtin_amdgcn_readfirstlane(c.tid >> 6);
    c.bid = blockIdx.x; c.G = gridDim.x;
    volatile LAS unsigned* misc = (volatile LAS unsigned*)(c.lds + LDS_MISC);
    if (c.tid < 64) misc[c.tid] = 0u;
    __syncthreads();
    const int lo = p.ph_lo, hi = p.ph_hi;
    XcdBarrier bar; bar.bar = (unsigned*)(p.ws + WS_CTL); bar.x = 0; bar.st = nullptr;
    if (hi - lo > 1) bar = xcd_barrier_post((unsigned*)(p.ws + WS_CTL), misc + 8);
    PHASE(0, phase0(p, c));
    PHASE(1, phase_normmod(p, c, true, p.in[I_NMG], 0, 0, 1));
    PHASE(2, phase_gemm_inproj(p, c));
    PHASE(3, phase_postproj(p, c));
    PHASE(4, phase_mix0(p, c, dry ? 2 : 0));
    PHASE(5, phase_ssdcombine(p, c));
    PHASE(6, phase_gemm_res(p, c, (const h16*)(p.ws + WS_CAT), D, (const h16*)(p.ws + WS_WOUT), D, 0, 2, true, dry, true));
    PHASE(8, phase_gemm_gu(p, c, 0));
    PHASE(9, phase_gemm_res(p, c, (const h16*)(p.ws + WS_HID), FF, (const h16*)(p.ws + WS_WDN), FF, 0, 5, false, dry, false));
    PHASE(10, phase_rwkvmix(p, c));
    PHASE(11, phase_gemm_rkv(p, c));
    PHASE(12, phase_gemm_lora2(p, c));
    PHASE(13, phase_rwkvprep(p, c));
    PHASE(14, phase_rwkvscan(p, c, dry ? 3 : 1));
    PHASE(15, phase_rwkvpost(p, c));
    PHASE(16, phase_gemm_res(p, c, (const h16*)(p.ws + WS_HA), D, (const h16*)(p.ws + WS_WO), D, 1, 2, false, dry, true));
    PHASE(18, phase_gemm_gu(p, c, 1));
    PHASE(19, phase_gemm_res(p, c, (const h16*)(p.ws + WS_HID), FF, (const h16*)(p.ws + WS_WDN) + (size_t)1024 * 2816, FF, 1, 5, false, dry, false));
    PHASE(20, phase_final(p, c));
}

extern "C" void kernel_launch(void* const* d_in, const int* in_sizes, int n_in, void* d_out, int out_size, void* d_ws, size_t ws_size, hipStream_t stream) {
    static int grid = 0;
    if (grid == 0) {
        if (n_in != 46 || ws_size < WS_END) { fprintf(stderr, "kernel_launch: unexpected n_in %d or ws_size %zu\n", n_in, ws_size); grid = -1; return; }
        int dev = 0, cus = 0, per_cu = 0;
        (void)hipGetDevice(&dev);
        (void)hipDeviceGetAttribute(&cus, hipDeviceAttributeMultiprocessorCount, dev);
        if (hipFuncSetAttribute((const void*)mk_fwd, hipFuncAttributeMaxDynamicSharedMemorySize, LDS_BYTES) != hipSuccess) { fprintf(stderr, "kernel_launch: hipFuncSetAttribute failed\n"); grid = -1; return; }
        if (hipOccupancyMaxActiveBlocksPerMultiprocessor(&per_cu, (const void*)mk_fwd, NTHREADS, LDS_BYTES) != hipSuccess || per_cu < 1) { fprintf(stderr, "kernel_launch: occupancy query says %d\n", per_cu); }
        (void)hipGetLastError();
        grid = cus;
    }
    if (grid < 0) return;
    (void)hipMemsetAsync((char*)d_ws + WS_CTL, 0, CTL_ZERO_BYTES, stream);
    Params p{};
    for (int i = 0; i < 46; ++i) p.in[i] = (const float*)d_in[i];
    p.out = (float*)d_out; p.ws = (unsigned char*)d_ws;
#if MK_N_LAUNCHES == 1
    p.ph_lo = 0; p.ph_hi = NPH;
    hipLaunchKernelGGL(mk_fwd, dim3(grid), dim3(NTHREADS), LDS_BYTES, stream, p);
#else
    for (int ph = 0; ph < NPH; ++ph) { p.ph_lo = ph; p.ph_hi = ph + 1; hipLaunchKernelGGL(mk_fwd, dim3(grid), dim3(NTHREADS), LDS_BYTES, stream, p); }
#endif
}
```

```cpp
#include <hip/hip_runtime.h>
#include <cstdio>
#include <cstdint>

#ifndef MK_N_LAUNCHES
#define MK_N_LAUNCHES 1
#endif

#define LAS __attribute__((address_space(3)))
#define GAS __attribute__((address_space(1)))
typedef _Float16 h16;
typedef _Float16 h16x2 __attribute__((ext_vector_type(2)));
typedef _Float16 h16x4 __attribute__((ext_vector_type(4)));
typedef _Float16 h16x8 __attribute__((ext_vector_type(8)));
typedef float f32x4 __attribute__((ext_vector_type(4)));
typedef float f32x2 __attribute__((ext_vector_type(2)));
typedef unsigned u32x4 __attribute__((ext_vector_type(4)));

constexpr int D = 1024, NTOK = 6144, NCTX = 4096, FF = 2816;
constexpr int PROJ_LD = 2176;
constexpr int NPH = 21;
constexpr int NWAVES = 8, NTHREADS = 512;

constexpr size_t MiB = 1u << 20;
constexpr size_t WS_CTL = 0, CTL_ZERO_BYTES = 32768;
constexpr size_t WS_WIN = 1 * MiB;
constexpr size_t WS_WOUT = 6 * MiB;
constexpr size_t WS_WGU = 8 * MiB;
constexpr size_t WS_WDN = 30 * MiB;
constexpr size_t WS_WRKV = 41 * MiB;
constexpr size_t WS_WO = 48 * MiB;
constexpr size_t WS_W2T = 50 * MiB;
constexpr size_t WS_A2T = WS_W2T + 262144;
constexpr size_t WS_G2T = WS_A2T + 262144;
constexpr size_t WS_ADA = 51 * MiB;
constexpr size_t WS_ROPE = WS_ADA + 262144;
constexpr size_t WS_ROWSS = WS_ADA + 524288;
constexpr size_t WS_FBIAS = WS_ADA + 589824;
constexpr size_t WS_X = 52 * MiB;
constexpr size_t WS_HA = 76 * MiB;
constexpr size_t WS_HID = 88 * MiB;
constexpr size_t WS_PROJ = 121 * MiB;
constexpr size_t WS_Q16 = 172 * MiB;
constexpr size_t WS_K16C = 178 * MiB;
constexpr size_t WS_VT16C = 179 * MiB;
constexpr size_t WS_K16L = 180 * MiB;
constexpr size_t WS_VT16L = 181 * MiB;
constexpr size_t WS_CAT = 182 * MiB;
constexpr size_t WS_XBC = 194 * MiB;
constexpr size_t WS_DT = 212 * MiB;
constexpr size_t WS_DA = WS_DT + 6144 * 16 * 4;
constexpr size_t WS_SSDY = 213 * MiB;
constexpr size_t WS_G16 = 1 * MiB;
constexpr size_t WS_BONUS = 13 * MiB;
constexpr size_t WS_LORA16 = 76 * MiB;
constexpr size_t WS_R16 = 88 * MiB;
constexpr size_t WS_K16 = 100 * MiB;
constexpr size_t WS_Y16 = 88 * MiB;
constexpr size_t WS_V16 = 112 * MiB;
constexpr size_t WS_XMIX = 124 * MiB;
constexpr size_t WS_DEC16 = 124 * MiB;
constexpr size_t WS_A16 = 148 * MiB;
constexpr size_t WS_OPS2 = 172 * MiB;
constexpr size_t OPS2_ITEM = 6400;
constexpr size_t WS_END = 256 * MiB;

constexpr size_t O_Y = 0, O_K = 6291456, O_V = 6815744, O_SSDF = 7340032, O_SSDB = 7864320, O_RWF = 8388608, O_RWB = 9437184;

constexpr int LDS_BYTES = 148480;
constexpr int LDS_MISC = 147456;

struct Params {
    const float* in[46];
    float* out;
    unsigned char* ws;
    int ph_lo, ph_hi;
};
enum { I_XP = 0, I_XS, I_CK, I_CV, I_SSDF, I_SSDB, I_RWF, I_RWB, I_C, I_CCTX, I_MODW, I_MODB, I_NMG, I_NFG, I_WG, I_WU, I_WD,
       I_WIN, I_WOUT, I_QG, I_KG, I_CONVW, I_CONVB, I_DTB, I_ALOG, I_SSDD, I_SSDG, I_MU, I_WR, I_WK, I_WV, I_W0, I_W1, I_W2,
       I_A0, I_A1, I_A2, I_G1, I_G2, I_KKW, I_KA, I_RK, I_LNG, I_LNB, I_WO, I_FNG };

struct Ctx { int tid, lane, wave, bid, G; LAS unsigned char* lds; };

__device__ __forceinline__ float wave_sum(float v) {
#pragma unroll
    for (int o = 1; o < 64; o <<= 1) v += __shfl_xor(v, o);
    return v;
}
__device__ __forceinline__ float sigmoid_f(float x) { return __builtin_amdgcn_rcpf(1.f + __expf(-x)); }
__device__ __forceinline__ float silu_f(float x) { return x * sigmoid_f(x); }
__device__ __forceinline__ float softplus_f(float x) { return fmaxf(x, 0.f) + log1pf(__expf(-fabsf(x))); }
__device__ __forceinline__ int stream_of(int row) { return row < NCTX ? 0 : 1 + ((row - NCTX) >> 10); }
__device__ __forceinline__ h16x4 cvt4(f32x4 v) { h16x4 o; o.x = (h16)v.x; o.y = (h16)v.y; o.z = (h16)v.z; o.w = (h16)v.w; return o; }

template <int M> __device__ __forceinline__ void fmac_bc(float& d, float a, float b) {
    asm("v_fmac_f32_dpp %0, %1, %2 row_newbcast:%3 row_mask:0xf bank_mask:0xf" : "+v"(d) : "v"(a), "v"(b), "n"(M));
}
template <int M> __device__ __forceinline__ void fmac_bc_safe(float& d, float a, float b) {
    asm volatile("s_nop 1\n\tv_fmac_f32_dpp %0, %1, %2 row_newbcast:%3 row_mask:0xf bank_mask:0xf\n\ts_nop 1" : "+v"(d) : "v"(a), "v"(b), "n"(M));
}
template <int M> __device__ __forceinline__ void mul_bc(float& d, float a) {
    asm("v_mul_f32_dpp %0, %1, %0 row_newbcast:%2 row_mask:0xf bank_mask:0xf" : "+v"(d) : "v"(a), "n"(M));
}
__device__ __forceinline__ float rowsum4(float x) {
    float a = x, b = x;
    asm volatile("s_nop 1\n\tv_permlane16_swap_b32 %0, %1\n\ts_nop 1" : "+v"(a), "+v"(b));
    x = a + b; a = x; b = x;
    asm volatile("s_nop 1\n\tv_permlane32_swap_b32 %0, %1\n\ts_nop 1" : "+v"(a), "+v"(b));
    return a + b;
}

#define XB_TMO      128
#define XB_XCNT(j)  (256  + 64 * (j))
#define XB_XSUB(j)  (1280 + 64 * (j))
#define XB_XGEN(j)  (2304 + 64 * (j))
#define XB_TOP      3328
#define XB_TOPGEN   3392
#define XCD_BAR_WORDS 3456
#define XB_SPIN_CAP (1u << 22)
__device__ __forceinline__ unsigned xb_ld(unsigned* p)              { return __hip_atomic_load(p, __ATOMIC_RELAXED, __HIP_MEMORY_SCOPE_AGENT); }
__device__ __forceinline__ unsigned xb_add(unsigned* p, unsigned v) { return __hip_atomic_fetch_add(p, v, __ATOMIC_RELAXED, __HIP_MEMORY_SCOPE_AGENT); }
__device__ __forceinline__ unsigned xb_xcc_id() { return (unsigned)__builtin_amdgcn_s_getreg((3 << 11) | 20) & 0xFu; }
#define XB_SPIN(cond, bar) do { unsigned _sp = 0; while (cond) { __builtin_amdgcn_s_sleep(1); \
    if ((++_sp & 255u) == 0u) { if (xb_ld(&(bar)[XB_TMO])) break; if (_sp > XB_SPIN_CAP) { atomicAdd(&(bar)[XB_TMO], 1u); break; } } } } while (0)
struct XcdBarrier { unsigned* bar; unsigned x; volatile LAS unsigned* st; };
__device__ __forceinline__ XcdBarrier xcd_barrier_post(unsigned* bar, volatile LAS unsigned* st) {
    XcdBarrier b; b.bar = bar; b.x = xb_xcc_id(); b.st = st;
    if (threadIdx.x == 0) (void)xb_add(&bar[XB_XCNT(b.x)], 1u);
    return b;
}
__device__ __forceinline__ void xcd_barrier_complete(unsigned* bar, unsigned x, unsigned& nloc, unsigned& nx) {
    const unsigned G = gridDim.x * gridDim.y * gridDim.z;
    unsigned sum, cnt, mine, sp = 0u;
    for (;;) {
        sum = 0u; cnt = 0u; mine = 0u;
#pragma unroll
        for (unsigned j = 0; j < 16; ++j) { const unsigned c = xb_ld(&bar[XB_XCNT(j)]); sum += c; cnt += (c > 0u) ? 1u : 0u; mine = (j == x) ? c : mine; }
        if (sum == G) break;
        __builtin_amdgcn_s_sleep(1);
        if ((++sp & 255u) == 0u) { if (xb_ld(&bar[XB_TMO])) break; if (sp > XB_SPIN_CAP) { atomicAdd(&bar[XB_TMO], 1u); break; } }
    }
    nloc = mine > 0u ? mine : 1u; nx = cnt > 0u ? cnt : 1u;
}
__device__ __forceinline__ void xcd_barrier(const XcdBarrier& b) {
    asm volatile("s_waitcnt vmcnt(0)" ::: "memory");
    __syncthreads();
    if (threadIdx.x == 0) {
        unsigned* bar = b.bar;
        __builtin_amdgcn_s_waitcnt(0);
        unsigned nloc = b.st[0], nx = b.st[1];
        if (nloc == 0u) { xcd_barrier_complete(bar, b.x, nloc, nx); b.st[0] = nloc; b.st[1] = nx; }
        const unsigned old = xb_add(&bar[XB_XSUB(b.x)], 1u);
        const unsigned gen = old / nloc;
        if (old + 1u == (gen + 1u) * nloc) {
            __builtin_amdgcn_fence(__ATOMIC_RELEASE, "agent");
            asm volatile("s_waitcnt vmcnt(0)" ::: "memory");
            const unsigned og = xb_add(&bar[XB_TOP], 1u);
            const unsigned tg = og / nx;
            if (og + 1u == (tg + 1u) * nx) xb_add(&bar[XB_TOPGEN], 1u);
            else XB_SPIN(xb_ld(&bar[XB_TOPGEN]) == tg, bar);
            __builtin_amdgcn_fence(__ATOMIC_ACQUIRE, "agent");
            xb_add(&bar[XB_XGEN(b.x)], 1u);
            asm volatile("s_waitcnt vmcnt(0)" ::: "memory");
        } else {
            XB_SPIN(xb_ld(&bar[XB_XGEN(b.x)]) == gen, bar);
            __builtin_amdgcn_fence(__ATOMIC_ACQUIRE, "agent");
            asm volatile("s_waitcnt vmcnt(0)" ::: "memory");
        }
    }
    __syncthreads();
}

struct GemmTile { const h16* A; int lda; const h16* Bt; int ldb; int K; int m0, n0; };
constexpr int GEMM_STAGE_BYTES = 49152;

template <int BM>
__device__ __forceinline__ void gemm_tile(const Ctx& c, const GemmTile& g, f32x4 (&acc)[BM / 64][4]) {
    constexpr int MF = BM / 64, WM = BM / 4;
    LAS unsigned char* lds = c.lds;
    const int tid = c.tid, lane = c.lane, wave = c.wave;
    const int wm = wave >> 1, wn = wave & 1;
    const int srow = tid >> 3, schunk = (tid & 7) ^ (srow & 7);
    const h16* gA = g.A + (size_t)(g.m0 + srow) * g.lda + schunk * 8;
    const h16* gB = g.Bt + (size_t)(g.n0 + srow) * g.ldb + schunk * 8;
    const size_t stepA = (size_t)64 * g.lda, stepB = (size_t)64 * g.ldb;
    const unsigned ldsw = (unsigned)wave * 1024u;
    const int fr = lane & 15, fq = lane >> 4;
    int offA[2], offB[2];
#pragma unroll
    for (int s = 0; s < 2; ++s) {
        offA[s] = (wm * WM + fr) * 128 + (((s * 4 + fq) ^ (fr & 7)) << 4);
        offB[s] = 32768 + (wn * 64 + fr) * 128 + (((s * 4 + fq) ^ (fr & 7)) << 4);
    }
#pragma unroll
    for (int i = 0; i < MF; ++i)
#pragma unroll
        for (int j = 0; j < 4; ++j) acc[i][j] = (f32x4){0.f, 0.f, 0.f, 0.f};
    const int nk = g.K >> 6;
#define GEMM_STAGE(kt, buf) do { \
        _Pragma("unroll") for (int _p = 0; _p < MF; ++_p) \
            __builtin_amdgcn_global_load_lds((const unsigned*)(gA + _p * stepA + (size_t)(kt) * 64), (LAS unsigned*)(lds + (buf) * GEMM_STAGE_BYTES + _p * 8192 + ldsw), 16, 0, 0); \
        _Pragma("unroll") for (int _p = 0; _p < 2; ++_p) \
            __builtin_amdgcn_global_load_lds((const unsigned*)(gB + _p * stepB + (size_t)(kt) * 64), (LAS unsigned*)(lds + (buf) * GEMM_STAGE_BYTES + 32768 + _p * 8192 + ldsw), 16, 0, 0); \
    } while (0)
    GEMM_STAGE(0, 0);
    if (nk > 1) GEMM_STAGE(1, 1);
    int cur = 0;
    for (int kt = 0; kt < nk; ++kt) {
        if (kt + 1 < nk) { if (MF == 4) asm volatile("s_waitcnt vmcnt(6)" ::: "memory"); else asm volatile("s_waitcnt vmcnt(5)" ::: "memory"); }
        else asm volatile("s_waitcnt vmcnt(0)" ::: "memory");
        asm volatile("s_waitcnt lgkmcnt(0)" ::: "memory");
        __builtin_amdgcn_s_barrier();
        asm volatile("" ::: "memory");
        if (kt + 2 < nk) { const int nb = cur >= 1 ? cur - 1 : 2; GEMM_STAGE(kt + 2, nb); }
        const LAS unsigned char* lb = lds + cur * GEMM_STAGE_BYTES;
#pragma unroll
        for (int s = 0; s < 2; ++s) {
            h16x8 af[MF], bf[4];
#pragma unroll
            for (int i = 0; i < MF; ++i) af[i] = *(const LAS h16x8*)(lb + offA[s] + i * 2048);
#pragma unroll
            for (int j = 0; j < 4; ++j) bf[j] = *(const LAS h16x8*)(lb + offB[s] + j * 2048);
#pragma unroll
            for (int i = 0; i < MF; ++i)
#pragma unroll
                for (int j = 0; j < 4; ++j) acc[i][j] = __builtin_amdgcn_mfma_f32_16x16x32_f16(bf[j], af[i], acc[i][j], 0, 0, 0);
        }
        cur = cur == 2 ? 0 : cur + 1;
    }
    asm volatile("s_waitcnt lgkmcnt(0)" ::: "memory");
    __builtin_amdgcn_s_barrier();
    asm volatile("" ::: "memory");
#undef GEMM_STAGE
}

__device__ __forceinline__ void tr_item(const float* W, int ldw, int nvalid, int k0, int n0, h16* dst, int ldd, int drow0, LAS float* scr, int lane) {
    const int c4 = lane & 7, kr = lane >> 3;
    const bool ok = (n0 + 4 * c4) < nvalid;
#pragma unroll
    for (int i = 0; i < 8; ++i) {
        const int kk = kr + 8 * i;
        const f32x4 v = ok ? *(const f32x4*)(W + (size_t)(k0 + kk) * ldw + n0 + 4 * c4) : (f32x4){0.f, 0.f, 0.f, 0.f};
        LAS float* s = scr + kk * 33 + 4 * c4;
        s[0] = v[0]; s[1] = v[1]; s[2] = v[2]; s[3] = v[3];
    }
    asm volatile("s_waitcnt lgkmcnt(0)" ::: "memory");
    const int cch = lane & 7;
#pragma unroll
    for (int j = 0; j < 4; ++j) {
        const int n = (lane >> 3) + 8 * j; const LAS float* s = scr + (8 * cch) * 33 + n;
        h16x8 o;
#pragma unroll
        for (int e = 0; e < 8; ++e) o[e] = (h16)s[e * 33];
        *(h16x8*)(dst + (size_t)(drow0 + n) * ldd + k0 + 8 * cch) = o;
    }
    asm volatile("s_waitcnt lgkmcnt(0)" ::: "memory");
}
struct TrJob { const float* src; int K, N, ldw, nvalid; h16* dst; int ldd, kind, base; };
__device__ __forceinline__ int tr_job(const Params& p, int j, TrJob& J) {
    unsigned char* ws = p.ws;
    switch (j) {
    case 0: J = {p.in[I_WIN], 1024, 2176, 2064, 2064, (h16*)(ws + WS_WIN), 1024, 0, 0}; break;
    case 1: J = {p.in[I_WOUT], 1024, 1024, 1024, 1024, (h16*)(ws + WS_WOUT), 1024, 0, 0}; break;
    case 2: case 3: J = {p.in[I_WG] + (size_t)(j - 2) * 1024 * 2816, 1024, 2816, 2816, 2816, (h16*)(ws + WS_WGU) + (size_t)(j - 2) * 5632 * 1024, 1024, 1, 0}; break;
    case 4: case 5: J = {p.in[I_WU] + (size_t)(j - 4) * 1024 * 2816, 1024, 2816, 2816, 2816, (h16*)(ws + WS_WGU) + (size_t)(j - 4) * 5632 * 1024, 1024, 2, 0}; break;
    case 6: case 7: J = {p.in[I_WD] + (size_t)(j - 6) * 2816 * 1024, 2816, 1024, 1024, 1024, (h16*)(ws + WS_WDN) + (size_t)(j - 6) * 1024 * 2816, 2816, 0, 0}; break;
    case 8: J = {p.in[I_WR], 1024, 1024, 1024, 1024, (h16*)(ws + WS_WRKV), 1024, 0, 0}; break;
    case 9: J = {p.in[I_WK], 1024, 1024, 1024, 1024, (h16*)(ws + WS_WRKV), 1024, 0, 1024}; break;
    case 10: J = {p.in[I_WV], 1024, 1024, 1024, 1024, (h16*)(ws + WS_WRKV), 1024, 0, 2048}; break;
    case 11: case 12: J = {p.in[I_W1] + (size_t)(j - 11) * 1024 * 64, 1024, 64, 64, 64, (h16*)(ws + WS_WRKV), 1024, 0, 3072 + 64 * (j - 11)}; break;
    case 13: case 14: J = {p.in[I_A1] + (size_t)(j - 13) * 1024 * 64, 1024, 64, 64, 64, (h16*)(ws + WS_WRKV), 1024, 0, 3072 + 128 + 64 * (j - 13)}; break;
    case 15: J = {p.in[I_G1], 1024, 128, 128, 128, (h16*)(ws + WS_WRKV), 1024, 0, 3072 + 256}; break;
    case 16: J = {p.in[I_WO], 1024, 1024, 1024, 1024, (h16*)(ws + WS_WO), 1024, 0, 0}; break;
    case 17: case 18: J = {p.in[I_W2] + (size_t)(j - 17) * 64 * 1024, 64, 1024, 1024, 1024, (h16*)(ws + WS_W2T) + (size_t)(j - 17) * 1024 * 64, 64, 0, 0}; break;
    case 19: case 20: J = {p.in[I_A2] + (size_t)(j - 19) * 64 * 1024, 64, 1024, 1024, 1024, (h16*)(ws + WS_A2T) + (size_t)(j - 19) * 1024 * 64, 64, 0, 0}; break;
    default: J = {p.in[I_G2], 128, 1024, 1024, 1024, (h16*)(ws + WS_G2T), 128, 0, 0}; break;
    }
    return (J.K / 64) * (J.N / 32);
}
constexpr int N_TRJOBS = 22;

__device__ __forceinline__ void ada_unit(const Params& p, const Ctx& c, int u) {
    LAS float* sc = (LAS float*)c.lds;
    LAS float* red = (LAS float*)(c.lds + 16384);
    const int layer = u / 96, cb = u % 96;
    __syncthreads();
    for (int i = c.tid; i < 3072; i += NTHREADS) {
        const int k = i >> 10, d = i & 1023;
        const float v = (k == 0) ? p.in[I_CCTX][d] : p.in[I_C][(k - 1) * 1024 + d];
        sc[i] = silu_f(v);
    }
    __syncthreads();
    const int tx = c.tid & 15, dg = c.tid >> 4;
    const float* w = p.in[I_MODW] + (size_t)layer * 1024 * 6144 + (size_t)(dg * 32) * 6144 + cb * 64 + tx * 4;
    f32x4 a0 = {0, 0, 0, 0}, a1 = a0, a2 = a0;
#pragma unroll 8
    for (int d = 0; d < 32; ++d) {
        const f32x4 wv = *(const f32x4*)(w + (size_t)d * 6144);
        const int dd = dg * 32 + d;
        a0 += wv * sc[dd]; a1 += wv * sc[1024 + dd]; a2 += wv * sc[2048 + dd];
    }
    *(LAS f32x4*)(red + (dg * 3 + 0) * 64 + tx * 4) = a0;
    *(LAS f32x4*)(red + (dg * 3 + 1) * 64 + tx * 4) = a1;
    *(LAS f32x4*)(red + (dg * 3 + 2) * 64 + tx * 4) = a2;
    __syncthreads();
    if (c.tid < 192) {
        const int k = c.tid >> 6, col = c.tid & 63;
        float s = p.in[I_MODB][layer * 6144 + cb * 64 + col];
#pragma unroll 8
        for (int g = 0; g < 32; ++g) s += red[(g * 3 + k) * 64 + col];
        ((float*)(p.ws + WS_ADA))[(layer * 3 + k) * 6144 + cb * 64 + col] = s;
    }
}

constexpr int N_CONV_ITEMS = 11392, N_CONV_UNITS = N_CONV_ITEMS / 64;
__device__ __forceinline__ void conv_unit(const Params& p, const Ctx& c, int u) {
    LAS float* scr = (LAS float*)(c.lds + c.wave * 16384);
    __syncthreads();
    for (int e = 0; e < 8; ++e) {
        int it = u * 64 + c.wave * 8 + e;
        int j = 1; TrJob J; int cnt = tr_job(p, j, J);
        while (it >= cnt) { it -= cnt; ++j; cnt = tr_job(p, j, J); }
        const int nblk = J.N / 32, kb = it / nblk, nb = it % nblk, n0 = nb * 32;
        const int drow0 = J.kind == 0 ? J.base + n0 : (J.kind == 1 ? 2 * n0 : 2 * n0 + 32);
        tr_item(J.src, J.ldw, J.nvalid, kb * 64, n0, J.dst, J.ldd, drow0, scr, c.lane);
    }
    __syncthreads();
}
__device__ __forceinline__ void phase0(const Params& p, const Ctx& c) {
    for (int u = c.bid; u < 192; u += c.G) ada_unit(p, c, u);
    __syncthreads();
    {
        LAS float* scr = (LAS float*)(c.lds + c.wave * 16384);
        const int gw = c.bid * NWAVES + c.wave, NGW = c.G * NWAVES;
        TrJob J; const int cnt = tr_job(p, 0, J);
        const int nblk = J.N / 32;
        for (int it = gw; it < cnt; it += NGW) {
            const int kb = it / nblk, nb = it % nblk, n0 = nb * 32;
            tr_item(J.src, J.ldw, J.nvalid, kb * 64, n0, J.dst, J.ldd, J.base + n0, scr, c.lane);
        }
    }
    { float* rs_ = (float*)(p.ws + WS_ROWSS); for (int i = c.bid * NTHREADS + c.tid; i < 2 * NTOK; i += c.G * NTHREADS) rs_[i] = 0.f; }
    const int gt = c.bid * NTHREADS + c.tid, NGT = c.G * NTHREADS;
    float* rc = (float*)(p.ws + WS_ROPE); float* rs = rc + 32768;
    for (int i = gt; i < 32768; i += NGT) {
        const int tok = i >> 5, f = i & 31;
        const float pos = (float)((f < 16) ? (tok >> 6) : (tok & 63));
        const float inv = powf(10000.f, -(float)(f & 15) / 16.f);
        const float ang = pos * inv;
        rc[i] = cosf(ang); rs[i] = sinf(ang);
    }
    h16* k16l = (h16*)(p.ws + WS_K16L); h16* vt16l = (h16*)(p.ws + WS_VT16L);
    for (int i = gt; i < 65536; i += NGT) {
        const int d = i & 63, kvh = (i >> 6) & 1, key = (i >> 7) & 255, b = i >> 15;
        k16l[((size_t)(b * 2 + kvh) * 1280 + key) * 64 + d] = (h16)p.in[I_CK][i];
        vt16l[((size_t)(b * 2 + kvh) * 64 + d) * 1280 + key] = (h16)p.in[I_CV][i];
    }
}

__device__ __forceinline__ void load_row(const float* r, int lane, f32x4 (&v)[4]) {
#pragma unroll
    for (int j = 0; j < 4; ++j) v[j] = *(const f32x4*)(r + 256 * j + 4 * lane);
}
__device__ __forceinline__ float row_rstd(const f32x4 (&v)[4]) {
    float s = 0.f;
#pragma unroll
    for (int j = 0; j < 4; ++j) s += v[j].x * v[j].x + v[j].y * v[j].y + v[j].z * v[j].z + v[j].w * v[j].w;
    return rsqrtf(wave_sum(s) * (1.f / 1024.f) + 1e-6f);
}
__device__ __forceinline__ const float* xin_row(const Params& p, int row) {
    return row < NCTX ? p.in[I_XP] + (size_t)row * D : p.in[I_XS] + (size_t)(row - NCTX) * D;
}
__device__ __forceinline__ void phase_normmod(const Params& p, const Ctx& c, bool from_input, const float* g, int layer, int ch_sh, int ch_sc) {
    const int gw = c.bid * NWAVES + c.wave, NGW = c.G * NWAVES;
    const float* ada = (const float*)(p.ws + WS_ADA);
    h16* hA = (h16*)(p.ws + WS_HA);
    for (int row = gw; row < NTOK; row += NGW) {
        const float* xr = from_input ? xin_row(p, row) : (const float*)(p.ws + WS_X) + (size_t)row * D;
        f32x4 v[4]; load_row(xr, c.lane, v);
        const float rstd = row_rstd(v);
        const float* a = ada + (size_t)(layer * 3 + stream_of(row)) * 6144;
#pragma unroll
        for (int j = 0; j < 4; ++j) {
            const int col = 256 * j + 4 * c.lane;
            const f32x4 gg = *(const f32x4*)(g + col), sh = *(const f32x4*)(a + ch_sh * 1024 + col), sc = *(const f32x4*)(a + ch_sc * 1024 + col);
            const f32x4 o = v[j] * rstd * gg * (sc + 1.f) + sh;
            *(h16x4*)(hA + (size_t)row * D + col) = cvt4(o);
        }
    }
}

__device__ __forceinline__ void phase_postproj(const Params& p, const Ctx& c) {
    const int gw = c.bid * NWAVES + c.wave, NGW = c.G * NWAVES, lane = c.lane;
    const float* proj = (const float*)(p.ws + WS_PROJ);
    float* xbc = (float*)(p.ws + WS_XBC);
    float* dtv = (float*)(p.ws + WS_DT);
    for (int it = gw; it < 384 * 3; it += NGW) {
        const int seg = it / 3, cb = it % 3, row0 = seg * 16, ch = cb * 256 + lane * 4;
        const int T = row0 >= NCTX ? 1024 : 256, t0 = (row0 >= NCTX ? row0 - NCTX : row0) & (T - 1);
        f32x4 x[20];
#pragma unroll
        for (int r = 0; r < 20; ++r) {
            const int tt = t0 + r - 2;
            x[r] = (tt >= 0 && tt < T) ? *(const f32x4*)(proj + (size_t)(row0 + r - 2) * PROJ_LD + 1280 + ch) : (f32x4){0.f, 0.f, 0.f, 0.f};
        }
        f32x4 w[5];
#pragma unroll
        for (int i = 0; i < 5; ++i) w[i] = *(const f32x4*)(p.in[I_CONVW] + i * 768 + ch);
        const f32x4 bias = *(const f32x4*)(p.in[I_CONVB] + ch);
#pragma unroll
        for (int r = 0; r < 16; ++r) {
            f32x4 a = bias;
#pragma unroll
            for (int i = 0; i < 5; ++i) a += w[i] * x[r + i];
            f32x4 o; o[0] = silu_f(a[0]); o[1] = silu_f(a[1]); o[2] = silu_f(a[2]); o[3] = silu_f(a[3]);
            *(f32x4*)(xbc + (size_t)(row0 + r) * 768 + ch) = o;
        }
    }
    for (int it = gw; it < NTOK / 4; it += NGW) {
        const int row = it * 4 + (lane >> 4), e = lane & 15;
        dtv[row * 16 + e] = softplus_f(proj[(size_t)row * PROJ_LD + 2048 + e] + p.in[I_DTB][e]);
    }
}

__device__ __forceinline__ void phase_ssdcombine(const Params& p, const Ctx& c) {
    const int gw = c.bid * NWAVES + c.wave, NGW = c.G * NWAVES, lane = c.lane;
    {
        const float* ada = (const float*)(p.ws + WS_ADA); float* fb = (float*)(p.ws + WS_FBIAS);
        for (int it = gw; it < 2 * 5632; it += NGW) {
            const int l = it / 5632, n = it % 5632;
            const h16* wr = (const h16*)(p.ws + WS_WGU) + ((size_t)l * 5632 + n) * 1024 + lane * 16;
            const h16x8 w0 = *(const h16x8*)wr, w1 = *(const h16x8*)(wr + 8);
            float a0 = 0.f, a1 = 0.f, a2 = 0.f;
#pragma unroll
            for (int e = 0; e < 16; ++e) {
                const float w = (float)(e < 8 ? w0[e & 7] : w1[e & 7]); const int k = lane * 16 + e;
                a0 += w * ada[(size_t)(l * 3 + 0) * 6144 + 3072 + k]; a1 += w * ada[(size_t)(l * 3 + 1) * 6144 + 3072 + k]; a2 += w * ada[(size_t)(l * 3 + 2) * 6144 + 3072 + k];
            }
            a0 = wave_sum(a0); a1 = wave_sum(a1); a2 = wave_sum(a2);
            if (lane == 0) { fb[(size_t)(l * 3 + 0) * 5632 + n] = a0; fb[(size_t)(l * 3 + 1) * 5632 + n] = a1; fb[(size_t)(l * 3 + 2) * 5632 + n] = a2; }
        }
    }
    const float* ssdy = (const float*)(p.ws + WS_SSDY);
    const float* xbc = (const float*)(p.ws + WS_XBC);
    const float* proj = (const float*)(p.ws + WS_PROJ);
    h16* cat = (h16*)(p.ws + WS_CAT);
    for (int row = gw; row < NTOK; row += NGW) {
        const int c0 = lane * 8, h = lane >> 3;
        const float dsk = p.in[I_SSDD][h];
        float y[8]; float ss = 0.f;
#pragma unroll
        for (int e = 0; e < 2; ++e) {
            const f32x4 yf = *(const f32x4*)(ssdy + (size_t)row * 512 + c0 + 4 * e), yb = *(const f32x4*)(ssdy + (size_t)(NTOK + row) * 512 + c0 + 4 * e);
            const f32x4 xs = *(const f32x4*)(xbc + (size_t)row * 768 + c0 + 4 * e), z = *(const f32x4*)(proj + (size_t)row * PROJ_LD + 768 + c0 + 4 * e);
#pragma unroll
            for (int q = 0; q < 4; ++q) { const float v = (yf[q] + yb[q] + dsk * xs[q]) * silu_f(z[q]); y[4 * e + q] = v; ss += v * v; }
        }
        const float rstd = rsqrtf(wave_sum(ss) * (1.f / 512.f) + 1e-6f);
        h16x8 o;
#pragma unroll
        for (int e = 0; e < 8; ++e) o[e] = (h16)(y[e] * rstd * p.in[I_SSDG][c0 + e]);
        *(h16x8*)(cat + (size_t)row * D + 512 + c0) = o;
    }
}

__device__ __forceinline__ void phase_rwkvmix(const Params& p, const Ctx& c) {
    const int gw = c.bid * NWAVES + c.wave, NGW = c.G * NWAVES, lane = c.lane;
    const float* X = (const float*)(p.ws + WS_X);
    const float* ada = (const float*)(p.ws + WS_ADA);
    const float* g = p.in[I_NMG] + 1024;
    h16* xm = (h16*)(p.ws + WS_XMIX);
    for (int row = gw; row < NTOK; row += NGW) {
        const bool lat = row >= NCTX;
        const int r2 = lat ? row - NCTX : row;
        const int t = lat ? (r2 & 1023) : (r2 & 255), T = lat ? 1024 : 256;
        const float* a = ada + (size_t)(3 + stream_of(row)) * 6144;
        f32x4 h0[4], hp[4], hn[4];
        load_row(X + (size_t)row * D, lane, h0);
        const float r0 = row_rstd(h0);
        const bool hasp = t > 0, hasn = t < T - 1;
        float rp = 0.f, rn = 0.f;
        if (hasp) { load_row(X + (size_t)(row - 1) * D, lane, hp); rp = row_rstd(hp); }
        if (hasn) { load_row(X + (size_t)(row + 1) * D, lane, hn); rn = row_rstd(hn); }
#pragma unroll
        for (int j = 0; j < 4; ++j) {
            const int col = 256 * j + 4 * lane;
            const f32x4 gg = *(const f32x4*)(g + col), sh = *(const f32x4*)(a + col), sc = *(const f32x4*)(a + 1024 + col);
            const f32x4 m = gg * (sc + 1.f);
            const f32x4 hh = h0[j] * r0 * m + sh;
            f32x4 dp = -hh, dn = -hh;
            if (hasp) dp = (hp[j] * rp * m + sh) - hh;
            if (hasn) dn = (hn[j] * rn * m + sh) - hh;
#pragma unroll
            for (int i = 0; i < 6; ++i) {
                const f32x4 m0 = *(const f32x4*)(p.in[I_MU] + i * 1024 + col), m1 = *(const f32x4*)(p.in[I_MU] + (6 + i) * 1024 + col);
                *(h16x4*)(xm + ((size_t)i * NTOK + row) * D + col) = cvt4(hh + dp * m0 + dn * m1);
            }
        }
    }
}

template <int N> __device__ __forceinline__ float dpp_row_shr1(float x) {
    return __builtin_bit_cast(float, __builtin_amdgcn_update_dpp(0x3f800000, __builtin_bit_cast(int, x), 0x110 + N, 0xf, 0xf, false));
}
__device__ __forceinline__ float dpp_bcast15(float x) {
    return __builtin_bit_cast(float, __builtin_amdgcn_update_dpp(0, __builtin_bit_cast(int, x), 0x150 + 15, 0xf, 0xf, false));
}
template <int J> struct TriSolve {
    static __device__ __forceinline__ void run(float (&Tm)[4], const float (&nL)[16]) {
#pragma unroll
        for (int cc = 0; cc < 4; ++cc) { float src_ = Tm[cc]; fmac_bc_safe<J>(Tm[cc], src_, nL[J]); }
        if constexpr (J < 14) TriSolve<J + 1>::run(Tm, nL);
    }
};
__device__ __forceinline__ void phase_rwkvprep(const Params& p, const Ctx& c) {
    const int gw = c.bid * NWAVES + c.wave, NGW = c.G * NWAVES, lane = c.lane;
    const int i = lane & 15, g = lane >> 4;
    LAS unsigned char* scr = c.lds + c.wave * 8192;
    const h16* r16 = (const h16*)(p.ws + WS_R16); const h16* k16 = (const h16*)(p.ws + WS_K16);
    float* bonus = (float*)(p.ws + WS_BONUS);
    for (int item = gw; item < 2 * 384 * 16; item += NGW) {
        const int h = item & 15, rbg = (item >> 4) % 384, dir = item / (16 * 384);
        const int row0 = rbg * 16, row = row0 + (dir ? 15 - i : i);
        h16* dec = (h16*)(p.ws + WS_DEC16) + (size_t)dir * NTOK * D; h16* a16 = (h16*)(p.ws + WS_A16) + (size_t)dir * NTOK * D;
        float kv[16], rv[16], wv[16], av[16];
#pragma unroll
        for (int q = 0; q < 4; ++q) {
            const size_t o = (size_t)row * D + h * 64 + 16 * q + 4 * g;
            const h16x4 k4 = *(const h16x4*)(k16 + o), r4 = *(const h16x4*)(r16 + o), d4 = *(const h16x4*)(dec + o), a4 = *(const h16x4*)(a16 + o);
#pragma unroll
            for (int jj = 0; jj < 4; ++jj) { kv[4 * q + jj] = (float)k4[jj]; rv[4 * q + jj] = (float)r4[jj]; wv[4 * q + jj] = 1.f - (float)d4[jj]; av[4 * q + jj] = (float)a4[jj]; }
        }
        float kap[16], ss = 0.f;
#pragma unroll
        for (int q = 0; q < 4; ++q) {
            const f32x4 kkw = *(const f32x4*)(p.in[I_KKW] + h * 64 + 16 * q + 4 * g);
#pragma unroll
            for (int jj = 0; jj < 4; ++jj) { kap[4 * q + jj] = kv[4 * q + jj] * kkw[jj]; ss += kap[4 * q + jj] * kap[4 * q + jj]; }
        }
        ss = rowsum4(ss);
        const float rn = rsqrtf(ss + 1e-12f);
        float bon = 0.f;
        float beta[16], kt[16];
#pragma unroll
        for (int q = 0; q < 4; ++q) {
            const f32x4 ka4 = *(const f32x4*)(p.in[I_KA] + h * 64 + 16 * q + 4 * g), rk4 = *(const f32x4*)(p.in[I_RK] + h * 64 + 16 * q + 4 * g);
#pragma unroll
            for (int jj = 0; jj < 4; ++jj) {
                const int m = 4 * q + jj;
                kap[m] *= rn; beta[m] = kap[m] * av[m]; kt[m] = kv[m] * (1.f + (av[m] - 1.f) * ka4[jj]);
                bon += rv[m] * kt[m] * rk4[jj];
            }
        }
        bon = rowsum4(bon);
        if (g == 0) bonus[((size_t)dir * NTOK + row) * 16 + h] = bon;
        f32x4 A1 = {0.f, 0.f, 0.f, 0.f}, Lm = A1, N1 = A1, N2 = A1;
        h16 kapo[16], rho[16], kbo[16], bbo[16];
        float gcv[16];
#pragma unroll
        for (int m = 0; m < 16; ++m) {
            float G = wv[m];
            G *= dpp_row_shr1<1>(G); G *= dpp_row_shr1<2>(G); G *= dpp_row_shr1<4>(G); G *= dpp_row_shr1<8>(G);
            const float Gex = dpp_row_shr1<1>(G), GC = dpp_bcast15(G), rG = 1.f / G;
            const float kh = kap[m] * Gex, rh = rv[m] * G, k_h = kt[m] * rG, b_h = beta[m] * rG;
            A1 = __builtin_amdgcn_mfma_f32_16x16x4f32(k_h, kh, A1, 0, 0, 0);
            Lm = __builtin_amdgcn_mfma_f32_16x16x4f32(b_h, kh, Lm, 0, 0, 0);
            N1 = __builtin_amdgcn_mfma_f32_16x16x4f32(k_h, rh, N1, 0, 0, 0);
            N2 = __builtin_amdgcn_mfma_f32_16x16x4f32(b_h, rh, N2, 0, 0, 0);
            kapo[m] = (h16)kh; rho[m] = (h16)rh; kbo[m] = (h16)(k_h * GC); bbo[m] = (h16)(b_h * GC); gcv[m] = GC;
        }
#pragma unroll
        for (int r = 0; r < 4; ++r) { const int j = 4 * g + r; if (!(j < i)) { A1[r] = 0.f; Lm[r] = 0.f; } if (!(j <= i)) { N1[r] = 0.f; N2[r] = 0.f; } }
        LAS float* Lb = (LAS float*)(scr + 4096);
        *(LAS f32x4*)(Lb + i * 16 + 4 * g) = Lm;
        LAS h16* kbT = (LAS h16*)scr;
#pragma unroll
        for (int m = 0; m < 16; ++m) {
            const int f = m >> 2, kc = 4 * g + (m & 3);
            const int u = ((f * 16 + kc) * 4 + (i >> 2)) * 8 + (i & 3);
            kbT[u] = kbo[m]; kbT[u + 4] = bbo[m];
        }
        asm volatile("s_waitcnt lgkmcnt(0)" ::: "memory");
        float nL[16];
#pragma unroll
        for (int q = 0; q < 4; ++q) { const f32x4 v = *(const LAS f32x4*)(Lb + i * 16 + 4 * q); nL[4 * q] = -v[0]; nL[4 * q + 1] = -v[1]; nL[4 * q + 2] = -v[2]; nL[4 * q + 3] = -v[3]; }
        float Tm[4];
#pragma unroll
        for (int cc = 0; cc < 4; ++cc) Tm[cc] = (i == 4 * g + cc) ? 1.f : 0.f;
        asm volatile("s_nop 1" : "+v"(Tm[0]), "+v"(Tm[1]), "+v"(Tm[2]), "+v"(Tm[3]));
        TriSolve<0>::run(Tm, nL);
        unsigned char* item_o = p.ws + WS_OPS2 + (size_t)item * OPS2_ITEM;
        {
            h16x8 o;
#pragma unroll
            for (int s = 0; s < 2; ++s) {
#pragma unroll
                for (int e = 0; e < 8; ++e) o[e] = kapo[8 * s + e];
                *(h16x8*)(dec + (size_t)(row0 + i) * D + h * 64 + (g * 2 + s) * 8) = o;
#pragma unroll
                for (int e = 0; e < 8; ++e) o[e] = rho[8 * s + e];
                *(h16x8*)(a16 + (size_t)(row0 + i) * D + h * 64 + (g * 2 + s) * 8) = o;
            }
        }
#pragma unroll
        for (int q = 0; q < 4; ++q) *(u32x4*)(item_o + (q * 64 + lane) * 16) = *(const LAS u32x4*)(scr + (q * 64 + lane) * 16);
        *(h16x4*)(item_o + 4096 + (i * 4 + g) * 8) = cvt4(A1);
        { f32x4 t4 = {Tm[0], Tm[1], Tm[2], Tm[3]}; *(h16x4*)(item_o + 4608 + (i * 4 + g) * 8) = cvt4(t4); }
        { h16x8 o; for (int r = 0; r < 4; ++r) { o[r] = (h16)N1[r]; o[4 + r] = (h16)N2[r]; } *(h16x8*)(item_o + 5120 + (i * 4 + g) * 16) = o; }
        if (i == 0) {
#pragma unroll
            for (int q = 0; q < 4; ++q) *(f32x4*)(item_o + 6144 + (16 * q + 4 * g) * 4) = (f32x4){gcv[4 * q], gcv[4 * q + 1], gcv[4 * q + 2], gcv[4 * q + 3]};
        }
        asm volatile("s_waitcnt lgkmcnt(0)" ::: "memory");
    }
}

__device__ __forceinline__ void phase_rwkvpost(const Params& p, const Ctx& c) {
    const int gw = c.bid * NWAVES + c.wave, NGW = c.G * NWAVES, lane = c.lane;
    const h16* y16 = (const h16*)(p.ws + WS_Y16); const h16* v16 = (const h16*)(p.ws + WS_V16); const h16* g16 = (const h16*)(p.ws + WS_G16);
    const float* bonus = (const float*)(p.ws + WS_BONUS);
    h16* hA = (h16*)(p.ws + WS_HA);
    for (int row = gw; row < NTOK; row += NGW) {
        const int c0 = lane * 16;
        float y[16]; float s = 0.f;
#pragma unroll
        for (int e = 0; e < 2; ++e) {
            const h16x8 a = *(const h16x8*)(y16 + (size_t)row * D + c0 + 8 * e), b = *(const h16x8*)(y16 + ((size_t)NTOK + row) * D + c0 + 8 * e);
#pragma unroll
            for (int q = 0; q < 8; ++q) { y[8 * e + q] = (float)a[q] + (float)b[q]; s += y[8 * e + q]; }
        }
        s += __shfl_xor(s, 1); s += __shfl_xor(s, 2);
        const float mean = s * (1.f / 64.f);
        float vs = 0.f;
#pragma unroll
        for (int e = 0; e < 16; ++e) { y[e] -= mean; vs += y[e] * y[e]; }
        vs += __shfl_xor(vs, 1); vs += __shfl_xor(vs, 2);
        const float rstd = rsqrtf(vs * (1.f / 64.f) + 64e-5f);
        const float bon = bonus[row * 16 + (lane >> 2)] + bonus[((size_t)NTOK + row) * 16 + (lane >> 2)];
#pragma unroll
        for (int e = 0; e < 2; ++e) {
            const h16x8 vv = *(const h16x8*)(v16 + (size_t)row * D + c0 + 8 * e), gv = *(const h16x8*)(g16 + (size_t)row * D + c0 + 8 * e);
            h16x8 o;
#pragma unroll
            for (int q = 0; q < 8; ++q) {
                const int cc = c0 + 8 * e + q;
                const float yn = y[8 * e + q] * rstd * p.in[I_LNG][cc] + p.in[I_LNB][cc];
                o[q] = (h16)((yn + bon * (float)vv[q]) * (float)gv[q]);
            }
            *(h16x8*)(hA + (size_t)row * D + c0 + 8 * e) = o;
        }
    }
}

__device__ __forceinline__ void phase_final(const Params& p, const Ctx& c) {
    const int gw = c.bid * NWAVES + c.wave, NGW = c.G * NWAVES;
    const float* X = (const float*)(p.ws + WS_X);
    for (int row = gw; row < NTOK; row += NGW) {
        f32x4 v[4]; load_row(X + (size_t)row * D, c.lane, v);
        const float rstd = row_rstd(v);
#pragma unroll
        for (int j = 0; j < 4; ++j) {
            const int col = 256 * j + 4 * c.lane;
            *(f32x4*)(p.out + O_Y + (size_t)row * D + col) = v[j] * rstd * *(const f32x4*)(p.in[I_FNG] + col);
        }
    }
}

__device__ __forceinline__ void attn_unit(const Params& p, const Ctx& c, bool lat, int b, int kvh, int qb) {
    const int lane = c.lane, wave = c.wave, tid = c.tid;
    const int nkeys = lat ? 1280 : 256;
    const h16* Kg = lat ? (const h16*)(p.ws + WS_K16L) + (size_t)(b * 2 + kvh) * 1280 * 64 : (const h16*)(p.ws + WS_K16C) + (size_t)(b * 2 + kvh) * 256 * 64;
    const h16* Vg = lat ? (const h16*)(p.ws + WS_VT16L) + (size_t)(b * 2 + kvh) * 64 * 1280 : (const h16*)(p.ws + WS_VT16C) + (size_t)(b * 2 + kvh) * 64 * 256;
    const int row0 = (lat ? NCTX + b * 1024 : b * 256) + qb * 32 + (wave & 1) * 16;
    const int head = kvh * 4 + (wave >> 1);
    const int fr = lane & 15, fq = lane >> 4;
    const h16* q16 = (const h16*)(p.ws + WS_Q16);
    h16x8 qf[2];
#pragma unroll
    for (int s = 0; s < 2; ++s) qf[s] = *(const h16x8*)(q16 + (size_t)(row0 + fr) * 512 + head * 64 + s * 32 + fq * 8);
    LAS unsigned char* ldsK = c.lds; LAS unsigned char* ldsV = c.lds + 8192;
    float m = -1e30f, l = 0.f;
    f32x4 O[4];
#pragma unroll
    for (int f = 0; f < 4; ++f) O[f] = (f32x4){0.f, 0.f, 0.f, 0.f};
    const int srow = tid >> 3, sch = tid & 7;
    const int sdst = srow * 128 + ((sch ^ (srow & 7)) << 4);
    const int ntile = nkeys / 64;
    u32x4 kv = *(const u32x4*)(Kg + (size_t)srow * 64 + sch * 8);
    u32x4 vv = *(const u32x4*)(Vg + (size_t)srow * nkeys + sch * 8);
    for (int kt = 0; kt < ntile; ++kt) {
        __syncthreads();
        *(LAS u32x4*)(ldsK + sdst) = kv;
        *(LAS u32x4*)(ldsV + sdst) = vv;
        __syncthreads();
        if (kt + 1 < ntile) {
            kv = *(const u32x4*)(Kg + (size_t)((kt + 1) * 64 + srow) * 64 + sch * 8);
            vv = *(const u32x4*)(Vg + (size_t)srow * nkeys + (kt + 1) * 64 + sch * 8);
        }
        f32x4 sacc[4];
#pragma unroll
        for (int f = 0; f < 4; ++f) {
            sacc[f] = (f32x4){0.f, 0.f, 0.f, 0.f};
#pragma unroll
            for (int s = 0; s < 2; ++s) {
                const h16x8 kf = *(const LAS h16x8*)(ldsK + (f * 16 + fr) * 128 + (((s * 4 + fq) ^ (fr & 7)) << 4));
                sacc[f] = __builtin_amdgcn_mfma_f32_16x16x32_f16(kf, qf[s], sacc[f], 0, 0, 0);
            }
        }
        float mx = -1e30f;
#pragma unroll
        for (int f = 0; f < 4; ++f)
#pragma unroll
            for (int r = 0; r < 4; ++r) mx = fmaxf(mx, sacc[f][r]);
        mx = fmaxf(mx, __shfl_xor(mx, 16)); mx = fmaxf(mx, __shfl_xor(mx, 32));
        const float mn = fmaxf(m, mx);
        const float alpha = __expf(m - mn);
        m = mn;
        float ps = 0.f;
#pragma unroll
        for (int f = 0; f < 4; ++f)
#pragma unroll
            for (int r = 0; r < 4; ++r) { const float e = __expf(sacc[f][r] - mn); sacc[f][r] = e; ps += e; }
        l = l * alpha + ps;
#pragma unroll
        for (int f = 0; f < 4; ++f) O[f] *= alpha;
#pragma unroll
        for (int s2 = 0; s2 < 2; ++s2) {
            h16x8 pf;
#pragma unroll
            for (int r = 0; r < 4; ++r) { pf[r] = (h16)sacc[2 * s2][r]; pf[4 + r] = (h16)sacc[2 * s2 + 1][r]; }
#pragma unroll
            for (int fd = 0; fd < 4; ++fd) {
                const int d = fd * 16 + fr;
                const h16x4 lo = *(const LAS h16x4*)(ldsV + d * 128 + (((4 * s2 + (fq >> 1)) ^ (d & 7)) << 4) + (fq & 1) * 8);
                const h16x4 hi = *(const LAS h16x4*)(ldsV + d * 128 + (((4 * s2 + 2 + (fq >> 1)) ^ (d & 7)) << 4) + (fq & 1) * 8);
                h16x8 vf; vf[0] = lo[0]; vf[1] = lo[1]; vf[2] = lo[2]; vf[3] = lo[3]; vf[4] = hi[0]; vf[5] = hi[1]; vf[6] = hi[2]; vf[7] = hi[3];
                O[fd] = __builtin_amdgcn_mfma_f32_16x16x32_f16(vf, pf, O[fd], 0, 0, 0);
            }
        }
    }
    l += __shfl_xor(l, 16); l += __shfl_xor(l, 32);
    const float inv = 1.f / l;
    h16* cat = (h16*)(p.ws + WS_CAT);
#pragma unroll
    for (int fd = 0; fd < 4; ++fd)
        *(h16x4*)(cat + (size_t)(row0 + fr) * D + head * 64 + fd * 16 + 4 * fq) = cvt4(O[fd] * inv);
    __syncthreads();
}

__device__ __forceinline__ void ssd_unit(const Params& p, const Ctx& c, bool lat, int b, int h, int dir) {
    const int lane = c.lane, wave = c.wave, tid = c.tid;
    const int fr = lane & 15, fq = lane >> 4;
    const int T = lat ? 1024 : 256, rowbase = lat ? NCTX + b * 1024 : b * 256, grp = h >> 2;
    const float* xbc = (const float*)(p.ws + WS_XBC);
    const float* dtv = (const float*)(p.ws + WS_DT);
    float* ssdy = (float*)(p.ws + WS_SSDY) + (size_t)dir * NTOK * 512;
    const float Aneg = -__expf(p.in[I_ALOG][dir * 8 + h]);
    LAS unsigned char* Bn = c.lds; LAS unsigned char* Cn = c.lds + 16384; LAS unsigned char* xdtT = c.lds + 32768; LAS unsigned char* BdT = c.lds + 49152;
    LAS unsigned char* himg = c.lds + 65536; LAS float* acs = (LAS float*)(c.lds + 73728); LAS float* dtl = (LAS float*)(c.lds + 74240);
    const int fn = wave & 3, fp0 = 2 * (wave >> 2);
    f32x4 hst[2];
    const size_t sbase = (size_t)(b * 8 + h) * 4096;
#pragma unroll
    for (int e = 0; e < 2; ++e) {
        const int pp = 16 * (fp0 + e) + fr, n0 = 16 * fn + 4 * fq;
        hst[e] = lat ? *(const f32x4*)((dir ? p.in[I_SSDB] : p.in[I_SSDF]) + sbase + pp * 64 + n0) : (f32x4){0.f, 0.f, 0.f, 0.f};
    }
    __syncthreads();
#pragma unroll
    for (int e = 0; e < 2; ++e) {
        const int pp = 16 * (fp0 + e) + fr;
        *(LAS h16x4*)(himg + pp * 128 + (((2 * fn + (fq >> 1)) ^ (pp & 7)) << 4) + (fq & 1) * 8) = cvt4(hst[e]);
    }
    const int nchunk = T / 128;
    f32x4 pB[4], pC[4], pX[4]; float pd0 = 0.f, pd1 = 0.f;
    const int prow = tid >> 2, pq4 = tid & 3, pch = tid & 63, plb = tid >> 6;
    LAS unsigned char* Xn = c.lds + 75776;
#define SSD_PREFETCH(ck_) do { const int r0_ = dir ? rowbase + T - 1 - (ck_) * 128 : rowbase + (ck_) * 128, sg_ = dir ? -1 : 1; \
        const float* g_ = xbc + (size_t)(r0_ + sg_ * prow) * 768 + 16 * pq4; \
        _Pragma("unroll") for (int e_ = 0; e_ < 4; ++e_) { pB[e_] = *(const f32x4*)(g_ + 512 + grp * 64 + 4 * e_); pC[e_] = *(const f32x4*)(g_ + 640 + grp * 64 + 4 * e_); pX[e_] = *(const f32x4*)(g_ + h * 64 + 4 * e_); } \
        if (wave == 0) { pd0 = dtv[(r0_ + sg_ * (2 * lane)) * 16 + dir * 8 + h]; pd1 = dtv[(r0_ + sg_ * (2 * lane + 1)) * 16 + dir * 8 + h]; } } while (0)
    SSD_PREFETCH(0);
    for (int ck = 0; ck < nchunk; ++ck) {
        const int r0 = dir ? rowbase + T - 1 - ck * 128 : rowbase + ck * 128, sg = dir ? -1 : 1;
        if (wave == 0) {
            const float d0 = pd0, d1 = pd1;
            const float a0 = d0 * Aneg, a1 = d1 * Aneg;
            float s = a0 + a1;
#pragma unroll
            for (int o = 1; o < 64; o <<= 1) { const float t = __shfl_up(s, o); if (lane >= o) s += t; }
            const float ex = s - (a0 + a1);
            acs[2 * lane] = ex + a0; acs[2 * lane + 1] = ex + a0 + a1; dtl[2 * lane] = d0; dtl[2 * lane + 1] = d1;
        }
        {
            const int o0_ = prow * 128 + (((2 * pq4) ^ (prow & 7)) << 4), o1_ = prow * 128 + (((2 * pq4 + 1) ^ (prow & 7)) << 4);
            h16x8 o0, o1;
#pragma unroll
            for (int e = 0; e < 4; ++e) { o0[e] = (h16)pB[0][e]; o0[4 + e] = (h16)pB[1][e]; o1[e] = (h16)pB[2][e]; o1[4 + e] = (h16)pB[3][e]; }
            *(LAS h16x8*)(Bn + o0_) = o0; *(LAS h16x8*)(Bn + o1_) = o1;
#pragma unroll
            for (int e = 0; e < 4; ++e) { o0[e] = (h16)pC[0][e]; o0[4 + e] = (h16)pC[1][e]; o1[e] = (h16)pC[2][e]; o1[4 + e] = (h16)pC[3][e]; }
            *(LAS h16x8*)(Cn + o0_) = o0; *(LAS h16x8*)(Cn + o1_) = o1;
#pragma unroll
            for (int e = 0; e < 4; ++e) { o0[e] = (h16)pX[0][e]; o0[4 + e] = (h16)pX[1][e]; o1[e] = (h16)pX[2][e]; o1[4 + e] = (h16)pX[3][e]; }
            *(LAS h16x8*)(Xn + o0_) = o0; *(LAS h16x8*)(Xn + o1_) = o1;
        }
        __syncthreads();
        {
            const float aend = acs[127];
#pragma unroll 1
            for (int j = 0; j < 2; ++j) {
                const int l0 = 8 * plb + 64 * j;
                h16x8 ox, ob;
#pragma unroll
                for (int e = 0; e < 8; ++e) {
                    const int l = l0 + e, ad = l * 128 + (((pch >> 3) ^ (l & 7)) << 4) + (pch & 7) * 2;
                    ox[e] = (h16)((float)*(const LAS h16*)(Xn + ad) * dtl[l]);
                    ob[e] = (h16)((float)*(const LAS h16*)(Bn + ad) * __expf(aend - acs[l]));
                }
                const int off = pch * 256 + (((l0 >> 3) ^ (pch & 15)) << 4);
                *(LAS h16x8*)(xdtT + off) = ox; *(LAS h16x8*)(BdT + off) = ob;
            }
        }
        if (ck + 1 < nchunk) SSD_PREFETCH(ck + 1);
        __syncthreads();
        const int l = 16 * wave + fr;
        const float al = acs[l];
        f32x4 accy[4];
#pragma unroll
        for (int fd = 0; fd < 4; ++fd) accy[fd] = (f32x4){0.f, 0.f, 0.f, 0.f};
        h16x8 cf[2];
#pragma unroll
        for (int s2 = 0; s2 < 2; ++s2) cf[s2] = *(const LAS h16x8*)(Cn + l * 128 + (((4 * s2 + fq) ^ (l & 7)) << 4));
#pragma unroll
        for (int fd = 0; fd < 4; ++fd) {
            const int pp = 16 * fd + fr;
#pragma unroll
            for (int s2 = 0; s2 < 2; ++s2) {
                const h16x8 hf = *(const LAS h16x8*)(himg + pp * 128 + (((4 * s2 + fq) ^ (pp & 7)) << 4));
                accy[fd] = __builtin_amdgcn_mfma_f32_16x16x32_f16(hf, cf[s2], accy[fd], 0, 0, 0);
            }
        }
        {
            const float el = __expf(al);
#pragma unroll
            for (int fd = 0; fd < 4; ++fd) accy[fd] *= el;
        }
        for (int q = 0; 2 * q <= wave; ++q) {
            h16x8 pf;
#pragma unroll
            for (int e = 0; e < 2; ++e) {
                const int f = 2 * q + e;
                f32x4 sa = {0.f, 0.f, 0.f, 0.f};
                if (f <= wave) {
                    const int s = 16 * f + fr;
#pragma unroll
                    for (int s2 = 0; s2 < 2; ++s2) {
                        const h16x8 bf = *(const LAS h16x8*)(Bn + s * 128 + (((4 * s2 + fq) ^ (s & 7)) << 4));
                        sa = __builtin_amdgcn_mfma_f32_16x16x32_f16(bf, cf[s2], sa, 0, 0, 0);
                    }
                    const f32x4 as = *(const LAS f32x4*)(acs + 16 * f + 4 * fq);
#pragma unroll
                    for (int r = 0; r < 4; ++r) { const int ss = 16 * f + 4 * fq + r; sa[r] = (ss <= l) ? sa[r] * __expf(al - as[r]) : 0.f; }
                }
#pragma unroll
                for (int r = 0; r < 4; ++r) pf[4 * e + r] = (h16)sa[r];
            }
#pragma unroll
            for (int fd = 0; fd < 4; ++fd) {
                const int pp = 16 * fd + fr;
                const h16x4 lo = *(const LAS h16x4*)(xdtT + pp * 256 + (((4 * q + (fq >> 1)) ^ (pp & 15)) << 4) + (fq & 1) * 8);
                const h16x4 hi = *(const LAS h16x4*)(xdtT + pp * 256 + (((4 * q + 2 + (fq >> 1)) ^ (pp & 15)) << 4) + (fq & 1) * 8);
                h16x8 xf; xf[0] = lo[0]; xf[1] = lo[1]; xf[2] = lo[2]; xf[3] = lo[3]; xf[4] = hi[0]; xf[5] = hi[1]; xf[6] = hi[2]; xf[7] = hi[3];
                accy[fd] = __builtin_amdgcn_mfma_f32_16x16x32_f16(xf, pf, accy[fd], 0, 0, 0);
            }
        }
        {
            float* yo = ssdy + (size_t)(r0 + sg * l) * 512 + h * 64 + 4 * fq;
#pragma unroll
            for (int fd = 0; fd < 4; ++fd) *(f32x4*)(yo + 16 * fd) = accy[fd];
        }
        {
            const float cd = __expf(acs[127]);
            const int nn = 16 * fn + fr;
#pragma unroll
            for (int e = 0; e < 2; ++e) {
                const int pp = 16 * (fp0 + e) + fr;
                f32x4 st = {0.f, 0.f, 0.f, 0.f};
#pragma unroll
                for (int ks = 0; ks < 4; ++ks) {
                    const h16x8 bf = *(const LAS h16x8*)(BdT + nn * 256 + (((4 * ks + fq) ^ (nn & 15)) << 4));
                    const h16x8 xf = *(const LAS h16x8*)(xdtT + pp * 256 + (((4 * ks + fq) ^ (pp & 15)) << 4));
                    st = __builtin_amdgcn_mfma_f32_16x16x32_f16(bf, xf, st, 0, 0, 0);
                }
                hst[e] = hst[e] * cd + st;
            }
        }
        __syncthreads();
#pragma unroll
        for (int e = 0; e < 2; ++e) {
            const int pp = 16 * (fp0 + e) + fr;
            *(LAS h16x4*)(himg + pp * 128 + (((2 * fn + (fq >> 1)) ^ (pp & 7)) << 4) + (fq & 1) * 8) = cvt4(hst[e]);
        }
    }
#undef SSD_PREFETCH
    if (!lat) {
#pragma unroll
        for (int e = 0; e < 2; ++e) {
            const int pp = 16 * (fp0 + e) + fr, n0 = 16 * fn + 4 * fq;
            *(f32x4*)(p.out + (dir ? O_SSDB : O_SSDF) + sbase + pp * 64 + n0) = hst[e];
        }
    }
    __syncthreads();
}
__device__ __forceinline__ int next_unit(const Params& p, const Ctx& c, int q) {
    volatile LAS int* slot = (volatile LAS int*)(c.lds + LDS_MISC + 64);
    __syncthreads();
    if (c.tid == 0) *slot = (int)atomicAdd((unsigned*)(p.ws + WS_CTL) + 4096 + 64 * q, 1u);
    __syncthreads();
    return *slot;
}
__device__ __forceinline__ void phase_mix0(const Params& p, const Ctx& c, int q) {
    for (int u = next_unit(p, c, q); u < 672 + N_CONV_UNITS; u = next_unit(p, c, q)) {
        if (u >= 672) { if (q == 0) conv_unit(p, c, u - 672); continue; }
        if (u < 32) ssd_unit(p, c, true, u >> 4, (u >> 1) & 7, u & 1);
        else if (u < 160) { const int v = u - 32; attn_unit(p, c, true, v >> 6, (v >> 5) & 1, v & 31); }
        else if (u < 416) { const int v = u - 160; ssd_unit(p, c, false, v >> 4, (v >> 1) & 7, v & 1); }
        else { const int v = u - 416; attn_unit(p, c, false, v >> 4, (v >> 3) & 1, v & 7); }
    }
}

constexpr int RW_SLOT = 12544, RW_NS = 5, RW_PF = 4;
__device__ __forceinline__ void rwkv_unit(const Params& p, const Ctx& c, bool lat, int b, int h) {
    const int lane = c.lane, wave = c.wave;
    const int dir = wave >> 2, q = wave & 3, fr = lane & 15, g = lane >> 4;
    const int T = lat ? 1024 : 256, rowbase = lat ? NCTX + b * 1024 : b * 256, nchunk = T / 16;
    const unsigned char* kapg = p.ws + WS_DEC16 + (size_t)dir * NTOK * D * 2; const unsigned char* rhg = p.ws + WS_A16 + (size_t)dir * NTOK * D * 2;
    const unsigned char* vg = p.ws + WS_V16;
    h16* y16 = (h16*)(p.ws + WS_Y16) + (size_t)dir * NTOK * D;
    LAS unsigned char* ring = c.lds + dir * (RW_NS * RW_SLOT);
    f32x4 St[4];
    const size_t soff = ((size_t)(b * 16 + h) * 64 + 16 * q + fr) * 64 + 4 * g;
#pragma unroll
    for (int f = 0; f < 4; ++f) St[f] = lat ? *(const f32x4*)((dir ? p.in[I_RWB] : p.in[I_RWF]) + soff + 16 * f) : (f32x4){0.f, 0.f, 0.f, 0.f};
    const int e0 = q * 64 + lane;
    auto issue = [&](int ck) {
        const int rbg = (rowbase >> 4) + (dir ? nchunk - 1 - ck : ck), row0 = rbg * 16;
        LAS unsigned char* slot = ring + (ck % RW_NS) * RW_SLOT;
        const unsigned char* item = p.ws + WS_OPS2 + (size_t)((dir * 384 + rbg) * 16 + h) * OPS2_ITEM;
        {
            const int e = e0 & 127, t = e >> 3, pc = e & 7;
            const unsigned char* s_ = (e0 < 128 ? kapg : rhg) + ((size_t)(row0 + t) * D + h * 64) * 2 + pc * 16;
            __builtin_amdgcn_global_load_lds((const unsigned*)s_, (LAS unsigned*)(slot + q * 1024), 16, 0, 0);
        }
        __builtin_amdgcn_global_load_lds((const unsigned*)(item + e0 * 16), (LAS unsigned*)(slot + 4096 + q * 1024), 16, 0, 0);
        {
            const int e = e0;
            const unsigned char* s_;
            if (e < 144) s_ = item + 4096 + e * 16;
            else { const int ve = e - 144, t = ve >> 3, pc = ve & 7; s_ = vg + ((size_t)(row0 + (dir ? 15 - t : t)) * D + h * 64) * 2 + pc * 16; }
            __builtin_amdgcn_global_load_lds((const unsigned*)s_, (LAS unsigned*)(slot + 8192 + q * 1024), 16, 0, 0);
        }
        if (q == 0 && lane < 16) {
            const int ve = 112 + lane, t = ve >> 3, pc = ve & 7;
            const unsigned char* s_ = vg + ((size_t)(row0 + (dir ? 15 - t : t)) * D + h * 64) * 2 + pc * 16;
            __builtin_amdgcn_global_load_lds((const unsigned*)s_, (LAS unsigned*)(slot + 12288), 16, 0, 0);
        }
    };
    __syncthreads();
    for (int ck = 0; ck < RW_PF && ck < nchunk; ++ck) issue(ck);
    for (int ck = 0; ck < nchunk; ++ck) {
        if (ck + RW_PF > nchunk) asm volatile("s_waitcnt vmcnt(0)" ::: "memory");
        else if (q == 0) asm volatile("s_waitcnt vmcnt(12)" ::: "memory");
        else asm volatile("s_waitcnt vmcnt(9)" ::: "memory");
        asm volatile("s_waitcnt lgkmcnt(0)" ::: "memory");
        __builtin_amdgcn_s_barrier();
        asm volatile("" ::: "memory");
        if (ck + RW_PF < nchunk) issue(ck + RW_PF);
        const LAS unsigned char* slot = ring + (ck % RW_NS) * RW_SLOT;
        const int rbg = (rowbase >> 4) + (dir ? nchunk - 1 - ck : ck), row0 = rbg * 16;
        h16x8 Sh[2];
#pragma unroll
        for (int s = 0; s < 2; ++s)
#pragma unroll
            for (int r = 0; r < 4; ++r) { Sh[s][r] = (h16)St[2 * s][r]; Sh[s][4 + r] = (h16)St[2 * s + 1][r]; }
        const h16x8 ka0 = *(const LAS h16x8*)(slot + (fr * 4 + g) * 32), ka1 = *(const LAS h16x8*)(slot + (fr * 4 + g) * 32 + 16);
        const h16x8 rh0 = *(const LAS h16x8*)(slot + 2048 + (fr * 4 + g) * 32), rh1 = *(const LAS h16x8*)(slot + 2048 + (fr * 4 + g) * 32 + 16);
        const h16x4 a1 = *(const LAS h16x4*)(slot + 8192 + (fr * 4 + g) * 8), t4 = *(const LAS h16x4*)(slot + 8704 + (fr * 4 + g) * 8);
        const h16x8 nn = *(const LAS h16x8*)(slot + 9216 + (fr * 4 + g) * 16);
        h16x8 vu, a1op, top;
#pragma unroll
        for (int jj = 0; jj < 4; ++jj) {
            vu[jj] = *(const LAS h16*)(slot + 10496 + (4 * g + jj) * 128 + (16 * q + fr) * 2);
            a1op[jj] = a1[jj]; a1op[4 + jj] = (h16)0.f; top[jj] = t4[jj]; top[4 + jj] = (h16)0.f; vu[4 + jj] = (h16)0.f;
        }
        f32x4 X = {0.f, 0.f, 0.f, 0.f};
        X = __builtin_amdgcn_mfma_f32_16x16x32_f16(ka0, Sh[0], X, 0, 0, 0);
        X = __builtin_amdgcn_mfma_f32_16x16x32_f16(ka1, Sh[1], X, 0, 0, 0);
        X = __builtin_amdgcn_mfma_f32_16x16x32_f16(a1op, vu, X, 0, 0, 0);
        h16x8 xo;
#pragma unroll
        for (int r = 0; r < 4; ++r) { xo[r] = (h16)X[r]; xo[4 + r] = (h16)0.f; }
        f32x4 U = {0.f, 0.f, 0.f, 0.f};
        U = __builtin_amdgcn_mfma_f32_16x16x32_f16(top, xo, U, 0, 0, 0);
#pragma unroll
        for (int r = 0; r < 4; ++r) vu[4 + r] = (h16)(-U[r]);
        f32x4 Y = {0.f, 0.f, 0.f, 0.f};
        Y = __builtin_amdgcn_mfma_f32_16x16x32_f16(rh0, Sh[0], Y, 0, 0, 0);
        Y = __builtin_amdgcn_mfma_f32_16x16x32_f16(rh1, Sh[1], Y, 0, 0, 0);
        Y = __builtin_amdgcn_mfma_f32_16x16x32_f16(nn, vu, Y, 0, 0, 0);
#pragma unroll
        for (int f = 0; f < 4; ++f) {
            const f32x4 gc = *(const LAS f32x4*)(slot + 10240 + (16 * f + 4 * g) * 4);
            const h16x8 kb = *(const LAS h16x8*)(slot + 4096 + ((f * 16 + fr) * 4 + g) * 16);
            St[f] = __builtin_amdgcn_mfma_f32_16x16x32_f16(kb, vu, St[f] * gc, 0, 0, 0);
        }
#pragma unroll
        for (int r = 0; r < 4; ++r) { const int t = 4 * g + r; y16[(size_t)(row0 + (dir ? 15 - t : t)) * D + h * 64 + 16 * q + fr] = (h16)Y[r]; }
    }
    if (!lat) {
#pragma unroll
        for (int f = 0; f < 4; ++f) *(f32x4*)(p.out + (dir ? O_RWB : O_RWF) + soff + 16 * f) = St[f];
    }
    asm volatile("s_waitcnt vmcnt(0) lgkmcnt(0)" ::: "memory");
    __syncthreads();
}
__device__ __forceinline__ void phase_rwkvscan(const Params& p, const Ctx& c, int qn) {
    for (int u = next_unit(p, c, qn); u < 288; u = next_unit(p, c, qn)) {
        if (u < 32) rwkv_unit(p, c, true, u >> 4, u & 15);
        else { const int v = u - 32; rwkv_unit(p, c, false, v >> 4, v & 15); }
    }
}

__device__ __forceinline__ const float* ada_chunk(const Params& p, int layer, int row, int chunk) {
    return (const float*)(p.ws + WS_ADA) + (size_t)(layer * 3 + stream_of(row)) * 6144 + chunk * 1024;
}
__device__ __forceinline__ void phase_gemm_inproj(const Params& p, const Ctx& c) {
    float* proj = (float*)(p.ws + WS_PROJ);
    const float* rc = (const float*)(p.ws + WS_ROPE); const float* rs = rc + 32768;
    const int fr = c.lane & 15, fq = c.lane >> 4, wm = c.wave >> 1, wn = c.wave & 1;
    for (int u = c.bid; u < 24 * 17; u += c.G) {
        const int pm = u % 24, pn = u / 24;
        GemmTile g{(const h16*)(p.ws + WS_HA), D, (const h16*)(p.ws + WS_WIN), D, D, pm * 256, pn * 128};
        f32x4 acc[4][4]; gemm_tile<256>(c, g, acc);
        if (pn >= 6) {
#pragma unroll
            for (int i = 0; i < 4; ++i)
#pragma unroll
                for (int j = 0; j < 4; ++j)
                    *(f32x4*)(proj + (size_t)(g.m0 + wm * 64 + 16 * i + fr) * PROJ_LD + g.n0 + wn * 64 + 16 * j + 4 * fq) = acc[i][j];
            continue;
        }
#pragma unroll
        for (int i = 0; i < 4; ++i) {
            const int row = g.m0 + wm * 64 + 16 * i + fr;
            const bool lat = row >= NCTX;
            const int r2 = lat ? row - NCTX : row;
            const int b = lat ? (r2 >> 10) : (r2 >> 8), t = lat ? (r2 & 1023) : (r2 & 255);
            if (pn < 5) {
                float ss = 0.f;
#pragma unroll
                for (int j = 0; j < 4; ++j) ss += acc[i][j][0] * acc[i][j][0] + acc[i][j][1] * acc[i][j][1] + acc[i][j][2] * acc[i][j][2] + acc[i][j][3] * acc[i][j][3];
                ss = rowsum4(ss);
                const float rstd = rsqrtf(ss * (1.f / 64.f) + 1e-6f);
                const float* gw_ = (pn < 4) ? p.in[I_QG] : p.in[I_KG];
                f32x4 xn[4];
#pragma unroll
                for (int j = 0; j < 4; ++j) xn[j] = acc[i][j] * rstd * *(const f32x4*)(gw_ + 16 * j + 4 * fq);
                if (lat) {
#pragma unroll
                    for (int j = 0; j < 2; ++j) {
                        const f32x4 cs = *(const f32x4*)(rc + t * 32 + 16 * j + 4 * fq), sn = *(const f32x4*)(rs + t * 32 + 16 * j + 4 * fq);
                        const f32x4 x1 = xn[j], x2 = xn[j + 2];
                        xn[j] = x1 * cs - x2 * sn; xn[j + 2] = x1 * sn + x2 * cs;
                    }
                }
                if (pn < 4) {
                    h16* q16 = (h16*)(p.ws + WS_Q16) + (size_t)row * 512 + (2 * pn + wn) * 64 + 4 * fq;
#pragma unroll
                    for (int j = 0; j < 4; ++j) *(h16x4*)(q16 + 16 * j) = cvt4(xn[j] * 0.125f);
                } else {
                    h16* kd = lat ? (h16*)(p.ws + WS_K16L) + ((size_t)(b * 2 + wn) * 1280 + 256 + t) * 64 + 4 * fq
                                  : (h16*)(p.ws + WS_K16C) + ((size_t)(b * 2 + wn) * 256 + t) * 64 + 4 * fq;
#pragma unroll
                    for (int j = 0; j < 4; ++j) {
                        *(h16x4*)(kd + 16 * j) = cvt4(xn[j]);
                        if (!lat) *(f32x4*)(p.out + O_K + (size_t)row * 128 + wn * 64 + 16 * j + 4 * fq) = xn[j];
                    }
                }
            } else {
                h16* vt = lat ? (h16*)(p.ws + WS_VT16L) + (size_t)(b * 2 + wn) * 64 * 1280 + 256 + t
                              : (h16*)(p.ws + WS_VT16C) + (size_t)(b * 2 + wn) * 64 * 256 + t;
                const int ld = lat ? 1280 : 256;
#pragma unroll
                for (int j = 0; j < 4; ++j) {
#pragma unroll
                    for (int r = 0; r < 4; ++r) vt[(size_t)(16 * j + 4 * fq + r) * ld] = (h16)acc[i][j][r];
                    if (!lat) *(f32x4*)(p.out + O_V + (size_t)row * 128 + wn * 64 + 16 * j + 4 * fq) = acc[i][j];
                }
            }
        }
    }
}
__device__ __forceinline__ void phase_gemm_res(const Params& p, const Ctx& c, const h16* A, int lda, const h16* Bt, int K, int layer, int gate_chunk, bool init, bool dry, bool ffn_pre) {
    float* X = (float*)(p.ws + WS_X);
    float* Xw = dry ? (float*)(p.ws + WS_PROJ) : X;
    const int fr = c.lane & 15, fq = c.lane >> 4, wm = c.wave >> 1, wn = c.wave & 1;
    for (int u = c.bid; u < 32 * 8; u += c.G) {
        const int pm = u & 31, pn = u >> 5;
        GemmTile g{A, lda, Bt, K, K, pm * 192, pn * 128};
        f32x4 acc[3][4]; gemm_tile<192>(c, g, acc);
#pragma unroll
        for (int i = 0; i < 3; ++i) {
            const int row = g.m0 + wm * 48 + 16 * i + fr;
            const float* gt = ada_chunk(p, layer, row, gate_chunk);
            const float* base = init ? xin_row(p, row) : X + (size_t)row * D;
            float ss = 0.f;
            const float* scp = ada_chunk(p, layer, row, 4);
#pragma unroll
            for (int j = 0; j < 4; ++j) {
                const int col = g.n0 + wn * 64 + 16 * j + 4 * fq;
                const f32x4 xn = *(const f32x4*)(base + col) + *(const f32x4*)(gt + col) * acc[i][j];
                *(f32x4*)(Xw + (size_t)row * D + col) = xn;
                if (ffn_pre) {
                    ss += xn[0] * xn[0] + xn[1] * xn[1] + xn[2] * xn[2] + xn[3] * xn[3];
                    const f32x4 pre = xn * *(const f32x4*)(p.in[I_NFG] + layer * 1024 + col) * (*(const f32x4*)(scp + col) + 1.f);
                    *(h16x4*)((h16*)(p.ws + (layer ? WS_XMIX : WS_HA)) + (size_t)row * D + col) = cvt4(pre);
                }
            }
            if (ffn_pre) { ss = rowsum4(ss); if (fq == 0 && !dry) atomicAdd((float*)(p.ws + WS_ROWSS) + layer * NTOK + row, ss); }
        }
    }
}
__device__ __forceinline__ void phase_gemm_gu(const Params& p, const Ctx& c, int layer) {
    h16* hid = (h16*)(p.ws + WS_HID);
    const int fr = c.lane & 15, fq = c.lane >> 4, wm = c.wave >> 1, wn = c.wave & 1;
    for (int u = c.bid; u < 24 * 44; u += c.G) {
        const int pm = u % 24, pn = u / 24;
        GemmTile g{(const h16*)(p.ws + (layer ? WS_XMIX : WS_HA)), D, (const h16*)(p.ws + WS_WGU) + (size_t)layer * 5632 * 1024, D, D, pm * 256, pn * 128};
        f32x4 acc[4][4]; gemm_tile<256>(c, g, acc);
        const int hc0 = (g.n0 + wn * 64) / 2 + 4 * fq, nb0 = g.n0 + wn * 64 + 4 * fq;
#pragma unroll
        for (int i = 0; i < 4; ++i) {
            const int row = g.m0 + wm * 64 + 16 * i + fr;
            const float rstd = rsqrtf(((const float*)(p.ws + WS_ROWSS))[layer * NTOK + row] * (1.f / 1024.f) + 1e-6f);
            const float* fb = (const float*)(p.ws + WS_FBIAS) + (size_t)(layer * 3 + stream_of(row)) * 5632 + nb0;
#pragma unroll
            for (int j = 0; j < 2; ++j) {
                const f32x4 bg = *(const f32x4*)(fb + 16 * j), bu = *(const f32x4*)(fb + 16 * (j + 2));
                f32x4 o;
#pragma unroll
                for (int r = 0; r < 4; ++r) o[r] = silu_f(acc[i][j][r] * rstd + bg[r]) * (acc[i][j + 2][r] * rstd + bu[r]);
                *(h16x4*)(hid + (size_t)row * FF + hc0 + 16 * j) = cvt4(o);
            }
        }
    }
}
__device__ __forceinline__ void phase_gemm_rkv(const Params& p, const Ctx& c) {
    h16* lora = (h16*)(p.ws + WS_LORA16);
    const h16* xm = (const h16*)(p.ws + WS_XMIX);
    const int fr = c.lane & 15, fq = c.lane >> 4, wm = c.wave >> 1, wn = c.wave & 1;
    for (int u = c.bid; u < 24 * 27; u += c.G) {
        const int pm = u % 24, pn = u / 24;
        const int ai = pn < 8 ? 0 : pn < 16 ? 2 : pn < 24 ? 3 : pn == 24 ? 1 : pn == 25 ? 4 : 5;
        GemmTile g{xm + (size_t)ai * NTOK * D, D, (const h16*)(p.ws + WS_WRKV), D, D, pm * 256, pn * 128};
        f32x4 acc[4][4]; gemm_tile<256>(c, g, acc);
#pragma unroll
        for (int i = 0; i < 4; ++i) {
            const int row = g.m0 + wm * 64 + 16 * i + fr;
#pragma unroll
            for (int j = 0; j < 4; ++j) {
                const int col = g.n0 + wn * 64 + 16 * j + 4 * fq;
                f32x4 v = acc[i][j];
                if (pn < 24) *(h16x4*)((h16*)(p.ws + (pn < 8 ? WS_R16 : pn < 16 ? WS_K16 : WS_V16)) + (size_t)row * D + (col & 1023)) = cvt4(v);
                else {
                    if (pn == 24) { for (int r = 0; r < 4; ++r) v[r] = 2.f * sigmoid_f(2.f * v[r]) - 1.f; }
                    else if (pn == 26) { for (int r = 0; r < 4; ++r) v[r] = sigmoid_f(v[r]); }
                    *(h16x4*)(lora + (size_t)row * 384 + col - 3072) = cvt4(v);
                }
            }
        }
    }
}
__device__ __forceinline__ void phase_gemm_lora2(const Params& p, const Ctx& c) {
    const h16* lora = (const h16*)(p.ws + WS_LORA16);
    h16* dec16 = (h16*)(p.ws + WS_DEC16); h16* a16 = (h16*)(p.ws + WS_A16); h16* g16 = (h16*)(p.ws + WS_G16);
    const int fr = c.lane & 15, fq = c.lane >> 4, wm = c.wave >> 1, wn = c.wave & 1;
    for (int u = c.bid; u < 24 * 40; u += c.G) {
        const int pm = u % 24, pn = u / 24, gq = pn >> 3, n0 = (pn & 7) * 128;
        const int K = gq < 4 ? 64 : 128;
        const h16* A = lora + (gq < 2 ? 64 * gq : gq < 4 ? 128 + 64 * (gq - 2) : 256);
        const h16* Bt = gq < 2 ? (const h16*)(p.ws + WS_W2T) + (size_t)gq * 65536 : gq < 4 ? (const h16*)(p.ws + WS_A2T) + (size_t)(gq - 2) * 65536 : (const h16*)(p.ws + WS_G2T);
        GemmTile g{A, 384, Bt, K, K, pm * 256, n0};
        f32x4 acc[4][4]; gemm_tile<256>(c, g, acc);
#pragma unroll
        for (int i = 0; i < 4; ++i) {
            const int row = g.m0 + wm * 64 + 16 * i + fr;
#pragma unroll
            for (int j = 0; j < 4; ++j) {
                const int col = n0 + wn * 64 + 16 * j + 4 * fq;
                f32x4 v = acc[i][j];
                if (gq < 2) {
                    const f32x4 w0 = *(const f32x4*)(p.in[I_W0] + gq * 1024 + col);
                    for (int r = 0; r < 4; ++r) { const float wl = w0[r] + v[r]; const float uu = 0.60653066f * sigmoid_f(wl); v[r] = 1.f - __expf(-uu); }
                    *(h16x4*)(dec16 + ((size_t)gq * NTOK + row) * D + col) = cvt4(v);
                } else if (gq < 4) {
                    const f32x4 a0 = *(const f32x4*)(p.in[I_A0] + (gq - 2) * 1024 + col);
                    for (int r = 0; r < 4; ++r) v[r] = sigmoid_f(a0[r] + v[r]);
                    *(h16x4*)(a16 + ((size_t)(gq - 2) * NTOK + row) * D + col) = cvt4(v);
                } else *(h16x4*)(g16 + (size_t)row * D + col) = cvt4(v);
            }
        }
    }
}

#ifdef ONLY_PHASE
#define PH_ON(k) ((k) == ONLY_PHASE)
#else
#define PH_ON(k) true
#endif
#ifndef REP_MASK
#define REP_MASK 0u
#endif
#define NREP(k) (((REP_MASK >> (k)) & 1u) ? 2 : 1)
#define PHASE(k, call) do { if (PH_ON(k) && lo <= (k) && (k) < hi) { _Pragma("unroll") for (int rep = NREP(k) - 1; rep >= 0; --rep) { const bool dry = rep > 0; (void)dry; call; if ((k) + 1 < hi || dry) xcd_barrier(bar); } } } while (0)

__global__ void __launch_bounds__(NTHREADS, 2) mk_fwd(Params p) {
    extern __shared__ __attribute__((aligned(16))) unsigned char lds_raw[];
    Ctx c;
    c.lds = (LAS unsigned char*)lds_raw;
    c.tid = threadIdx.x; c.lane = c.tid & 63; c.wave = __builtin_amdgcn_readfirstlane(c.tid >> 6);
    c.bid = blockIdx.x; c.G = gridDim.x;
    volatile LAS unsigned* misc = (volatile LAS unsigned*)(c.lds + LDS_MISC);
    if (c.tid < 64) misc[c.tid] = 0u;
    __syncthreads();
    const int lo = p.ph_lo, hi = p.ph_hi;
    XcdBarrier bar; bar.bar = (unsigned*)(p.ws + WS_CTL); bar.x = 0; bar.st = nullptr;
    if (hi - lo > 1) bar = xcd_barrier_post((unsigned*)(p.ws + WS_CTL), misc + 8);
    PHASE(0, phase0(p, c));
    PHASE(1, phase_normmod(p, c, true, p.in[I_NMG], 0, 0, 1));
    PHASE(2, phase_gemm_inproj(p, c));
    PHASE(3, phase_postproj(p, c));
    PHASE(4, phase_mix0(p, c, dry ? 2 : 0));
    PHASE(5, phase_ssdcombine(p, c));
    PHASE(6, phase_gemm_res(p, c, (const h16*)(p.ws + WS_CAT), D, (const h16*)(p.ws + WS_WOUT), D, 0, 2, true, dry, true));
    PHASE(8, phase_gemm_gu(p, c, 0));
    PHASE(9, phase_gemm_res(p, c, (const h16*)(p.ws + WS_HID), FF, (const h16*)(p.ws + WS_WDN), FF, 0, 5, false, dry, false));
    PHASE(10, phase_rwkvmix(p, c));
    PHASE(11, phase_gemm_rkv(p, c));
    PHASE(12, phase_gemm_lora2(p, c));
    PHASE(13, phase_rwkvprep(p, c));
    PHASE(14, phase_rwkvscan(p, c, dry ? 3 : 1));
    PHASE(15, phase_rwkvpost(p, c));
    PHASE(16, phase_gemm_res(p, c, (const h16*)(p.ws + WS_HA), D, (const h16*)(p.ws + WS_WO), D, 1, 2, false, dry, true));
    PHASE(18, phase_gemm_gu(p, c, 1));
    PHASE(19, phase_gemm_res(p, c, (const h16*)(p.ws + WS_HID), FF, (const h16*)(p.ws + WS_WDN) + (size_t)1024 * 2816, FF, 1, 5, false, dry, false));
    PHASE(20, phase_final(p, c));
}

extern "C" void kernel_launch(void* const* d_in, const int* in_sizes, int n_in, void* d_out, int out_size, void* d_ws, size_t ws_size, hipStream_t stream) {
    static int grid = 0;
    if (grid == 0) {
        if (n_in != 46 || ws_size < WS_END) { fprintf(stderr, "kernel_launch: unexpected n_in %d or ws_size %zu\n", n_in, ws_size); grid = -1; return; }
        int dev = 0, cus = 0, per_cu = 0;
        (void)hipGetDevice(&dev);
        (void)hipDeviceGetAttribute(&cus, hipDeviceAttributeMultiprocessorCount, dev);
        if (hipFuncSetAttribute((const void*)mk_fwd, hipFuncAttributeMaxDynamicSharedMemorySize, LDS_BYTES) != hipSuccess) { fprintf(stderr, "kernel_launch: hipFuncSetAttribute failed\n"); grid = -1; return; }
        if (hipOccupancyMaxActiveBlocksPerMultiprocessor(&per_cu, (const void*)mk_fwd, NTHREADS, LDS_BYTES) != hipSuccess || per_cu < 1) { fprintf(stderr, "kernel_launch: occupancy query says %d\n", per_cu); }
        (void)hipGetLastError();
        grid = cus;
    }
    if (grid < 0) return;
    (void)hipMemsetAsync((char*)d_ws + WS_CTL, 0, CTL_ZERO_BYTES, stream);
    Params p{};
    for (int i = 0; i < 46; ++i) p.in[i] = (const float*)d_in[i];
    p.out = (float*)d_out; p.ws = (unsigned char*)d_ws;
#if MK_N_LAUNCHES == 1
    p.ph_lo = 0; p.ph_hi = NPH;
    hipLaunchKernelGGL(mk_fwd, dim3(grid), dim3(NTHREADS), LDS_BYTES, stream, p);
#else
    for (int ph = 0; ph < NPH; ++ph) { p.ph_lo = ph; p.ph_hi = ph + 1; hipLaunchKernelGGL(mk_fwd, dim3(grid), dim3(NTHREADS), LDS_BYTES, stream, p); }
#endif
}
```

```cpp
#include <hip/hip_runtime.h>
#include <cstdio>
#include <cstdint>

#ifndef MK_N_LAUNCHES
#define MK_N_LAUNCHES 1
#endif

#define LAS __attribute__((address_space(3)))
#define GAS __attribute__((address_space(1)))
typedef _Float16 h16;
typedef _Float16 h16x2 __attribute__((ext_vector_type(2)));
typedef _Float16 h16x4 __attribute__((ext_vector_type(4)));
typedef _Float16 h16x8 __attribute__((ext_vector_type(8)));
typedef float f32x4 __attribute__((ext_vector_type(4)));
typedef float f32x2 __attribute__((ext_vector_type(2)));
typedef unsigned u32x4 __attribute__((ext_vector_type(4)));

constexpr int D = 1024, NTOK = 6144, NCTX = 4096, FF = 2816;
constexpr int PROJ_LD = 2176;
constexpr int NPH = 21;
constexpr int NWAVES = 8, NTHREADS = 512;

constexpr size_t MiB = 1u << 20;
constexpr size_t WS_CTL = 0, CTL_ZERO_BYTES = 32768;
constexpr size_t WS_WIN = 1 * MiB;
constexpr size_t WS_WOUT = 6 * MiB;
constexpr size_t WS_WGU = 8 * MiB;
constexpr size_t WS_WDN = 30 * MiB;
constexpr size_t WS_WRKV = 41 * MiB;
constexpr size_t WS_WO = 48 * MiB;
constexpr size_t WS_W2T = 50 * MiB;
constexpr size_t WS_A2T = WS_W2T + 262144;
constexpr size_t WS_G2T = WS_A2T + 262144;
constexpr size_t WS_ADA = 51 * MiB;
constexpr size_t WS_ROPE = WS_ADA + 262144;
constexpr size_t WS_ROWSS = WS_ADA + 524288;
constexpr size_t WS_FBIAS = WS_ADA + 589824;
constexpr size_t WS_X = 52 * MiB;
constexpr size_t WS_HA = 76 * MiB;
constexpr size_t WS_HID = 88 * MiB;
constexpr size_t WS_PROJ = 121 * MiB;
constexpr size_t WS_Q16 = 172 * MiB;
constexpr size_t WS_K16C = 178 * MiB;
constexpr size_t WS_VT16C = 179 * MiB;
constexpr size_t WS_K16L = 180 * MiB;
constexpr size_t WS_VT16L = 181 * MiB;
constexpr size_t WS_CAT = 182 * MiB;
constexpr size_t WS_XBC = 194 * MiB;
constexpr size_t WS_DT = 212 * MiB;
constexpr size_t WS_DA = WS_DT + 6144 * 16 * 4;
constexpr size_t WS_SSDY = 213 * MiB;
constexpr size_t WS_G16 = 1 * MiB;
constexpr size_t WS_BONUS = 13 * MiB;
constexpr size_t WS_LORA16 = 76 * MiB;
constexpr size_t WS_R16 = 88 * MiB;
constexpr size_t WS_K16 = 100 * MiB;
constexpr size_t WS_Y16 = 88 * MiB;
constexpr size_t WS_V16 = 112 * MiB;
constexpr size_t WS_XMIX = 124 * MiB;
constexpr size_t WS_DEC16 = 124 * MiB;
constexpr size_t WS_A16 = 148 * MiB;
constexpr size_t WS_OPS2 = 172 * MiB;
constexpr size_t OPS2_ITEM = 6400;
constexpr size_t WS_END = 256 * MiB;

constexpr size_t O_Y = 0, O_K = 6291456, O_V = 6815744, O_SSDF = 7340032, O_SSDB = 7864320, O_RWF = 8388608, O_RWB = 9437184;

constexpr int LDS_BYTES = 148480;
constexpr int LDS_MISC = 147456;

struct Params {
    const float* in[46];
    float* out;
    unsigned char* ws;
    int ph_lo, ph_hi;
};
enum { I_XP = 0, I_XS, I_CK, I_CV, I_SSDF, I_SSDB, I_RWF, I_RWB, I_C, I_CCTX, I_MODW, I_MODB, I_NMG, I_NFG, I_WG, I_WU, I_WD,
       I_WIN, I_WOUT, I_QG, I_KG, I_CONVW, I_CONVB, I_DTB, I_ALOG, I_SSDD, I_SSDG, I_MU, I_WR, I_WK, I_WV, I_W0, I_W1, I_W2,
       I_A0, I_A1, I_A2, I_G1, I_G2, I_KKW, I_KA, I_RK, I_LNG, I_LNB, I_WO, I_FNG };

struct Ctx { int tid, lane, wave, bid, G; LAS unsigned char* lds; };

__device__ __forceinline__ float wave_sum(float v) {
#pragma unroll
    for (int o = 1; o < 64; o <<= 1) v += __shfl_xor(v, o);
    return v;
}
__device__ __forceinline__ float sigmoid_f(float x) { return __builtin_amdgcn_rcpf(1.f + __expf(-x)); }
__device__ __forceinline__ float silu_f(float x) { return x * sigmoid_f(x); }
__device__ __forceinline__ float softplus_f(float x) { return fmaxf(x, 0.f) + log1pf(__expf(-fabsf(x))); }
__device__ __forceinline__ int stream_of(int row) { return row < NCTX ? 0 : 1 + ((row - NCTX) >> 10); }
__device__ __forceinline__ h16x4 cvt4(f32x4 v) { h16x4 o; o.x = (h16)v.x; o.y = (h16)v.y; o.z = (h16)v.z; o.w = (h16)v.w; return o; }

template <int M> __device__ __forceinline__ void fmac_bc(float& d, float a, float b) {
    asm("v_fmac_f32_dpp %0, %1, %2 row_newbcast:%3 row_mask:0xf bank_mask:0xf" : "+v"(d) : "v"(a), "v"(b), "n"(M));
}
template <int M> __device__ __forceinline__ void fmac_bc_safe(float& d, float a, float b) {
    asm volatile("s_nop 1\n\tv_fmac_f32_dpp %0, %1, %2 row_newbcast:%3 row_mask:0xf bank_mask:0xf\n\ts_nop 1" : "+v"(d) : "v"(a), "v"(b), "n"(M));
}
template <int M> __device__ __forceinline__ void mul_bc(float& d, float a) {
    asm("v_mul_f32_dpp %0, %1, %0 row_newbcast:%2 row_mask:0xf bank_mask:0xf" : "+v"(d) : "v"(a), "n"(M));
}
__device__ __forceinline__ float rowsum4(float x) {
    float a = x, b = x;
    asm volatile("s_nop 1\n\tv_permlane16_swap_b32 %0, %1\n\ts_nop 1" : "+v"(a), "+v"(b));
    x = a + b; a = x; b = x;
    asm volatile("s_nop 1\n\tv_permlane32_swap_b32 %0, %1\n\ts_nop 1" : "+v"(a), "+v"(b));
    return a + b;
}

#define XB_TMO      128
#define XB_XCNT(j)  (256  + 64 * (j))
#define XB_XSUB(j)  (1280 + 64 * (j))
#define XB_XGEN(j)  (2304 + 64 * (j))
#define XB_TOP      3328
#define XB_TOPGEN   3392
#define XCD_BAR_WORDS 3456
#define XB_SPIN_CAP (1u << 22)
__device__ __forceinline__ unsigned xb_ld(unsigned* p)              { return __hip_atomic_load(p, __ATOMIC_RELAXED, __HIP_MEMORY_SCOPE_AGENT); }
__device__ __forceinline__ unsigned xb_add(unsigned* p, unsigned v) { return __hip_atomic_fetch_add(p, v, __ATOMIC_RELAXED, __HIP_MEMORY_SCOPE_AGENT); }
__device__ __forceinline__ unsigned xb_xcc_id() { return (unsigned)__builtin_amdgcn_s_getreg((3 << 11) | 20) & 0xFu; }
#define XB_SPIN(cond, bar) do { unsigned _sp = 0; while (cond) { __builtin_amdgcn_s_sleep(1); \
    if ((++_sp & 255u) == 0u) { if (xb_ld(&(bar)[XB_TMO])) break; if (_sp > XB_SPIN_CAP) { atomicAdd(&(bar)[XB_TMO], 1u); break; } } } } while (0)
struct XcdBarrier { unsigned* bar; unsigned x; volatile LAS unsigned* st; };
__device__ __forceinline__ XcdBarrier xcd_barrier_post(unsigned* bar, volatile LAS unsigned* st) {
    XcdBarrier b; b.bar = bar; b.x = xb_xcc_id(); b.st = st;
    if (threadIdx.x == 0) (void)xb_add(&bar[XB_XCNT(b.x)], 1u);
    return b;
}
__device__ __forceinline__ void xcd_barrier_complete(unsigned* bar, unsigned x, unsigned& nloc, unsigned& nx) {
    const unsigned G = gridDim.x * gridDim.y * gridDim.z;
    unsigned sum, cnt, mine, sp = 0u;
    for (;;) {
        sum = 0u; cnt = 0u; mine = 0u;
#pragma unroll
        for (unsigned j = 0; j < 16; ++j) { const unsigned c = xb_ld(&bar[XB_XCNT(j)]); sum += c; cnt += (c > 0u) ? 1u : 0u; mine = (j == x) ? c : mine; }
        if (sum == G) break;
        __builtin_amdgcn_s_sleep(1);
        if ((++sp & 255u) == 0u) { if (xb_ld(&bar[XB_TMO])) break; if (sp > XB_SPIN_CAP) { atomicAdd(&bar[XB_TMO], 1u); break; } }
    }
    nloc = mine > 0u ? mine : 1u; nx = cnt > 0u ? cnt : 1u;
}
__device__ __forceinline__ void xcd_barrier(const XcdBarrier& b) {
    asm volatile("s_waitcnt vmcnt(0)" ::: "memory");
    __syncthreads();
    if (threadIdx.x == 0) {
        unsigned* bar = b.bar;
        __builtin_amdgcn_s_waitcnt(0);
        unsigned nloc = b.st[0], nx = b.st[1];
        if (nloc == 0u) { xcd_barrier_complete(bar, b.x, nloc, nx); b.st[0] = nloc; b.st[1] = nx; }
        const unsigned old = xb_add(&bar[XB_XSUB(b.x)], 1u);
        const unsigned gen = old / nloc;
        if (old + 1u == (gen + 1u) * nloc) {
            __builtin_amdgcn_fence(__ATOMIC_RELEASE, "agent");
            asm volatile("s_waitcnt vmcnt(0)" ::: "memory");
            const unsigned og = xb_add(&bar[XB_TOP], 1u);
            const unsigned tg = og / nx;
            if (og + 1u == (tg + 1u) * nx) xb_add(&bar[XB_TOPGEN], 1u);
            else XB_SPIN(xb_ld(&bar[XB_TOPGEN]) == tg, bar);
            __builtin_amdgcn_fence(__ATOMIC_ACQUIRE, "agent");
            xb_add(&bar[XB_XGEN(b.x)], 1u);
            asm volatile("s_waitcnt vmcnt(0)" ::: "memory");
        } else {
            XB_SPIN(xb_ld(&bar[XB_XGEN(b.x)]) == gen, bar);
            __builtin_amdgcn_fence(__ATOMIC_ACQUIRE, "agent");
            asm volatile("s_waitcnt vmcnt(0)" ::: "memory");
        }
    }
    __syncthreads();
}

struct GemmTile { const h16* A; int lda; const h16* Bt; int ldb; int K; int m0, n0; };
constexpr int GEMM_STAGE_BYTES = 49152;

template <int BM>
__device__ __forceinline__ void gemm_tile(const Ctx& c, const GemmTile& g, f32x4 (&acc)[BM / 64][4]) {
    constexpr int MF = BM / 64, WM = BM / 4;
    LAS unsigned char* lds = c.lds;
    const int tid = c.tid, lane = c.lane, wave = c.wave;
    const int wm = wave >> 1, wn = wave & 1;
    const int srow = tid >> 3, schunk = (tid & 7) ^ (srow & 7);
    const h16* gA = g.A + (size_t)(g.m0 + srow) * g.lda + schunk * 8;
    const h16* gB = g.Bt + (size_t)(g.n0 + srow) * g.ldb + schunk * 8;
    const size_t stepA = (size_t)64 * g.lda, stepB = (size_t)64 * g.ldb;
    const unsigned ldsw = (unsigned)wave * 1024u;
    const int fr = lane & 15, fq = lane >> 4;
    int offA[2], offB[2];
#pragma unroll
    for (int s = 0; s < 2; ++s) {
        offA[s] = (wm * WM + fr) * 128 + (((s * 4 + fq) ^ (fr & 7)) << 4);
        offB[s] = 32768 + (wn * 64 + fr) * 128 + (((s * 4 + fq) ^ (fr & 7)) << 4);
    }
#pragma unroll
    for (int i = 0; i < MF; ++i)
#pragma unroll
        for (int j = 0; j < 4; ++j) acc[i][j] = (f32x4){0.f, 0.f, 0.f, 0.f};
    const int nk = g.K >> 6;
#define GEMM_STAGE(kt, buf) do { \
        _Pragma("unroll") for (int _p = 0; _p < MF; ++_p) \
            __builtin_amdgcn_global_load_lds((const unsigned*)(gA + _p * stepA + (size_t)(kt) * 64), (LAS unsigned*)(lds + (buf) * GEMM_STAGE_BYTES + _p * 8192 + ldsw), 16, 0, 0); \
        _Pragma("unroll") for (int _p = 0; _p < 2; ++_p) \
            __builtin_amdgcn_global_load_lds((const unsigned*)(gB + _p * stepB + (size_t)(kt) * 64), (LAS unsigned*)(lds + (buf) * GEMM_STAGE_BYTES + 32768 + _p * 8192 + ldsw), 16, 0, 0); \
    } while (0)
    GEMM_STAGE(0, 0);
    if (nk > 1) GEMM_STAGE(1, 1);
    int cur = 0;
    for (int kt = 0; kt < nk; ++kt) {
        if (kt + 1 < nk) { if (MF == 4) asm volatile("s_waitcnt vmcnt(6)" ::: "memory"); else asm volatile("s_waitcnt vmcnt(5)" ::: "memory"); }
        else asm volatile("s_waitcnt vmcnt(0)" ::: "memory");
        asm volatile("s_waitcnt lgkmcnt(0)" ::: "memory");
        __builtin_amdgcn_s_barrier();
        asm volatile("" ::: "memory");
        if (kt + 2 < nk) { const int nb = cur >= 1 ? cur - 1 : 2; GEMM_STAGE(kt + 2, nb); }
        const LAS unsigned char* lb = lds + cur * GEMM_STAGE_BYTES;
#pragma unroll
        for (int s = 0; s < 2; ++s) {
            h16x8 af[MF], bf[4];
#pragma unroll
            for (int i = 0; i < MF; ++i) af[i] = *(const LAS h16x8*)(lb + offA[s] + i * 2048);
#pragma unroll
            for (int j = 0; j < 4; ++j) bf[j] = *(const LAS h16x8*)(lb + offB[s] + j * 2048);
#pragma unroll
            for (int i = 0; i < MF; ++i)
#pragma unroll
                for (int j = 0; j < 4; ++j) acc[i][j] = __builtin_amdgcn_mfma_f32_16x16x32_f16(bf[j], af[i], acc[i][j], 0, 0, 0);
        }
        cur = cur == 2 ? 0 : cur + 1;
    }
    asm volatile("s_waitcnt lgkmcnt(0)" ::: "memory");
    __builtin_amdgcn_s_barrier();
    asm volatile("" ::: "memory");
#undef GEMM_STAGE
}

constexpr int GEMMW_STAGE = 57344;
__device__ __forceinline__ void gemm_tile_wide(const Ctx& c, const GemmTile& g, f32x4 (&acc)[3][8]) {
    LAS unsigned char* lds = c.lds;
    const int tid = c.tid, lane = c.lane, wave = c.wave;
    const int wm = wave >> 1, wn = wave & 1;
    const int srow = tid >> 3, schunk = (tid & 7) ^ (srow & 7);
    const h16* gA = g.A + (size_t)(g.m0 + srow) * g.lda + schunk * 8;
    const h16* gB = g.Bt + (size_t)(g.n0 + srow) * g.ldb + schunk * 8;
    const size_t stepA = (size_t)64 * g.lda, stepB = (size_t)64 * g.ldb;
    const unsigned ldsw = (unsigned)wave * 1024u;
    const int fr = lane & 15, fq = lane >> 4;
    int offA[2], offB[2];
#pragma unroll
    for (int s = 0; s < 2; ++s) {
        offA[s] = (wm * 48 + fr) * 128 + (((s * 4 + fq) ^ (fr & 7)) << 4);
        offB[s] = 24576 + (wn * 128 + fr) * 128 + (((s * 4 + fq) ^ (fr & 7)) << 4);
    }
#pragma unroll
    for (int i = 0; i < 3; ++i)
#pragma unroll
        for (int j = 0; j < 8; ++j) acc[i][j] = (f32x4){0.f, 0.f, 0.f, 0.f};
    const int nk = g.K >> 6;
#define GW_STAGE(kt, buf) do { \
        _Pragma("unroll") for (int _p = 0; _p < 3; ++_p) \
            __builtin_amdgcn_global_load_lds((const unsigned*)(gA + _p * stepA + (size_t)(kt) * 64), (LAS unsigned*)(lds + (buf) * GEMMW_STAGE + _p * 8192 + ldsw), 16, 0, 0); \
        _Pragma("unroll") for (int _p = 0; _p < 4; ++_p) \
            __builtin_amdgcn_global_load_lds((const unsigned*)(gB + _p * stepB + (size_t)(kt) * 64), (LAS unsigned*)(lds + (buf) * GEMMW_STAGE + 24576 + _p * 8192 + ldsw), 16, 0, 0); \
    } while (0)
    GW_STAGE(0, 0);
    for (int kt = 0; kt < nk; ++kt) {
        asm volatile("s_waitcnt vmcnt(0)" ::: "memory");
        asm volatile("s_waitcnt lgkmcnt(0)" ::: "memory");
        __builtin_amdgcn_s_barrier();
        asm volatile("" ::: "memory");
        const int cur = kt & 1;
        if (kt + 1 < nk) GW_STAGE(kt + 1, cur ^ 1);
        const LAS unsigned char* lb = lds + cur * GEMMW_STAGE;
#pragma unroll
        for (int s = 0; s < 2; ++s) {
            h16x8 af[3], bf[8];
#pragma unroll
            for (int i = 0; i < 3; ++i) af[i] = *(const LAS h16x8*)(lb + offA[s] + i * 2048);
#pragma unroll
            for (int j = 0; j < 8; ++j) bf[j] = *(const LAS h16x8*)(lb + offB[s] + j * 2048);
#pragma unroll
            for (int i = 0; i < 3; ++i)
#pragma unroll
                for (int j = 0; j < 8; ++j) acc[i][j] = __builtin_amdgcn_mfma_f32_16x16x32_f16(bf[j], af[i], acc[i][j], 0, 0, 0);
        }
    }
    asm volatile("s_waitcnt lgkmcnt(0)" ::: "memory");
    __builtin_amdgcn_s_barrier();
    asm volatile("" ::: "memory");
#undef GW_STAGE
}

__device__ __forceinline__ void tr_item(const float* W, int ldw, int nvalid, int k0, int n0, h16* dst, int ldd, int drow0, LAS float* scr, int lane) {
    const int c4 = lane & 7, kr = lane >> 3;
    const bool ok = (n0 + 4 * c4) < nvalid;
#pragma unroll
    for (int i = 0; i < 8; ++i) {
        const int kk = kr + 8 * i;
        const f32x4 v = ok ? *(const f32x4*)(W + (size_t)(k0 + kk) * ldw + n0 + 4 * c4) : (f32x4){0.f, 0.f, 0.f, 0.f};
        LAS float* s = scr + kk * 33 + 4 * c4;
        s[0] = v[0]; s[1] = v[1]; s[2] = v[2]; s[3] = v[3];
    }
    asm volatile("s_waitcnt lgkmcnt(0)" ::: "memory");
    const int cch = lane & 7;
#pragma unroll
    for (int j = 0; j < 4; ++j) {
        const int n = (lane >> 3) + 8 * j; const LAS float* s = scr + (8 * cch) * 33 + n;
        h16x8 o;
#pragma unroll
        for (int e = 0; e < 8; ++e) o[e] = (h16)s[e * 33];
        *(h16x8*)(dst + (size_t)(drow0 + n) * ldd + k0 + 8 * cch) = o;
    }
    asm volatile("s_waitcnt lgkmcnt(0)" ::: "memory");
}
struct TrJob { const float* src; int K, N, ldw, nvalid; h16* dst; int ldd, kind, base; };
__device__ __forceinline__ int tr_job(const Params& p, int j, TrJob& J) {
    unsigned char* ws = p.ws;
    switch (j) {
    case 0: J = {p.in[I_WIN], 1024, 2176, 2064, 2064, (h16*)(ws + WS_WIN), 1024, 0, 0}; break;
    case 1: J = {p.in[I_WOUT], 1024, 1024, 1024, 1024, (h16*)(ws + WS_WOUT), 1024, 0, 0}; break;
    case 2: case 3: J = {p.in[I_WG] + (size_t)(j - 2) * 1024 * 2816, 1024, 2816, 2816, 2816, (h16*)(ws + WS_WGU) + (size_t)(j - 2) * 5632 * 1024, 1024, 1, 0}; break;
    case 4: case 5: J = {p.in[I_WU] + (size_t)(j - 4) * 1024 * 2816, 1024, 2816, 2816, 2816, (h16*)(ws + WS_WGU) + (size_t)(j - 4) * 5632 * 1024, 1024, 2, 0}; break;
    case 6: case 7: J = {p.in[I_WD] + (size_t)(j - 6) * 2816 * 1024, 2816, 1024, 1024, 1024, (h16*)(ws + WS_WDN) + (size_t)(j - 6) * 1024 * 2816, 2816, 0, 0}; break;
    case 8: J = {p.in[I_WR], 1024, 1024, 1024, 1024, (h16*)(ws + WS_WRKV), 1024, 0, 0}; break;
    case 9: J = {p.in[I_WK], 1024, 1024, 1024, 1024, (h16*)(ws + WS_WRKV), 1024, 0, 1024}; break;
    case 10: J = {p.in[I_WV], 1024, 1024, 1024, 1024, (h16*)(ws + WS_WRKV), 1024, 0, 2048}; break;
    case 11: case 12: J = {p.in[I_W1] + (size_t)(j - 11) * 1024 * 64, 1024, 64, 64, 64, (h16*)(ws + WS_WRKV), 1024, 0, 3072 + 64 * (j - 11)}; break;
    case 13: case 14: J = {p.in[I_A1] + (size_t)(j - 13) * 1024 * 64, 1024, 64, 64, 64, (h16*)(ws + WS_WRKV), 1024, 0, 3072 + 128 + 64 * (j - 13)}; break;
    case 15: J = {p.in[I_G1], 1024, 128, 128, 128, (h16*)(ws + WS_WRKV), 1024, 0, 3072 + 256}; break;
    case 16: J = {p.in[I_WO], 1024, 1024, 1024, 1024, (h16*)(ws + WS_WO), 1024, 0, 0}; break;
    case 17: case 18: J = {p.in[I_W2] + (size_t)(j - 17) * 64 * 1024, 64, 1024, 1024, 1024, (h16*)(ws + WS_W2T) + (size_t)(j - 17) * 1024 * 64, 64, 0, 0}; break;
    case 19: case 20: J = {p.in[I_A2] + (size_t)(j - 19) * 64 * 1024, 64, 1024, 1024, 1024, (h16*)(ws + WS_A2T) + (size_t)(j - 19) * 1024 * 64, 64, 0, 0}; break;
    default: J = {p.in[I_G2], 128, 1024, 1024, 1024, (h16*)(ws + WS_G2T), 128, 0, 0}; break;
    }
    return (J.K / 64) * (J.N / 32);
}
constexpr int N_TRJOBS = 22;

__device__ __forceinline__ void ada_unit(const Params& p, const Ctx& c, int u) {
    LAS float* sc = (LAS float*)c.lds;
    LAS float* red = (LAS float*)(c.lds + 16384);
    const int layer = u / 96, cb = u % 96;
    __syncthreads();
    for (int i = c.tid; i < 3072; i += NTHREADS) {
        const int k = i >> 10, d = i & 1023;
        const float v = (k == 0) ? p.in[I_CCTX][d] : p.in[I_C][(k - 1) * 1024 + d];
        sc[i] = silu_f(v);
    }
    __syncthreads();
    const int tx = c.tid & 15, dg = c.tid >> 4;
    const float* w = p.in[I_MODW] + (size_t)layer * 1024 * 6144 + (size_t)(dg * 32) * 6144 + cb * 64 + tx * 4;
    f32x4 a0 = {0, 0, 0, 0}, a1 = a0, a2 = a0;
#pragma unroll 8
    for (int d = 0; d < 32; ++d) {
        const f32x4 wv = *(const f32x4*)(w + (size_t)d * 6144);
        const int dd = dg * 32 + d;
        a0 += wv * sc[dd]; a1 += wv * sc[1024 + dd]; a2 += wv * sc[2048 + dd];
    }
    *(LAS f32x4*)(red + (dg * 3 + 0) * 64 + tx * 4) = a0;
    *(LAS f32x4*)(red + (dg * 3 + 1) * 64 + tx * 4) = a1;
    *(LAS f32x4*)(red + (dg * 3 + 2) * 64 + tx * 4) = a2;
    __syncthreads();
    if (c.tid < 192) {
        const int k = c.tid >> 6, col = c.tid & 63;
        float s = p.in[I_MODB][layer * 6144 + cb * 64 + col];
#pragma unroll 8
        for (int g = 0; g < 32; ++g) s += red[(g * 3 + k) * 64 + col];
        ((float*)(p.ws + WS_ADA))[(layer * 3 + k) * 6144 + cb * 64 + col] = s;
    }
}

constexpr int N_CONV_ITEMS = 11392, N_CONV_UNITS = N_CONV_ITEMS / 64;
__device__ __forceinline__ void conv_unit(const Params& p, const Ctx& c, int u) {
    LAS float* scr = (LAS float*)(c.lds + c.wave * 16384);
    __syncthreads();
    for (int e = 0; e < 8; ++e) {
        int it = u * 64 + c.wave * 8 + e;
        int j = 1; TrJob J; int cnt = tr_job(p, j, J);
        while (it >= cnt) { it -= cnt; ++j; cnt = tr_job(p, j, J); }
        const int nblk = J.N / 32, kb = it / nblk, nb = it % nblk, n0 = nb * 32;
        const int drow0 = J.kind == 0 ? J.base + n0 : (J.kind == 1 ? 2 * n0 : 2 * n0 + 32);
        tr_item(J.src, J.ldw, J.nvalid, kb * 64, n0, J.dst, J.ldd, drow0, scr, c.lane);
    }
    __syncthreads();
}
__device__ __forceinline__ void phase0(const Params& p, const Ctx& c) {
    for (int u = c.bid; u < 192; u += c.G) ada_unit(p, c, u);
    __syncthreads();
    {
        LAS float* scr = (LAS float*)(c.lds + c.wave * 16384);
        const int gw = c.bid * NWAVES + c.wave, NGW = c.G * NWAVES;
        TrJob J; const int cnt = tr_job(p, 0, J);
        const int nblk = J.N / 32;
        for (int it = gw; it < cnt; it += NGW) {
            const int kb = it / nblk, nb = it % nblk, n0 = nb * 32;
            tr_item(J.src, J.ldw, J.nvalid, kb * 64, n0, J.dst, J.ldd, J.base + n0, scr, c.lane);
        }
    }
    { float* rs_ = (float*)(p.ws + WS_ROWSS); for (int i = c.bid * NTHREADS + c.tid; i < 2 * NTOK; i += c.G * NTHREADS) rs_[i] = 0.f; }
    const int gt = c.bid * NTHREADS + c.tid, NGT = c.G * NTHREADS;
    float* rc = (float*)(p.ws + WS_ROPE); float* rs = rc + 32768;
    for (int i = gt; i < 32768; i += NGT) {
        const int tok = i >> 5, f = i & 31;
        const float pos = (float)((f < 16) ? (tok >> 6) : (tok & 63));
        const float inv = powf(10000.f, -(float)(f & 15) / 16.f);
        const float ang = pos * inv;
        rc[i] = cosf(ang); rs[i] = sinf(ang);
    }
    h16* k16l = (h16*)(p.ws + WS_K16L); h16* vt16l = (h16*)(p.ws + WS_VT16L);
    for (int i = gt; i < 65536; i += NGT) {
        const int d = i & 63, kvh = (i >> 6) & 1, key = (i >> 7) & 255, b = i >> 15;
        k16l[((size_t)(b * 2 + kvh) * 1280 + key) * 64 + d] = (h16)p.in[I_CK][i];
        vt16l[((size_t)(b * 2 + kvh) * 64 + d) * 1280 + key] = (h16)p.in[I_CV][i];
    }
}

__device__ __forceinline__ void load_row(const float* r, int lane, f32x4 (&v)[4]) {
#pragma unroll
    for (int j = 0; j < 4; ++j) v[j] = *(const f32x4*)(r + 256 * j + 4 * lane);
}
__device__ __forceinline__ float row_rstd(const f32x4 (&v)[4]) {
    float s = 0.f;
#pragma unroll
    for (int j = 0; j < 4; ++j) s += v[j].x * v[j].x + v[j].y * v[j].y + v[j].z * v[j].z + v[j].w * v[j].w;
    return rsqrtf(wave_sum(s) * (1.f / 1024.f) + 1e-6f);
}
__device__ __forceinline__ const float* xin_row(const Params& p, int row) {
    return row < NCTX ? p.in[I_XP] + (size_t)row * D : p.in[I_XS] + (size_t)(row - NCTX) * D;
}
__device__ __forceinline__ void phase_normmod(const Params& p, const Ctx& c, bool from_input, const float* g, int layer, int ch_sh, int ch_sc) {
    const int gw = c.bid * NWAVES + c.wave, NGW = c.G * NWAVES;
    const float* ada = (const float*)(p.ws + WS_ADA);
    h16* hA = (h16*)(p.ws + WS_HA);
    for (int row = gw; row < NTOK; row += NGW) {
        const float* xr = from_input ? xin_row(p, row) : (const float*)(p.ws + WS_X) + (size_t)row * D;
        f32x4 v[4]; load_row(xr, c.lane, v);
        const float rstd = row_rstd(v);
        const float* a = ada + (size_t)(layer * 3 + stream_of(row)) * 6144;
#pragma unroll
        for (int j = 0; j < 4; ++j) {
            const int col = 256 * j + 4 * c.lane;
            const f32x4 gg = *(const f32x4*)(g + col), sh = *(const f32x4*)(a + ch_sh * 1024 + col), sc = *(const f32x4*)(a + ch_sc * 1024 + col);
            const f32x4 o = v[j] * rstd * gg * (sc + 1.f) + sh;
            *(h16x4*)(hA + (size_t)row * D + col) = cvt4(o);
        }
    }
}

__device__ __forceinline__ void phase_postproj(const Params& p, const Ctx& c) {
    const int gw = c.bid * NWAVES + c.wave, NGW = c.G * NWAVES, lane = c.lane;
    const float* proj = (const float*)(p.ws + WS_PROJ);
    float* xbc = (float*)(p.ws + WS_XBC);
    float* dtv = (float*)(p.ws + WS_DT);
    for (int it = gw; it < 384 * 3; it += NGW) {
        const int seg = it / 3, cb = it % 3, row0 = seg * 16, ch = cb * 256 + lane * 4;
        const int T = row0 >= NCTX ? 1024 : 256, t0 = (row0 >= NCTX ? row0 - NCTX : row0) & (T - 1);
        f32x4 x[20];
#pragma unroll
        for (int r = 0; r < 20; ++r) {
            const int tt = t0 + r - 2;
            x[r] = (tt >= 0 && tt < T) ? *(const f32x4*)(proj + (size_t)(row0 + r - 2) * PROJ_LD + 1280 + ch) : (f32x4){0.f, 0.f, 0.f, 0.f};
        }
        f32x4 w[5];
#pragma unroll
        for (int i = 0; i < 5; ++i) w[i] = *(const f32x4*)(p.in[I_CONVW] + i * 768 + ch);
        const f32x4 bias = *(const f32x4*)(p.in[I_CONVB] + ch);
#pragma unroll
        for (int r = 0; r < 16; ++r) {
            f32x4 a = bias;
#pragma unroll
            for (int i = 0; i < 5; ++i) a += w[i] * x[r + i];
            f32x4 o; o[0] = silu_f(a[0]); o[1] = silu_f(a[1]); o[2] = silu_f(a[2]); o[3] = silu_f(a[3]);
            *(f32x4*)(xbc + (size_t)(row0 + r) * 768 + ch) = o;
        }
    }
    for (int it = gw; it < NTOK / 4; it += NGW) {
        const int row = it * 4 + (lane >> 4), e = lane & 15;
        dtv[row * 16 + e] = softplus_f(proj[(size_t)row * PROJ_LD + 2048 + e] + p.in[I_DTB][e]);
    }
}

__device__ __forceinline__ void phase_ssdcombine(const Params& p, const Ctx& c) {
    const int gw = c.bid * NWAVES + c.wave, NGW = c.G * NWAVES, lane = c.lane;
    {
        const float* ada = (const float*)(p.ws + WS_ADA); float* fb = (float*)(p.ws + WS_FBIAS);
        for (int it = gw; it < 2 * 5632; it += NGW) {
            const int l = it / 5632, n = it % 5632;
            const h16* wr = (const h16*)(p.ws + WS_WGU) + ((size_t)l * 5632 + n) * 1024 + lane * 16;
            const h16x8 w0 = *(const h16x8*)wr, w1 = *(const h16x8*)(wr + 8);
            float a0 = 0.f, a1 = 0.f, a2 = 0.f;
#pragma unroll
            for (int e = 0; e < 16; ++e) {
                const float w = (float)(e < 8 ? w0[e & 7] : w1[e & 7]); const int k = lane * 16 + e;
                a0 += w * ada[(size_t)(l * 3 + 0) * 6144 + 3072 + k]; a1 += w * ada[(size_t)(l * 3 + 1) * 6144 + 3072 + k]; a2 += w * ada[(size_t)(l * 3 + 2) * 6144 + 3072 + k];
            }
            a0 = wave_sum(a0); a1 = wave_sum(a1); a2 = wave_sum(a2);
            if (lane == 0) { fb[(size_t)(l * 3 + 0) * 5632 + n] = a0; fb[(size_t)(l * 3 + 1) * 5632 + n] = a1; fb[(size_t)(l * 3 + 2) * 5632 + n] = a2; }
        }
    }
    const float* ssdy = (const float*)(p.ws + WS_SSDY);
    const float* xbc = (const float*)(p.ws + WS_XBC);
    const float* proj = (const float*)(p.ws + WS_PROJ);
    h16* cat = (h16*)(p.ws + WS_CAT);
    for (int row = gw; row < NTOK; row += NGW) {
        const int c0 = lane * 8, h = lane >> 3;
        const float dsk = p.in[I_SSDD][h];
        float y[8]; float ss = 0.f;
#pragma unroll
        for (int e = 0; e < 2; ++e) {
            const f32x4 yf = *(const f32x4*)(ssdy + (size_t)row * 512 + c0 + 4 * e), yb = *(const f32x4*)(ssdy + (size_t)(NTOK + row) * 512 + c0 + 4 * e);
            const f32x4 xs = *(const f32x4*)(xbc + (size_t)row * 768 + c0 + 4 * e), z = *(const f32x4*)(proj + (size_t)row * PROJ_LD + 768 + c0 + 4 * e);
#pragma unroll
            for (int q = 0; q < 4; ++q) { const float v = (yf[q] + yb[q] + dsk * xs[q]) * silu_f(z[q]); y[4 * e + q] = v; ss += v * v; }
        }
        const float rstd = rsqrtf(wave_sum(ss) * (1.f / 512.f) + 1e-6f);
        h16x8 o;
#pragma unroll
        for (int e = 0; e < 8; ++e) o[e] = (h16)(y[e] * rstd * p.in[I_SSDG][c0 + e]);
        *(h16x8*)(cat + (size_t)row * D + 512 + c0) = o;
    }
}

__device__ __forceinline__ void phase_rwkvmix(const Params& p, const Ctx& c) {
    const int gw = c.bid * NWAVES + c.wave, NGW = c.G * NWAVES, lane = c.lane;
    const float* X = (const float*)(p.ws + WS_X);
    const float* ada = (const float*)(p.ws + WS_ADA);
    const float* g = p.in[I_NMG] + 1024;
    h16* xm = (h16*)(p.ws + WS_XMIX);
    for (int row = gw; row < NTOK; row += NGW) {
        const bool lat = row >= NCTX;
        const int r2 = lat ? row - NCTX : row;
        const int t = lat ? (r2 & 1023) : (r2 & 255), T = lat ? 1024 : 256;
        const float* a = ada + (size_t)(3 + stream_of(row)) * 6144;
        f32x4 h0[4], hp[4], hn[4];
        load_row(X + (size_t)row * D, lane, h0);
        const float r0 = row_rstd(h0);
        const bool hasp = t > 0, hasn = t < T - 1;
        float rp = 0.f, rn = 0.f;
        if (hasp) { load_row(X + (size_t)(row - 1) * D, lane, hp); rp = row_rstd(hp); }
        if (hasn) { load_row(X + (size_t)(row + 1) * D, lane, hn); rn = row_rstd(hn); }
#pragma unroll
        for (int j = 0; j < 4; ++j) {
            const int col = 256 * j + 4 * lane;
            const f32x4 gg = *(const f32x4*)(g + col), sh = *(const f32x4*)(a + col), sc = *(const f32x4*)(a + 1024 + col);
            const f32x4 m = gg * (sc + 1.f);
            const f32x4 hh = h0[j] * r0 * m + sh;
            f32x4 dp = -hh, dn = -hh;
            if (hasp) dp = (hp[j] * rp * m + sh) - hh;
            if (hasn) dn = (hn[j] * rn * m + sh) - hh;
#pragma unroll
            for (int i = 0; i < 6; ++i) {
                const f32x4 m0 = *(const f32x4*)(p.in[I_MU] + i * 1024 + col), m1 = *(const f32x4*)(p.in[I_MU] + (6 + i) * 1024 + col);
                *(h16x4*)(xm + ((size_t)i * NTOK + row) * D + col) = cvt4(hh + dp * m0 + dn * m1);
            }
        }
    }
}

template <int N> __device__ __forceinline__ float dpp_row_shr1(float x) {
    return __builtin_bit_cast(float, __builtin_amdgcn_update_dpp(0x3f800000, __builtin_bit_cast(int, x), 0x110 + N, 0xf, 0xf, false));
}
__device__ __forceinline__ float dpp_bcast15(float x) {
    return __builtin_bit_cast(float, __builtin_amdgcn_update_dpp(0, __builtin_bit_cast(int, x), 0x150 + 15, 0xf, 0xf, false));
}
template <int J> struct TriSolve {
    static __device__ __forceinline__ void run(float (&Tm)[4], const float (&nL)[16]) {
#pragma unroll
        for (int cc = 0; cc < 4; ++cc) { float src_ = Tm[cc]; fmac_bc_safe<J>(Tm[cc], src_, nL[J]); }
        if constexpr (J < 14) TriSolve<J + 1>::run(Tm, nL);
    }
};
__device__ __forceinline__ void phase_rwkvprep(const Params& p, const Ctx& c) {
    const int gw = c.bid * NWAVES + c.wave, NGW = c.G * NWAVES, lane = c.lane;
    const int i = lane & 15, g = lane >> 4;
    LAS unsigned char* scr = c.lds + c.wave * 8192;
    const h16* r16 = (const h16*)(p.ws + WS_R16); const h16* k16 = (const h16*)(p.ws + WS_K16);
    float* bonus = (float*)(p.ws + WS_BONUS);
    for (int item = gw; item < 2 * 384 * 16; item += NGW) {
        const int h = item & 15, rbg = (item >> 4) % 384, dir = item / (16 * 384);
        const int row0 = rbg * 16, row = row0 + (dir ? 15 - i : i);
        h16* dec = (h16*)(p.ws + WS_DEC16) + (size_t)dir * NTOK * D; h16* a16 = (h16*)(p.ws + WS_A16) + (size_t)dir * NTOK * D;
        float kv[16], rv[16], wv[16], av[16];
#pragma unroll
        for (int q = 0; q < 4; ++q) {
            const size_t o = (size_t)row * D + h * 64 + 16 * q + 4 * g;
            const h16x4 k4 = *(const h16x4*)(k16 + o), r4 = *(const h16x4*)(r16 + o), d4 = *(const h16x4*)(dec + o), a4 = *(const h16x4*)(a16 + o);
#pragma unroll
            for (int jj = 0; jj < 4; ++jj) { kv[4 * q + jj] = (float)k4[jj]; rv[4 * q + jj] = (float)r4[jj]; wv[4 * q + jj] = 1.f - (float)d4[jj]; av[4 * q + jj] = (float)a4[jj]; }
        }
        float kap[16], ss = 0.f;
#pragma unroll
        for (int q = 0; q < 4; ++q) {
            const f32x4 kkw = *(const f32x4*)(p.in[I_KKW] + h * 64 + 16 * q + 4 * g);
#pragma unroll
            for (int jj = 0; jj < 4; ++jj) { kap[4 * q + jj] = kv[4 * q + jj] * kkw[jj]; ss += kap[4 * q + jj] * kap[4 * q + jj]; }
        }
        ss = rowsum4(ss);
        const float rn = rsqrtf(ss + 1e-12f);
        float bon = 0.f;
        float beta[16], kt[16];
#pragma unroll
        for (int q = 0; q < 4; ++q) {
            const f32x4 ka4 = *(const f32x4*)(p.in[I_KA] + h * 64 + 16 * q + 4 * g), rk4 = *(const f32x4*)(p.in[I_RK] + h * 64 + 16 * q + 4 * g);
#pragma unroll
            for (int jj = 0; jj < 4; ++jj) {
                const int m = 4 * q + jj;
                kap[m] *= rn; beta[m] = kap[m] * av[m]; kt[m] = kv[m] * (1.f + (av[m] - 1.f) * ka4[jj]);
                bon += rv[m] * kt[m] * rk4[jj];
            }
        }
        bon = rowsum4(bon);
        if (g == 0) bonus[((size_t)dir * NTOK + row) * 16 + h] = bon;
        f32x4 A1 = {0.f, 0.f, 0.f, 0.f}, Lm = A1, N1 = A1, N2 = A1;
        h16 kapo[16], rho[16], kbo[16], bbo[16], kho[16], bho[16];
        float gcv[16];
#pragma unroll
        for (int m = 0; m < 16; ++m) {
            float G = wv[m];
            G *= dpp_row_shr1<1>(G); G *= dpp_row_shr1<2>(G); G *= dpp_row_shr1<4>(G); G *= dpp_row_shr1<8>(G);
            const float Gex = dpp_row_shr1<1>(G), GC = dpp_bcast15(G), rG = __builtin_amdgcn_rcpf(G);
            const float kh = kap[m] * Gex, rh = rv[m] * G, k_h = kt[m] * rG, b_h = beta[m] * rG;
            kapo[m] = (h16)kh; rho[m] = (h16)rh; kbo[m] = (h16)(k_h * GC); bbo[m] = (h16)(b_h * GC); gcv[m] = GC;
            kho[m] = (h16)fminf(fmaxf(k_h, -60000.f), 60000.f); bho[m] = (h16)fminf(fmaxf(b_h, -60000.f), 60000.f);
        }
#pragma unroll
        for (int s = 0; s < 2; ++s) {
            h16x8 ka8, rh8, kh8, bh8;
#pragma unroll
            for (int e = 0; e < 8; ++e) { ka8[e] = kapo[8 * s + e]; rh8[e] = rho[8 * s + e]; kh8[e] = kho[8 * s + e]; bh8[e] = bho[8 * s + e]; }
            A1 = __builtin_amdgcn_mfma_f32_16x16x32_f16(kh8, ka8, A1, 0, 0, 0);
            Lm = __builtin_amdgcn_mfma_f32_16x16x32_f16(bh8, ka8, Lm, 0, 0, 0);
            N1 = __builtin_amdgcn_mfma_f32_16x16x32_f16(kh8, rh8, N1, 0, 0, 0);
            N2 = __builtin_amdgcn_mfma_f32_16x16x32_f16(bh8, rh8, N2, 0, 0, 0);
        }
#pragma unroll
        for (int r = 0; r < 4; ++r) { const int j = 4 * g + r; if (!(j < i)) { A1[r] = 0.f; Lm[r] = 0.f; } if (!(j <= i)) { N1[r] = 0.f; N2[r] = 0.f; } }
        LAS float* Lb = (LAS float*)(scr + 4096);
        *(LAS f32x4*)(Lb + i * 16 + 4 * g) = Lm;
        LAS h16* kbT = (LAS h16*)scr;
#pragma unroll
        for (int m = 0; m < 16; ++m) {
            const int f = m >> 2, kc = 4 * g + (m & 3);
            const int u = ((f * 16 + kc) * 4 + (i >> 2)) * 8 + (i & 3);
            kbT[u] = kbo[m]; kbT[u + 4] = bbo[m];
        }
        asm volatile("s_waitcnt lgkmcnt(0)" ::: "memory");
        float nL[16];
#pragma unroll
        for (int q = 0; q < 4; ++q) { const f32x4 v = *(const LAS f32x4*)(Lb + i * 16 + 4 * q); nL[4 * q] = -v[0]; nL[4 * q + 1] = -v[1]; nL[4 * q + 2] = -v[2]; nL[4 * q + 3] = -v[3]; }
        float Tm[4];
#pragma unroll
        for (int cc = 0; cc < 4; ++cc) Tm[cc] = (i == 4 * g + cc) ? 1.f : 0.f;
        asm volatile("s_nop 1" : "+v"(Tm[0]), "+v"(Tm[1]), "+v"(Tm[2]), "+v"(Tm[3]));
        TriSolve<0>::run(Tm, nL);
        unsigned char* item_o = p.ws + WS_OPS2 + (size_t)item * OPS2_ITEM;
        {
            h16x8 o;
#pragma unroll
            for (int s = 0; s < 2; ++s) {
#pragma unroll
                for (int e = 0; e < 8; ++e) o[e] = kapo[8 * s + e];
                *(h16x8*)(dec + (size_t)(row0 + i) * D + h * 64 + (g * 2 + s) * 8) = o;
#pragma unroll
                for (int e = 0; e < 8; ++e) o[e] = rho[8 * s + e];
                *(h16x8*)(a16 + (size_t)(row0 + i) * D + h * 64 + (g * 2 + s) * 8) = o;
            }
        }
#pragma unroll
        for (int q = 0; q < 4; ++q) *(u32x4*)(item_o + (q * 64 + lane) * 16) = *(const LAS u32x4*)(scr + (q * 64 + lane) * 16);
        *(h16x4*)(item_o + 4096 + (i * 4 + g) * 8) = cvt4(A1);
        { f32x4 t4 = {Tm[0], Tm[1], Tm[2], Tm[3]}; *(h16x4*)(item_o + 4608 + (i * 4 + g) * 8) = cvt4(t4); }
        { h16x8 o; for (int r = 0; r < 4; ++r) { o[r] = (h16)N1[r]; o[4 + r] = (h16)N2[r]; } *(h16x8*)(item_o + 5120 + (i * 4 + g) * 16) = o; }
        if (i == 0) {
#pragma unroll
            for (int q = 0; q < 4; ++q) *(f32x4*)(item_o + 6144 + (16 * q + 4 * g) * 4) = (f32x4){gcv[4 * q], gcv[4 * q + 1], gcv[4 * q + 2], gcv[4 * q + 3]};
        }
        asm volatile("s_waitcnt lgkmcnt(0)" ::: "memory");
    }
}

__device__ __forceinline__ void phase_rwkvpost(const Params& p, const Ctx& c) {
    const int gw = c.bid * NWAVES + c.wave, NGW = c.G * NWAVES, lane = c.lane;
    const h16* y16 = (const h16*)(p.ws + WS_Y16); const h16* v16 = (const h16*)(p.ws + WS_V16); const h16* g16 = (const h16*)(p.ws + WS_G16);
    const float* bonus = (const float*)(p.ws + WS_BONUS);
    h16* hA = (h16*)(p.ws + WS_HA);
    for (int row = gw; row < NTOK; row += NGW) {
        const int c0 = lane * 16;
        float y[16]; float s = 0.f;
#pragma unroll
        for (int e = 0; e < 2; ++e) {
            const h16x8 a = *(const h16x8*)(y16 + (size_t)row * D + c0 + 8 * e), b = *(const h16x8*)(y16 + ((size_t)NTOK + row) * D + c0 + 8 * e);
#pragma unroll
            for (int q = 0; q < 8; ++q) { y[8 * e + q] = (float)a[q] + (float)b[q]; s += y[8 * e + q]; }
        }
        s += __shfl_xor(s, 1); s += __shfl_xor(s, 2);
        const float mean = s * (1.f / 64.f);
        float vs = 0.f;
#pragma unroll
        for (int e = 0; e < 16; ++e) { y[e] -= mean; vs += y[e] * y[e]; }
        vs += __shfl_xor(vs, 1); vs += __shfl_xor(vs, 2);
        const float rstd = rsqrtf(vs * (1.f / 64.f) + 64e-5f);
        const float bon = bonus[row * 16 + (lane >> 2)] + bonus[((size_t)NTOK + row) * 16 + (lane >> 2)];
#pragma unroll
        for (int e = 0; e < 2; ++e) {
            const h16x8 vv = *(const h16x8*)(v16 + (size_t)row * D + c0 + 8 * e), gv = *(const h16x8*)(g16 + (size_t)row * D + c0 + 8 * e);
            h16x8 o;
#pragma unroll
            for (int q = 0; q < 8; ++q) {
                const int cc = c0 + 8 * e + q;
                const float yn = y[8 * e + q] * rstd * p.in[I_LNG][cc] + p.in[I_LNB][cc];
                o[q] = (h16)((yn + bon * (float)vv[q]) * (float)gv[q]);
            }
            *(h16x8*)(hA + (size_t)row * D + c0 + 8 * e) = o;
        }
    }
}

__device__ __forceinline__ void phase_final(const Params& p, const Ctx& c) {
    const int gw = c.bid * NWAVES + c.wave, NGW = c.G * NWAVES;
    const float* X = (const float*)(p.ws + WS_X);
    for (int row = gw; row < NTOK; row += NGW) {
        f32x4 v[4]; load_row(X + (size_t)row * D, c.lane, v);
        const float rstd = row_rstd(v);
#pragma unroll
        for (int j = 0; j < 4; ++j) {
            const int col = 256 * j + 4 * c.lane;
            *(f32x4*)(p.out + O_Y + (size_t)row * D + col) = v[j] * rstd * *(const f32x4*)(p.in[I_FNG] + col);
        }
    }
}

__device__ __forceinline__ void attn_unit(const Params& p, const Ctx& c, bool lat, int b, int kvh, int qb) {
    const int lane = c.lane, wave = c.wave, tid = c.tid;
    const int nkeys = lat ? 1280 : 256;
    const h16* Kg = lat ? (const h16*)(p.ws + WS_K16L) + (size_t)(b * 2 + kvh) * 1280 * 64 : (const h16*)(p.ws + WS_K16C) + (size_t)(b * 2 + kvh) * 256 * 64;
    const h16* Vg = lat ? (const h16*)(p.ws + WS_VT16L) + (size_t)(b * 2 + kvh) * 64 * 1280 : (const h16*)(p.ws + WS_VT16C) + (size_t)(b * 2 + kvh) * 64 * 256;
    const int row0 = (lat ? NCTX + b * 1024 : b * 256) + qb * 32 + (wave & 1) * 16;
    const int head = kvh * 4 + (wave >> 1);
    const int fr = lane & 15, fq = lane >> 4;
    const h16* q16 = (const h16*)(p.ws + WS_Q16);
    h16x8 qf[2];
#pragma unroll
    for (int s = 0; s < 2; ++s) qf[s] = *(const h16x8*)(q16 + (size_t)(row0 + fr) * 512 + head * 64 + s * 32 + fq * 8);
    LAS unsigned char* ldsK = c.lds; LAS unsigned char* ldsV = c.lds + 8192;
    float m = -1e30f, l = 0.f;
    f32x4 O[4];
#pragma unroll
    for (int f = 0; f < 4; ++f) O[f] = (f32x4){0.f, 0.f, 0.f, 0.f};
    const int srow = tid >> 3, sch = tid & 7;
    const int sdst = srow * 128 + ((sch ^ (srow & 7)) << 4);
    const int ntile = nkeys / 64;
    u32x4 kv = *(const u32x4*)(Kg + (size_t)srow * 64 + sch * 8);
    u32x4 vv = *(const u32x4*)(Vg + (size_t)srow * nkeys + sch * 8);
    for (int kt = 0; kt < ntile; ++kt) {
        __syncthreads();
        *(LAS u32x4*)(ldsK + sdst) = kv;
        *(LAS u32x4*)(ldsV + sdst) = vv;
        __syncthreads();
        if (kt + 1 < ntile) {
            kv = *(const u32x4*)(Kg + (size_t)((kt + 1) * 64 + srow) * 64 + sch * 8);
            vv = *(const u32x4*)(Vg + (size_t)srow * nkeys + (kt + 1) * 64 + sch * 8);
        }
        f32x4 sacc[4];
#pragma unroll
        for (int f = 0; f < 4; ++f) {
            sacc[f] = (f32x4){0.f, 0.f, 0.f, 0.f};
#pragma unroll
            for (int s = 0; s < 2; ++s) {
                const h16x8 kf = *(const LAS h16x8*)(ldsK + (f * 16 + fr) * 128 + (((s * 4 + fq) ^ (fr & 7)) << 4));
                sacc[f] = __builtin_amdgcn_mfma_f32_16x16x32_f16(kf, qf[s], sacc[f], 0, 0, 0);
            }
        }
        float mx = -1e30f;
#pragma unroll
        for (int f = 0; f < 4; ++f)
#pragma unroll
            for (int r = 0; r < 4; ++r) mx = fmaxf(mx, sacc[f][r]);
        mx = fmaxf(mx, __shfl_xor(mx, 16)); mx = fmaxf(mx, __shfl_xor(mx, 32));
        const float mn = fmaxf(m, mx);
        const float alpha = __expf(m - mn);
        m = mn;
        float ps = 0.f;
#pragma unroll
        for (int f = 0; f < 4; ++f)
#pragma unroll
            for (int r = 0; r < 4; ++r) { const float e = __expf(sacc[f][r] - mn); sacc[f][r] = e; ps += e; }
        l = l * alpha + ps;
#pragma unroll
        for (int f = 0; f < 4; ++f) O[f] *= alpha;
#pragma unroll
        for (int s2 = 0; s2 < 2; ++s2) {
            h16x8 pf;
#pragma unroll
            for (int r = 0; r < 4; ++r) { pf[r] = (h16)sacc[2 * s2][r]; pf[4 + r] = (h16)sacc[2 * s2 + 1][r]; }
#pragma unroll
            for (int fd = 0; fd < 4; ++fd) {
                const int d = fd * 16 + fr;
                const h16x4 lo = *(const LAS h16x4*)(ldsV + d * 128 + (((4 * s2 + (fq >> 1)) ^ (d & 7)) << 4) + (fq & 1) * 8);
                const h16x4 hi = *(const LAS h16x4*)(ldsV + d * 128 + (((4 * s2 + 2 + (fq >> 1)) ^ (d & 7)) << 4) + (fq & 1) * 8);
                h16x8 vf; vf[0] = lo[0]; vf[1] = lo[1]; vf[2] = lo[2]; vf[3] = lo[3]; vf[4] = hi[0]; vf[5] = hi[1]; vf[6] = hi[2]; vf[7] = hi[3];
                O[fd] = __builtin_amdgcn_mfma_f32_16x16x32_f16(vf, pf, O[fd], 0, 0, 0);
            }
        }
    }
    l += __shfl_xor(l, 16); l += __shfl_xor(l, 32);
    const float inv = 1.f / l;
    h16* cat = (h16*)(p.ws + WS_CAT);
#pragma unroll
    for (int fd = 0; fd < 4; ++fd)
        *(h16x4*)(cat + (size_t)(row0 + fr) * D + head * 64 + fd * 16 + 4 * fq) = cvt4(O[fd] * inv);
    __syncthreads();
}

__device__ __forceinline__ void ssd_unit(const Params& p, const Ctx& c, bool lat, int b, int h, int dir) {
    const int lane = c.lane, wave = c.wave, tid = c.tid;
    const int fr = lane & 15, fq = lane >> 4;
    const int T = lat ? 1024 : 256, rowbase = lat ? NCTX + b * 1024 : b * 256, grp = h >> 2;
    const float* xbc = (const float*)(p.ws + WS_XBC);
    const float* dtv = (const float*)(p.ws + WS_DT);
    float* ssdy = (float*)(p.ws + WS_SSDY) + (size_t)dir * NTOK * 512;
    const float Aneg = -__expf(p.in[I_ALOG][dir * 8 + h]);
    LAS unsigned char* Bn = c.lds; LAS unsigned char* Cn = c.lds + 16384; LAS unsigned char* xdtT = c.lds + 32768; LAS unsigned char* BdT = c.lds + 49152;
    LAS unsigned char* himg = c.lds + 65536; LAS float* acs = (LAS float*)(c.lds + 73728); LAS float* dtl = (LAS float*)(c.lds + 74240);
    const int fn = wave & 3, fp0 = 2 * (wave >> 2);
    f32x4 hst[2];
    const size_t sbase = (size_t)(b * 8 + h) * 4096;
#pragma unroll
    for (int e = 0; e < 2; ++e) {
        const int pp = 16 * (fp0 + e) + fr, n0 = 16 * fn + 4 * fq;
        hst[e] = lat ? *(const f32x4*)((dir ? p.in[I_SSDB] : p.in[I_SSDF]) + sbase + pp * 64 + n0) : (f32x4){0.f, 0.f, 0.f, 0.f};
    }
    __syncthreads();
#pragma unroll
    for (int e = 0; e < 2; ++e) {
        const int pp = 16 * (fp0 + e) + fr;
        *(LAS h16x4*)(himg + pp * 128 + (((2 * fn + (fq >> 1)) ^ (pp & 7)) << 4) + (fq & 1) * 8) = cvt4(hst[e]);
    }
    const int nchunk = T / 128;
    f32x4 pB[4], pC[4], pX[4]; float pd0 = 0.f, pd1 = 0.f;
    const int prow = tid >> 2, pq4 = tid & 3, pch = tid & 63, plb = tid >> 6;
    LAS unsigned char* Xn = c.lds + 75776;
#define SSD_PREFETCH(ck_) do { const int r0_ = dir ? rowbase + T - 1 - (ck_) * 128 : rowbase + (ck_) * 128, sg_ = dir ? -1 : 1; \
        const float* g_ = xbc + (size_t)(r0_ + sg_ * prow) * 768 + 16 * pq4; \
        _Pragma("unroll") for (int e_ = 0; e_ < 4; ++e_) { pB[e_] = *(const f32x4*)(g_ + 512 + grp * 64 + 4 * e_); pC[e_] = *(const f32x4*)(g_ + 640 + grp * 64 + 4 * e_); pX[e_] = *(const f32x4*)(g_ + h * 64 + 4 * e_); } \
        if (wave == 0) { pd0 = dtv[(r0_ + sg_ * (2 * lane)) * 16 + dir * 8 + h]; pd1 = dtv[(r0_ + sg_ * (2 * lane + 1)) * 16 + dir * 8 + h]; } } while (0)
    SSD_PREFETCH(0);
    for (int ck = 0; ck < nchunk; ++ck) {
        const int r0 = dir ? rowbase + T - 1 - ck * 128 : rowbase + ck * 128, sg = dir ? -1 : 1;
        if (wave == 0) {
            const float d0 = pd0, d1 = pd1;
            const float a0 = d0 * Aneg, a1 = d1 * Aneg;
            float s = a0 + a1;
#pragma unroll
            for (int o = 1; o < 64; o <<= 1) { const float t = __shfl_up(s, o); if (lane >= o) s += t; }
            const float ex = s - (a0 + a1);
            acs[2 * lane] = ex + a0; acs[2 * lane + 1] = ex + a0 + a1; dtl[2 * lane] = d0; dtl[2 * lane + 1] = d1;
        }
        {
            const int o0_ = prow * 128 + (((2 * pq4) ^ (prow & 7)) << 4), o1_ = prow * 128 + (((2 * pq4 + 1) ^ (prow & 7)) << 4);
            h16x8 o0, o1;
#pragma unroll
            for (int e = 0; e < 4; ++e) { o0[e] = (h16)pB[0][e]; o0[4 + e] = (h16)pB[1][e]; o1[e] = (h16)pB[2][e]; o1[4 + e] = (h16)pB[3][e]; }
            *(LAS h16x8*)(Bn + o0_) = o0; *(LAS h16x8*)(Bn + o1_) = o1;
#pragma unroll
            for (int e = 0; e < 4; ++e) { o0[e] = (h16)pC[0][e]; o0[4 + e] = (h16)pC[1][e]; o1[e] = (h16)pC[2][e]; o1[4 + e] = (h16)pC[3][e]; }
            *(LAS h16x8*)(Cn + o0_) = o0; *(LAS h16x8*)(Cn + o1_) = o1;
#pragma unroll
            for (int e = 0; e < 4; ++e) { o0[e] = (h16)pX[0][e]; o0[4 + e] = (h16)pX[1][e]; o1[e] = (h16)pX[2][e]; o1[4 + e] = (h16)pX[3][e]; }
            *(LAS h16x8*)(Xn + o0_) = o0; *(LAS h16x8*)(Xn + o1_) = o1;
        }
        __syncthreads();
        {
            const float aend = acs[127];
#pragma unroll 1
            for (int j = 0; j < 2; ++j) {
                const int l0 = 8 * plb + 64 * j;
                h16x8 ox, ob;
#pragma unroll
                for (int e = 0; e < 8; ++e) {
                    const int l = l0 + e, ad = l * 128 + (((pch >> 3) ^ (l & 7)) << 4) + (pch & 7) * 2;
                    ox[e] = (h16)((float)*(const LAS h16*)(Xn + ad) * dtl[l]);
                    ob[e] = (h16)((float)*(const LAS h16*)(Bn + ad) * __expf(aend - acs[l]));
                }
                const int off = pch * 256 + (((l0 >> 3) ^ (pch & 15)) << 4);
                *(LAS h16x8*)(xdtT + off) = ox; *(LAS h16x8*)(BdT + off) = ob;
            }
        }
        if (ck + 1 < nchunk) SSD_PREFETCH(ck + 1);
        __syncthreads();
        const int l = 16 * wave + fr;
        const float al = acs[l];
        f32x4 accy[4];
#pragma unroll
        for (int fd = 0; fd < 4; ++fd) accy[fd] = (f32x4){0.f, 0.f, 0.f, 0.f};
        h16x8 cf[2];
#pragma unroll
        for (int s2 = 0; s2 < 2; ++s2) cf[s2] = *(const LAS h16x8*)(Cn + l * 128 + (((4 * s2 + fq) ^ (l & 7)) << 4));
#pragma unroll
        for (int fd = 0; fd < 4; ++fd) {
            const int pp = 16 * fd + fr;
#pragma unroll
            for (int s2 = 0; s2 < 2; ++s2) {
                const h16x8 hf = *(const LAS h16x8*)(himg + pp * 128 + (((4 * s2 + fq) ^ (pp & 7)) << 4));
                accy[fd] = __builtin_amdgcn_mfma_f32_16x16x32_f16(hf, cf[s2], accy[fd], 0, 0, 0);
            }
        }
        {
            const float el = __expf(al);
#pragma unroll
            for (int fd = 0; fd < 4; ++fd) accy[fd] *= el;
        }
        for (int q = 0; 2 * q <= wave; ++q) {
            h16x8 pf;
#pragma unroll
            for (int e = 0; e < 2; ++e) {
                const int f = 2 * q + e;
                f32x4 sa = {0.f, 0.f, 0.f, 0.f};
                if (f <= wave) {
                    const int s = 16 * f + fr;
#pragma unroll
                    for (int s2 = 0; s2 < 2; ++s2) {
                        const h16x8 bf = *(const LAS h16x8*)(Bn + s * 128 + (((4 * s2 + fq) ^ (s & 7)) << 4));
                        sa = __builtin_amdgcn_mfma_f32_16x16x32_f16(bf, cf[s2], sa, 0, 0, 0);
                    }
                    const f32x4 as = *(const LAS f32x4*)(acs + 16 * f + 4 * fq);
#pragma unroll
                    for (int r = 0; r < 4; ++r) { const int ss = 16 * f + 4 * fq + r; sa[r] = (ss <= l) ? sa[r] * __expf(al - as[r]) : 0.f; }
                }
#pragma unroll
                for (int r = 0; r < 4; ++r) pf[4 * e + r] = (h16)sa[r];
            }
#pragma unroll
            for (int fd = 0; fd < 4; ++fd) {
                const int pp = 16 * fd + fr;
                const h16x4 lo = *(const LAS h16x4*)(xdtT + pp * 256 + (((4 * q + (fq >> 1)) ^ (pp & 15)) << 4) + (fq & 1) * 8);
                const h16x4 hi = *(const LAS h16x4*)(xdtT + pp * 256 + (((4 * q + 2 + (fq >> 1)) ^ (pp & 15)) << 4) + (fq & 1) * 8);
                h16x8 xf; xf[0] = lo[0]; xf[1] = lo[1]; xf[2] = lo[2]; xf[3] = lo[3]; xf[4] = hi[0]; xf[5] = hi[1]; xf[6] = hi[2]; xf[7] = hi[3];
                accy[fd] = __builtin_amdgcn_mfma_f32_16x16x32_f16(xf, pf, accy[fd], 0, 0, 0);
            }
        }
        {
            float* yo = ssdy + (size_t)(r0 + sg * l) * 512 + h * 64 + 4 * fq;
#pragma unroll
            for (int fd = 0; fd < 4; ++fd) *(f32x4*)(yo + 16 * fd) = accy[fd];
        }
        {
            const float cd = __expf(acs[127]);
            const int nn = 16 * fn + fr;
#pragma unroll
            for (int e = 0; e < 2; ++e) {
                const int pp = 16 * (fp0 + e) + fr;
                f32x4 st = {0.f, 0.f, 0.f, 0.f};
#pragma unroll
                for (int ks = 0; ks < 4; ++ks) {
                    const h16x8 bf = *(const LAS h16x8*)(BdT + nn * 256 + (((4 * ks + fq) ^ (nn & 15)) << 4));
                    const h16x8 xf = *(const LAS h16x8*)(xdtT + pp * 256 + (((4 * ks + fq) ^ (pp & 15)) << 4));
                    st = __builtin_amdgcn_mfma_f32_16x16x32_f16(bf, xf, st, 0, 0, 0);
                }
                hst[e] = hst[e] * cd + st;
            }
        }
        __syncthreads();
#pragma unroll
        for (int e = 0; e < 2; ++e) {
            const int pp = 16 * (fp0 + e) + fr;
            *(LAS h16x4*)(himg + pp * 128 + (((2 * fn + (fq >> 1)) ^ (pp & 7)) << 4) + (fq & 1) * 8) = cvt4(hst[e]);
        }
    }
#undef SSD_PREFETCH
    if (!lat) {
#pragma unroll
        for (int e = 0; e < 2; ++e) {
            const int pp = 16 * (fp0 + e) + fr, n0 = 16 * fn + 4 * fq;
            *(f32x4*)(p.out + (dir ? O_SSDB : O_SSDF) + sbase + pp * 64 + n0) = hst[e];
        }
    }
    __syncthreads();
}
__device__ __forceinline__ int next_unit(const Params& p, const Ctx& c, int q) {
    volatile LAS int* slot = (volatile LAS int*)(c.lds + LDS_MISC + 64);
    __syncthreads();
    if (c.tid == 0) *slot = (int)atomicAdd((unsigned*)(p.ws + WS_CTL) + 4096 + 64 * q, 1u);
    __syncthreads();
    return *slot;
}
__device__ __forceinline__ void phase_mix0(const Params& p, const Ctx& c, int q) {
    for (int u = next_unit(p, c, q); u < 672 + N_CONV_UNITS; u = next_unit(p, c, q)) {
        if (u >= 672) { if (q == 0) conv_unit(p, c, u - 672); continue; }
        if (u < 32) ssd_unit(p, c, true, u >> 4, (u >> 1) & 7, u & 1);
        else if (u < 160) { const int v = u - 32; attn_unit(p, c, true, v >> 6, (v >> 5) & 1, v & 31); }
        else if (u < 416) { const int v = u - 160; ssd_unit(p, c, false, v >> 4, (v >> 1) & 7, v & 1); }
        else { const int v = u - 416; attn_unit(p, c, false, v >> 4, (v >> 3) & 1, v & 7); }
    }
}

constexpr int RW_SLOT = 12544, RW_NS = 5, RW_PF = 4;
__device__ __forceinline__ void rwkv_unit(const Params& p, const Ctx& c, bool lat, int b, int h) {
    const int lane = c.lane, wave = c.wave;
    const int dir = wave >> 2, q = wave & 3, fr = lane & 15, g = lane >> 4;
    const int T = lat ? 1024 : 256, rowbase = lat ? NCTX + b * 1024 : b * 256, nchunk = T / 16;
    const unsigned char* kapg = p.ws + WS_DEC16 + (size_t)dir * NTOK * D * 2; const unsigned char* rhg = p.ws + WS_A16 + (size_t)dir * NTOK * D * 2;
    const unsigned char* vg = p.ws + WS_V16;
    h16* y16 = (h16*)(p.ws + WS_Y16) + (size_t)dir * NTOK * D;
    LAS unsigned char* ring = c.lds + dir * (RW_NS * RW_SLOT);
    f32x4 St[4];
    const size_t soff = ((size_t)(b * 16 + h) * 64 + 16 * q + fr) * 64 + 4 * g;
#pragma unroll
    for (int f = 0; f < 4; ++f) St[f] = lat ? *(const f32x4*)((dir ? p.in[I_RWB] : p.in[I_RWF]) + soff + 16 * f) : (f32x4){0.f, 0.f, 0.f, 0.f};
    const int e0 = q * 64 + lane;
    auto issue = [&](int ck) {
        const int rbg = (rowbase >> 4) + (dir ? nchunk - 1 - ck : ck), row0 = rbg * 16;
        LAS unsigned char* slot = ring + (ck % RW_NS) * RW_SLOT;
        const unsigned char* item = p.ws + WS_OPS2 + (size_t)((dir * 384 + rbg) * 16 + h) * OPS2_ITEM;
        {
            const int e = e0 & 127, t = e >> 3, pc = e & 7;
            const unsigned char* s_ = (e0 < 128 ? kapg : rhg) + ((size_t)(row0 + t) * D + h * 64) * 2 + pc * 16;
            __builtin_amdgcn_global_load_lds((const unsigned*)s_, (LAS unsigned*)(slot + q * 1024), 16, 0, 0);
        }
        __builtin_amdgcn_global_load_lds((const unsigned*)(item + e0 * 16), (LAS unsigned*)(slot + 4096 + q * 1024), 16, 0, 0);
        {
            const int e = e0;
            const unsigned char* s_;
            if (e < 144) s_ = item + 4096 + e * 16;
            else { const int ve = e - 144, t = ve >> 3, pc = ve & 7; s_ = vg + ((size_t)(row0 + (dir ? 15 - t : t)) * D + h * 64) * 2 + pc * 16; }
            __builtin_amdgcn_global_load_lds((const unsigned*)s_, (LAS unsigned*)(slot + 8192 + q * 1024), 16, 0, 0);
        }
        if (q == 0 && lane < 16) {
            const int ve = 112 + lane, t = ve >> 3, pc = ve & 7;
            const unsigned char* s_ = vg + ((size_t)(row0 + (dir ? 15 - t : t)) * D + h * 64) * 2 + pc * 16;
            __builtin_amdgcn_global_load_lds((const unsigned*)s_, (LAS unsigned*)(slot + 12288), 16, 0, 0);
        }
    };
    __syncthreads();
    for (int ck = 0; ck < RW_PF && ck < nchunk; ++ck) issue(ck);
    for (int ck = 0; ck < nchunk; ++ck) {
        if (ck + RW_PF > nchunk) asm volatile("s_waitcnt vmcnt(0)" ::: "memory");
        else if (q == 0) asm volatile("s_waitcnt vmcnt(12)" ::: "memory");
        else asm volatile("s_waitcnt vmcnt(9)" ::: "memory");
        asm volatile("s_waitcnt lgkmcnt(0)" ::: "memory");
        __builtin_amdgcn_s_barrier();
        asm volatile("" ::: "memory");
        if (ck + RW_PF < nchunk) issue(ck + RW_PF);
        const LAS unsigned char* slot = ring + (ck % RW_NS) * RW_SLOT;
        const int rbg = (rowbase >> 4) + (dir ? nchunk - 1 - ck : ck), row0 = rbg * 16;
        h16x8 Sh[2];
#pragma unroll
        for (int s = 0; s < 2; ++s)
#pragma unroll
            for (int r = 0; r < 4; ++r) { Sh[s][r] = (h16)St[2 * s][r]; Sh[s][4 + r] = (h16)St[2 * s + 1][r]; }
        const h16x8 ka0 = *(const LAS h16x8*)(slot + (fr * 4 + g) * 32), ka1 = *(const LAS h16x8*)(slot + (fr * 4 + g) * 32 + 16);
        const h16x8 rh0 = *(const LAS h16x8*)(slot + 2048 + (fr * 4 + g) * 32), rh1 = *(const LAS h16x8*)(slot + 2048 + (fr * 4 + g) * 32 + 16);
        const h16x4 a1 = *(const LAS h16x4*)(slot + 8192 + (fr * 4 + g) * 8), t4 = *(const LAS h16x4*)(slot + 8704 + (fr * 4 + g) * 8);
        const h16x8 nn = *(const LAS h16x8*)(slot + 9216 + (fr * 4 + g) * 16);
        h16x8 vu, a1op, top;
#pragma unroll
        for (int jj = 0; jj < 4; ++jj) {
            vu[jj] = *(const LAS h16*)(slot + 10496 + (4 * g + jj) * 128 + (16 * q + fr) * 2);
            a1op[jj] = a1[jj]; a1op[4 + jj] = (h16)0.f; top[jj] = t4[jj]; top[4 + jj] = (h16)0.f; vu[4 + jj] = (h16)0.f;
        }
        f32x4 X = {0.f, 0.f, 0.f, 0.f};
        X = __builtin_amdgcn_mfma_f32_16x16x32_f16(ka0, Sh[0], X, 0, 0, 0);
        X = __builtin_amdgcn_mfma_f32_16x16x32_f16(ka1, Sh[1], X, 0, 0, 0);
        X = __builtin_amdgcn_mfma_f32_16x16x32_f16(a1op, vu, X, 0, 0, 0);
        h16x8 xo;
#pragma unroll
        for (int r = 0; r < 4; ++r) { xo[r] = (h16)X[r]; xo[4 + r] = (h16)0.f; }
        f32x4 U = {0.f, 0.f, 0.f, 0.f};
        U = __builtin_amdgcn_mfma_f32_16x16x32_f16(top, xo, U, 0, 0, 0);
#pragma unroll
        for (int r = 0; r < 4; ++r) vu[4 + r] = (h16)(-U[r]);
        f32x4 Y = {0.f, 0.f, 0.f, 0.f};
        Y = __builtin_amdgcn_mfma_f32_16x16x32_f16(rh0, Sh[0], Y, 0, 0, 0);
        Y = __builtin_amdgcn_mfma_f32_16x16x32_f16(rh1, Sh[1], Y, 0, 0, 0);
        Y = __builtin_amdgcn_mfma_f32_16x16x32_f16(nn, vu, Y, 0, 0, 0);
#pragma unroll
        for (int f = 0; f < 4; ++f) {
            const f32x4 gc = *(const LAS f32x4*)(slot + 10240 + (16 * f + 4 * g) * 4);
            const h16x8 kb = *(const LAS h16x8*)(slot + 4096 + ((f * 16 + fr) * 4 + g) * 16);
            St[f] = __builtin_amdgcn_mfma_f32_16x16x32_f16(kb, vu, St[f] * gc, 0, 0, 0);
        }
#pragma unroll
        for (int r = 0; r < 4; ++r) { const int t = 4 * g + r; y16[(size_t)(row0 + (dir ? 15 - t : t)) * D + h * 64 + 16 * q + fr] = (h16)Y[r]; }
    }
    if (!lat) {
#pragma unroll
        for (int f = 0; f < 4; ++f) *(f32x4*)(p.out + (dir ? O_RWB : O_RWF) + soff + 16 * f) = St[f];
    }
    asm volatile("s_waitcnt vmcnt(0) lgkmcnt(0)" ::: "memory");
    __syncthreads();
}
__device__ __forceinline__ void phase_rwkvscan(const Params& p, const Ctx& c, int qn) {
    for (int u = next_unit(p, c, qn); u < 288; u = next_unit(p, c, qn)) {
        if (u < 32) rwkv_unit(p, c, true, u >> 4, u & 15);
        else { const int v = u - 32; rwkv_unit(p, c, false, v >> 4, v & 15); }
    }
}

__device__ __forceinline__ const float* ada_chunk(const Params& p, int layer, int row, int chunk) {
    return (const float*)(p.ws + WS_ADA) + (size_t)(layer * 3 + stream_of(row)) * 6144 + chunk * 1024;
}
__device__ __forceinline__ void phase_gemm_inproj(const Params& p, const Ctx& c) {
    float* proj = (float*)(p.ws + WS_PROJ);
    const float* rc = (const float*)(p.ws + WS_ROPE); const float* rs = rc + 32768;
    const int fr = c.lane & 15, fq = c.lane >> 4, wm = c.wave >> 1, wn = c.wave & 1;
    for (int u = c.bid; u < 24 * 17; u += c.G) {
        const int pm = u % 24, pn = u / 24;
        GemmTile g{(const h16*)(p.ws + WS_HA), D, (const h16*)(p.ws + WS_WIN), D, D, pm * 256, pn * 128};
        f32x4 acc[4][4]; gemm_tile<256>(c, g, acc);
        if (pn >= 6) {
#pragma unroll
            for (int i = 0; i < 4; ++i)
#pragma unroll
                for (int j = 0; j < 4; ++j)
                    *(f32x4*)(proj + (size_t)(g.m0 + wm * 64 + 16 * i + fr) * PROJ_LD + g.n0 + wn * 64 + 16 * j + 4 * fq) = acc[i][j];
            continue;
        }
#pragma unroll
        for (int i = 0; i < 4; ++i) {
            const int row = g.m0 + wm * 64 + 16 * i + fr;
            const bool lat = row >= NCTX;
            const int r2 = lat ? row - NCTX : row;
            const int b = lat ? (r2 >> 10) : (r2 >> 8), t = lat ? (r2 & 1023) : (r2 & 255);
            if (pn < 5) {
                float ss = 0.f;
#pragma unroll
                for (int j = 0; j < 4; ++j) ss += acc[i][j][0] * acc[i][j][0] + acc[i][j][1] * acc[i][j][1] + acc[i][j][2] * acc[i][j][2] + acc[i][j][3] * acc[i][j][3];
                ss = rowsum4(ss);
                const float rstd = rsqrtf(ss * (1.f / 64.f) + 1e-6f);
                const float* gw_ = (pn < 4) ? p.in[I_QG] : p.in[I_KG];
                f32x4 xn[4];
#pragma unroll
                for (int j = 0; j < 4; ++j) xn[j] = acc[i][j] * rstd * *(const f32x4*)(gw_ + 16 * j + 4 * fq);
                if (lat) {
#pragma unroll
                    for (int j = 0; j < 2; ++j) {
                        const f32x4 cs = *(const f32x4*)(rc + t * 32 + 16 * j + 4 * fq), sn = *(const f32x4*)(rs + t * 32 + 16 * j + 4 * fq);
                        const f32x4 x1 = xn[j], x2 = xn[j + 2];
                        xn[j] = x1 * cs - x2 * sn; xn[j + 2] = x1 * sn + x2 * cs;
                    }
                }
                if (pn < 4) {
                    h16* q16 = (h16*)(p.ws + WS_Q16) + (size_t)row * 512 + (2 * pn + wn) * 64 + 4 * fq;
#pragma unroll
                    for (int j = 0; j < 4; ++j) *(h16x4*)(q16 + 16 * j) = cvt4(xn[j] * 0.125f);
                } else {
                    h16* kd = lat ? (h16*)(p.ws + WS_K16L) + ((size_t)(b * 2 + wn) * 1280 + 256 + t) * 64 + 4 * fq
                                  : (h16*)(p.ws + WS_K16C) + ((size_t)(b * 2 + wn) * 256 + t) * 64 + 4 * fq;
#pragma unroll
                    for (int j = 0; j < 4; ++j) {
                        *(h16x4*)(kd + 16 * j) = cvt4(xn[j]);
                        if (!lat) *(f32x4*)(p.out + O_K + (size_t)row * 128 + wn * 64 + 16 * j + 4 * fq) = xn[j];
                    }
                }
            } else {
                h16* vt = lat ? (h16*)(p.ws + WS_VT16L) + (size_t)(b * 2 + wn) * 64 * 1280 + 256 + t
                              : (h16*)(p.ws + WS_VT16C) + (size_t)(b * 2 + wn) * 64 * 256 + t;
                const int ld = lat ? 1280 : 256;
#pragma unroll
                for (int j = 0; j < 4; ++j) {
#pragma unroll
                    for (int r = 0; r < 4; ++r) vt[(size_t)(16 * j + 4 * fq + r) * ld] = (h16)acc[i][j][r];
                    if (!lat) *(f32x4*)(p.out + O_V + (size_t)row * 128 + wn * 64 + 16 * j + 4 * fq) = acc[i][j];
                }
            }
        }
    }
}
__device__ __forceinline__ void phase_gemm_res(const Params& p, const Ctx& c, const h16* A, int lda, const h16* Bt, int K, int layer, int gate_chunk, bool init, bool dry, bool ffn_pre) {
    float* X = (float*)(p.ws + WS_X);
    float* Xw = dry ? (float*)(p.ws + WS_PROJ) : X;
    const int fr = c.lane & 15, fq = c.lane >> 4, wm = c.wave >> 1, wn = c.wave & 1;
    for (int u = c.bid; u < 32 * 8; u += c.G) {
        const int pm = u & 31, pn = u >> 5;
        GemmTile g{A, lda, Bt, K, K, pm * 192, pn * 128};
        f32x4 acc[3][4]; gemm_tile<192>(c, g, acc);
#pragma unroll
        for (int i = 0; i < 3; ++i) {
            const int row = g.m0 + wm * 48 + 16 * i + fr;
            const float* gt = ada_chunk(p, layer, row, gate_chunk);
            const float* base = init ? xin_row(p, row) : X + (size_t)row * D;
            float ss = 0.f;
            const float* scp = ada_chunk(p, layer, row, 4);
#pragma unroll
            for (int j = 0; j < 4; ++j) {
                const int col = g.n0 + wn * 64 + 16 * j + 4 * fq;
                const f32x4 xn = *(const f32x4*)(base + col) + *(const f32x4*)(gt + col) * acc[i][j];
                *(f32x4*)(Xw + (size_t)row * D + col) = xn;
                if (ffn_pre) {
                    ss += xn[0] * xn[0] + xn[1] * xn[1] + xn[2] * xn[2] + xn[3] * xn[3];
                    const f32x4 pre = xn * *(const f32x4*)(p.in[I_NFG] + layer * 1024 + col) * (*(const f32x4*)(scp + col) + 1.f);
                    *(h16x4*)((h16*)(p.ws + (layer ? WS_XMIX : WS_HA)) + (size_t)row * D + col) = cvt4(pre);
                }
            }
            if (ffn_pre) { ss = rowsum4(ss); if (fq == 0 && !dry) atomicAdd((float*)(p.ws + WS_ROWSS) + layer * NTOK + row, ss); }
        }
    }
}
__device__ __forceinline__ void phase_gemm_gu(const Params& p, const Ctx& c, int layer) {
    h16* hid = (h16*)(p.ws + WS_HID);
    const int fr = c.lane & 15, fq = c.lane >> 4, wm = c.wave >> 1, wn = c.wave & 1;
    for (int u = c.bid; u < 32 * 22; u += c.G) {
        const int pm = u & 31, pn = u >> 5;
        GemmTile g{(const h16*)(p.ws + (layer ? WS_XMIX : WS_HA)), D, (const h16*)(p.ws + WS_WGU) + (size_t)layer * 5632 * 1024, D, D, pm * 192, pn * 256};
        f32x4 acc[3][8]; gemm_tile_wide(c, g, acc);
#pragma unroll
        for (int i = 0; i < 3; ++i) {
            const int row = g.m0 + wm * 48 + 16 * i + fr;
            const float rstd = rsqrtf(((const float*)(p.ws + WS_ROWSS))[layer * NTOK + row] * (1.f / 1024.f) + 1e-6f);
#pragma unroll
            for (int cc = 0; cc < 2; ++cc) {
                const int nb0 = g.n0 + wn * 128 + 64 * cc + 4 * fq, hc0 = (g.n0 + wn * 128 + 64 * cc) / 2 + 4 * fq;
                const float* fb = (const float*)(p.ws + WS_FBIAS) + (size_t)(layer * 3 + stream_of(row)) * 5632 + nb0;
#pragma unroll
                for (int j = 0; j < 2; ++j) {
                    const f32x4 bg = *(const f32x4*)(fb + 16 * j), bu = *(const f32x4*)(fb + 16 * (j + 2));
                    f32x4 o;
#pragma unroll
                    for (int r = 0; r < 4; ++r) o[r] = silu_f(acc[i][4 * cc + j][r] * rstd + bg[r]) * (acc[i][4 * cc + j + 2][r] * rstd + bu[r]);
                    *(h16x4*)(hid + (size_t)row * FF + hc0 + 16 * j) = cvt4(o);
                }
            }
        }
    }
}
__device__ __forceinline__ void phase_gemm_rkv(const Params& p, const Ctx& c) {
    h16* lora = (h16*)(p.ws + WS_LORA16);
    const h16* xm = (const h16*)(p.ws + WS_XMIX);
    const int fr = c.lane & 15, fq = c.lane >> 4, wm = c.wave >> 1, wn = c.wave & 1;
    for (int u = c.bid; u < 24 * 27; u += c.G) {
        const int pm = u % 24, pn = u / 24;
        const int ai = pn < 8 ? 0 : pn < 16 ? 2 : pn < 24 ? 3 : pn == 24 ? 1 : pn == 25 ? 4 : 5;
        GemmTile g{xm + (size_t)ai * NTOK * D, D, (const h16*)(p.ws + WS_WRKV), D, D, pm * 256, pn * 128};
        f32x4 acc[4][4]; gemm_tile<256>(c, g, acc);
#pragma unroll
        for (int i = 0; i < 4; ++i) {
            const int row = g.m0 + wm * 64 + 16 * i + fr;
#pragma unroll
            for (int j = 0; j < 4; ++j) {
                const int col = g.n0 + wn * 64 + 16 * j + 4 * fq;
                f32x4 v = acc[i][j];
                if (pn < 24) *(h16x4*)((h16*)(p.ws + (pn < 8 ? WS_R16 : pn < 16 ? WS_K16 : WS_V16)) + (size_t)row * D + (col & 1023)) = cvt4(v);
                else {
                    if (pn == 24) { for (int r = 0; r < 4; ++r) v[r] = 2.f * sigmoid_f(2.f * v[r]) - 1.f; }
                    else if (pn == 26) { for (int r = 0; r < 4; ++r) v[r] = sigmoid_f(v[r]); }
                    *(h16x4*)(lora + (size_t)row * 384 + col - 3072) = cvt4(v);
                }
            }
        }
    }
}
__device__ __forceinline__ void phase_gemm_lora2(const Params& p, const Ctx& c) {
    const h16* lora = (const h16*)(p.ws + WS_LORA16);
    h16* dec16 = (h16*)(p.ws + WS_DEC16); h16* a16 = (h16*)(p.ws + WS_A16); h16* g16 = (h16*)(p.ws + WS_G16);
    const int fr = c.lane & 15, fq = c.lane >> 4, wm = c.wave >> 1, wn = c.wave & 1;
    for (int u = c.bid; u < 24 * 40; u += c.G) {
        const int pm = u % 24, pn = u / 24, gq = pn >> 3, n0 = (pn & 7) * 128;
        const int K = gq < 4 ? 64 : 128;
        const h16* A = lora + (gq < 2 ? 64 * gq : gq < 4 ? 128 + 64 * (gq - 2) : 256);
        const h16* Bt = gq < 2 ? (const h16*)(p.ws + WS_W2T) + (size_t)gq * 65536 : gq < 4 ? (const h16*)(p.ws + WS_A2T) + (size_t)(gq - 2) * 65536 : (const h16*)(p.ws + WS_G2T);
        GemmTile g{A, 384, Bt, K, K, pm * 256, n0};
        f32x4 acc[4][4]; gemm_tile<256>(c, g, acc);
#pragma unroll
        for (int i = 0; i < 4; ++i) {
            const int row = g.m0 + wm * 64 + 16 * i + fr;
#pragma unroll
            for (int j = 0; j < 4; ++j) {
                const int col = n0 + wn * 64 + 16 * j + 4 * fq;
                f32x4 v = acc[i][j];
                if (gq < 2) {
                    const f32x4 w0 = *(const f32x4*)(p.in[I_W0] + gq * 1024 + col);
                    for (int r = 0; r < 4; ++r) { const float wl = w0[r] + v[r]; const float uu = 0.60653066f * sigmoid_f(wl); v[r] = 1.f - __expf(-uu); }
                    *(h16x4*)(dec16 + ((size_t)gq * NTOK + row) * D + col) = cvt4(v);
                } else if (gq < 4) {
                    const f32x4 a0 = *(const f32x4*)(p.in[I_A0] + (gq - 2) * 1024 + col);
                    for (int r = 0; r < 4; ++r) v[r] = sigmoid_f(a0[r] + v[r]);
                    *(h16x4*)(a16 + ((size_t)(gq - 2) * NTOK + row) * D + col) = cvt4(v);
                } else *(h16x4*)(g16 + (size_t)row * D + col) = cvt4(v);
            }
        }
    }
}

#ifdef ONLY_PHASE
#define PH_ON(k) ((k) == ONLY_PHASE)
#else
#define PH_ON(k) true
#endif
#ifndef REP_MASK
#define REP_MASK 0u
#endif
#define NREP(k) (((REP_MASK >> (k)) & 1u) ? 2 : 1)
#define PHASE(k, call) do { if (PH_ON(k) && lo <= (k) && (k) < hi) { _Pragma("unroll") for (int rep = NREP(k) - 1; rep >= 0; --rep) { const bool dry = rep > 0; (void)dry; call; if ((k) + 1 < hi || dry) xcd_barrier(bar); } } } while (0)

__global__ void __launch_bounds__(NTHREADS, 2) mk_fwd(Params p) {
    extern __shared__ __attribute__((aligned(16))) unsigned char lds_raw[];
    Ctx c;
    c.lds = (LAS unsigned char*)lds_raw;
    c.tid = threadIdx.x; c.lane = c.tid & 63; c.wave = __builtin_amdgcn_readfirstlane(c.tid >> 6);
    c.bid = blockIdx.x; c.G = gridDim.x;
    volatile LAS unsigned* misc = (volatile LAS unsigned*)(c.lds + LDS_MISC);
    if (c.tid < 64) misc[c.tid] = 0u;
    __syncthreads();
    const int lo = p.ph_lo, hi = p.ph_hi;
    XcdBarrier bar; bar.bar = (unsigned*)(p.ws + WS_CTL); bar.x = 0; bar.st = nullptr;
    if (hi - lo > 1) bar = xcd_barrier_post((unsigned*)(p.ws + WS_CTL), misc + 8);
    PHASE(0, phase0(p, c));
    PHASE(1, phase_normmod(p, c, true, p.in[I_NMG], 0, 0, 1));
    PHASE(2, phase_gemm_inproj(p, c));
    PHASE(3, phase_postproj(p, c));
    PHASE(4, phase_mix0(p, c, dry ? 2 : 0));
    PHASE(5, phase_ssdcombine(p, c));
    PHASE(6, phase_gemm_res(p, c, (const h16*)(p.ws + WS_CAT), D, (const h16*)(p.ws + WS_WOUT), D, 0, 2, true, dry, true));
    PHASE(8, phase_gemm_gu(p, c, 0));
    PHASE(9, phase_gemm_res(p, c, (const h16*)(p.ws + WS_HID), FF, (const h16*)(p.ws + WS_WDN), FF, 0, 5, false, dry, false));
    PHASE(10, phase_rwkvmix(p, c));
    PHASE(11, phase_gemm_rkv(p, c));
    PHASE(12, phase_gemm_lora2(p, c));
    PHASE(13, phase_rwkvprep(p, c));
    PHASE(14, phase_rwkvscan(p, c, dry ? 3 : 1));
    PHASE(15, phase_rwkvpost(p, c));
    PHASE(16, phase_gemm_res(p, c, (const h16*)(p.ws + WS_HA), D, (const h16*)(p.ws + WS_WO), D, 1, 2, false, dry, true));
    PHASE(18, phase_gemm_gu(p, c, 1));
    PHASE(19, phase_gemm_res(p, c, (const h16*)(p.ws + WS_HID), FF, (const h16*)(p.ws + WS_WDN) + (size_t)1024 * 2816, FF, 1, 5, false, dry, false));
    PHASE(20, phase_final(p, c));
}

extern "C" void kernel_launch(void* const* d_in, const int* in_sizes, int n_in, void* d_out, int out_size, void* d_ws, size_t ws_size, hipStream_t stream) {
    static int grid = 0;
    if (grid == 0) {
        if (n_in != 46 || ws_size < WS_END) { fprintf(stderr, "kernel_launch: unexpected n_in %d or ws_size %zu\n", n_in, ws_size); grid = -1; return; }
        int dev = 0, cus = 0, per_cu = 0;
        (void)hipGetDevice(&dev);
        (void)hipDeviceGetAttribute(&cus, hipDeviceAttributeMultiprocessorCount, dev);
        if (hipFuncSetAttribute((const void*)mk_fwd, hipFuncAttributeMaxDynamicSharedMemorySize, LDS_BYTES) != hipSuccess) { fprintf(stderr, "kernel_launch: hipFuncSetAttribute failed\n"); grid = -1; return; }
        if (hipOccupancyMaxActiveBlocksPerMultiprocessor(&per_cu, (const void*)mk_fwd, NTHREADS, LDS_BYTES) != hipSuccess || per_cu < 1) { fprintf(stderr, "kernel_launch: occupancy query says %d\n", per_cu); }
        (void)hipGetLastError();
        grid = cus;
    }
    if (grid < 0) return;
    (void)hipMemsetAsync((char*)d_ws + WS_CTL, 0, CTL_ZERO_BYTES, stream);
    Params p{};
    for (int i = 0; i < 46; ++i) p.in[i] = (const float*)d_in[i];
    p.out = (float*)d_out; p.ws = (unsigned char*)d_ws;
#if MK_N_LAUNCHES == 1
    p.ph_lo = 0; p.ph_hi = NPH;
    hipLaunchKernelGGL(mk_fwd, dim3(grid), dim3(NTHREADS), LDS_BYTES, stream, p);
#else
    for (int ph = 0; ph < NPH; ++ph) { p.ph_lo = ph; p.ph_hi = ph + 1; hipLaunchKernelGGL(mk_fwd, dim3(grid), dim3(NTHREADS), LDS_BYTES, stream, p); }
#endif
}
```

```cpp
#include <hip/hip_runtime.h>
#include <cstdio>
#include <cstdint>

#ifndef MK_N_LAUNCHES
#define MK_N_LAUNCHES 1
#endif

#define LAS __attribute__((address_space(3)))
#define GAS __attribute__((address_space(1)))
typedef _Float16 h16;
typedef _Float16 h16x2 __attribute__((ext_vector_type(2)));
typedef _Float16 h16x4 __attribute__((ext_vector_type(4)));
typedef _Float16 h16x8 __attribute__((ext_vector_type(8)));
typedef float f32x4 __attribute__((ext_vector_type(4)));
typedef float f32x2 __attribute__((ext_vector_type(2)));
typedef unsigned u32x4 __attribute__((ext_vector_type(4)));

constexpr int D = 1024, NTOK = 6144, NCTX = 4096, FF = 2816;
constexpr int PROJ_LD = 2176;
constexpr int NPH = 21;
constexpr int NWAVES = 8, NTHREADS = 512;

constexpr size_t MiB = 1u << 20;
constexpr size_t WS_CTL = 0, CTL_ZERO_BYTES = 32768;
constexpr size_t WS_WIN = 1 * MiB;
constexpr size_t WS_WOUT = 6 * MiB;
constexpr size_t WS_WGU = 8 * MiB;
constexpr size_t WS_WDN = 30 * MiB;
constexpr size_t WS_WRKV = 41 * MiB;
constexpr size_t WS_WO = 48 * MiB;
constexpr size_t WS_W2T = 50 * MiB;
constexpr size_t WS_A2T = WS_W2T + 262144;
constexpr size_t WS_G2T = WS_A2T + 262144;
constexpr size_t WS_ADA = 51 * MiB;
constexpr size_t WS_ROPE = WS_ADA + 262144;
constexpr size_t WS_ROWSS = WS_ADA + 524288;
constexpr size_t WS_FBIAS = WS_ADA + 589824;
constexpr size_t WS_X = 52 * MiB;
constexpr size_t WS_HA = 76 * MiB;
constexpr size_t WS_HID = 88 * MiB;
constexpr size_t WS_PROJ = 121 * MiB;
constexpr size_t WS_Q16 = 172 * MiB;
constexpr size_t WS_K16C = 178 * MiB;
constexpr size_t WS_VT16C = 179 * MiB;
constexpr size_t WS_K16L = 180 * MiB;
constexpr size_t WS_VT16L = 181 * MiB;
constexpr size_t WS_CAT = 182 * MiB;
constexpr size_t WS_XBC = 194 * MiB;
constexpr size_t WS_DT = 212 * MiB;
constexpr size_t WS_DA = WS_DT + 6144 * 16 * 4;
constexpr size_t WS_SSDY = 213 * MiB;
constexpr size_t WS_G16 = 1 * MiB;
constexpr size_t WS_BONUS = 13 * MiB;
constexpr size_t WS_LORA16 = 76 * MiB;
constexpr size_t WS_R16 = 88 * MiB;
constexpr size_t WS_K16 = 100 * MiB;
constexpr size_t WS_Y16 = 88 * MiB;
constexpr size_t WS_V16 = 112 * MiB;
constexpr size_t WS_XMIX = 124 * MiB;
constexpr size_t WS_DEC16 = 124 * MiB;
constexpr size_t WS_A16 = 148 * MiB;
constexpr size_t WS_OPS2 = 172 * MiB;
constexpr size_t OPS2_ITEM = 6400;
constexpr size_t WS_END = 256 * MiB;

constexpr size_t O_Y = 0, O_K = 6291456, O_V = 6815744, O_SSDF = 7340032, O_SSDB = 7864320, O_RWF = 8388608, O_RWB = 9437184;

constexpr int LDS_BYTES = 148480;
constexpr int LDS_MISC = 147456;

struct Params {
    const float* in[46];
    float* out;
    unsigned char* ws;
    int ph_lo, ph_hi;
};
enum { I_XP = 0, I_XS, I_CK, I_CV, I_SSDF, I_SSDB, I_RWF, I_RWB, I_C, I_CCTX, I_MODW, I_MODB, I_NMG, I_NFG, I_WG, I_WU, I_WD,
       I_WIN, I_WOUT, I_QG, I_KG, I_CONVW, I_CONVB, I_DTB, I_ALOG, I_SSDD, I_SSDG, I_MU, I_WR, I_WK, I_WV, I_W0, I_W1, I_W2,
       I_A0, I_A1, I_A2, I_G1, I_G2, I_KKW, I_KA, I_RK, I_LNG, I_LNB, I_WO, I_FNG };

struct Ctx { int tid, lane, wave, bid, G; LAS unsigned char* lds; };

__device__ __forceinline__ float wave_sum(float v) {
#pragma unroll
    for (int o = 1; o < 64; o <<= 1) v += __shfl_xor(v, o);
    return v;
}
__device__ __forceinline__ float sigmoid_f(float x) { return __builtin_amdgcn_rcpf(1.f + __expf(-x)); }
__device__ __forceinline__ float silu_f(float x) { return x * sigmoid_f(x); }
__device__ __forceinline__ float softplus_f(float x) { return fmaxf(x, 0.f) + log1pf(__expf(-fabsf(x))); }
__device__ __forceinline__ int stream_of(int row) { return row < NCTX ? 0 : 1 + ((row - NCTX) >> 10); }
__device__ __forceinline__ h16x4 cvt4(f32x4 v) { h16x4 o; o.x = (h16)v.x; o.y = (h16)v.y; o.z = (h16)v.z; o.w = (h16)v.w; return o; }

template <int M> __device__ __forceinline__ void fmac_bc(float& d, float a, float b) {
    asm("v_fmac_f32_dpp %0, %1, %2 row_newbcast:%3 row_mask:0xf bank_mask:0xf" : "+v"(d) : "v"(a), "v"(b), "n"(M));
}
template <int M> __device__ __forceinline__ void fmac_bc_safe(float& d, float a, float b) {
    asm volatile("s_nop 1\n\tv_fmac_f32_dpp %0, %1, %2 row_newbcast:%3 row_mask:0xf bank_mask:0xf\n\ts_nop 1" : "+v"(d) : "v"(a), "v"(b), "n"(M));
}
template <int M> __device__ __forceinline__ void mul_bc(float& d, float a) {
    asm("v_mul_f32_dpp %0, %1, %0 row_newbcast:%2 row_mask:0xf bank_mask:0xf" : "+v"(d) : "v"(a), "n"(M));
}
__device__ __forceinline__ float rowsum4(float x) {
    float a = x, b = x;
    asm volatile("s_nop 1\n\tv_permlane16_swap_b32 %0, %1\n\ts_nop 1" : "+v"(a), "+v"(b));
    x = a + b; a = x; b = x;
    asm volatile("s_nop 1\n\tv_permlane32_swap_b32 %0, %1\n\ts_nop 1" : "+v"(a), "+v"(b));
    return a + b;
}

#define XB_TMO      128
#define XB_XCNT(j)  (256  + 64 * (j))
#define XB_XSUB(j)  (1280 + 64 * (j))
#define XB_XGEN(j)  (2304 + 64 * (j))
#define XB_TOP      3328
#define XB_TOPGEN   3392
#define XCD_BAR_WORDS 3456
#define XB_SPIN_CAP (1u << 22)
__device__ __forceinline__ unsigned xb_ld(unsigned* p)              { return __hip_atomic_load(p, __ATOMIC_RELAXED, __HIP_MEMORY_SCOPE_AGENT); }
__device__ __forceinline__ unsigned xb_add(unsigned* p, unsigned v) { return __hip_atomic_fetch_add(p, v, __ATOMIC_RELAXED, __HIP_MEMORY_SCOPE_AGENT); }
__device__ __forceinline__ unsigned xb_xcc_id() { return (unsigned)__builtin_amdgcn_s_getreg((3 << 11) | 20) & 0xFu; }
#define XB_SPIN(cond, bar) do { unsigned _sp = 0; while (cond) { __builtin_amdgcn_s_sleep(1); \
    if ((++_sp & 255u) == 0u) { if (xb_ld(&(bar)[XB_TMO])) break; if (_sp > XB_SPIN_CAP) { atomicAdd(&(bar)[XB_TMO], 1u); break; } } } } while (0)
struct XcdBarrier { unsigned* bar; unsigned x; volatile LAS unsigned* st; };
__device__ __forceinline__ XcdBarrier xcd_barrier_post(unsigned* bar, volatile LAS unsigned* st) {
    XcdBarrier b; b.bar = bar; b.x = xb_xcc_id(); b.st = st;
    if (threadIdx.x == 0) (void)xb_add(&bar[XB_XCNT(b.x)], 1u);
    return b;
}
__device__ __forceinline__ void xcd_barrier_complete(unsigned* bar, unsigned x, unsigned& nloc, unsigned& nx) {
    const unsigned G = gridDim.x * gridDim.y * gridDim.z;
    unsigned sum, cnt, mine, sp = 0u;
    for (;;) {
        sum = 0u; cnt = 0u; mine = 0u;
#pragma unroll
        for (unsigned j = 0; j < 16; ++j) { const unsigned c = xb_ld(&bar[XB_XCNT(j)]); sum += c; cnt += (c > 0u) ? 1u : 0u; mine = (j == x) ? c : mine; }
        if (sum == G) break;
        __builtin_amdgcn_s_sleep(1);
        if ((++sp & 255u) == 0u) { if (xb_ld(&bar[XB_TMO])) break; if (sp > XB_SPIN_CAP) { atomicAdd(&bar[XB_TMO], 1u); break; } }
    }
    nloc = mine > 0u ? mine : 1u; nx = cnt > 0u ? cnt : 1u;
}
__device__ __forceinline__ void xcd_barrier(const XcdBarrier& b) {
    asm volatile("s_waitcnt vmcnt(0)" ::: "memory");
    __syncthreads();
    if (threadIdx.x == 0) {
        unsigned* bar = b.bar;
        __builtin_amdgcn_s_waitcnt(0);
        unsigned nloc = b.st[0], nx = b.st[1];
        if (nloc == 0u) { xcd_barrier_complete(bar, b.x, nloc, nx); b.st[0] = nloc; b.st[1] = nx; }
        const unsigned old = xb_add(&bar[XB_XSUB(b.x)], 1u);
        const unsigned gen = old / nloc;
        if (old + 1u == (gen + 1u) * nloc) {
            __builtin_amdgcn_fence(__ATOMIC_RELEASE, "agent");
            asm volatile("s_waitcnt vmcnt(0)" ::: "memory");
            const unsigned og = xb_add(&bar[XB_TOP], 1u);
            const unsigned tg = og / nx;
            if (og + 1u == (tg + 1u) * nx) xb_add(&bar[XB_TOPGEN], 1u);
            else XB_SPIN(xb_ld(&bar[XB_TOPGEN]) == tg, bar);
            __builtin_amdgcn_fence(__ATOMIC_ACQUIRE, "agent");
            xb_add(&bar[XB_XGEN(b.x)], 1u);
            asm volatile("s_waitcnt vmcnt(0)" ::: "memory");
        } else {
            XB_SPIN(xb_ld(&bar[XB_XGEN(b.x)]) == gen, bar);
            __builtin_amdgcn_fence(__ATOMIC_ACQUIRE, "agent");
            asm volatile("s_waitcnt vmcnt(0)" ::: "memory");
        }
    }
    __syncthreads();
}

struct GemmTile { const h16* A; int lda; const h16* Bt; int ldb; int K; int m0, n0; };
constexpr int GEMM_STAGE_BYTES = 49152;

template <int BM>
__device__ __forceinline__ void gemm_tile(const Ctx& c, const GemmTile& g, f32x4 (&acc)[BM / 64][4]) {
    constexpr int MF = BM / 64, WM = BM / 4;
    LAS unsigned char* lds = c.lds;
    const int tid = c.tid, lane = c.lane, wave = c.wave;
    const int wm = wave >> 1, wn = wave & 1;
    const int srow = tid >> 3, schunk = (tid & 7) ^ (srow & 7);
    const h16* gA = g.A + (size_t)(g.m0 + srow) * g.lda + schunk * 8;
    const h16* gB = g.Bt + (size_t)(g.n0 + srow) * g.ldb + schunk * 8;
    const size_t stepA = (size_t)64 * g.lda, stepB = (size_t)64 * g.ldb;
    const unsigned ldsw = (unsigned)wave * 1024u;
    const int fr = lane & 15, fq = lane >> 4;
    int offA[2], offB[2];
#pragma unroll
    for (int s = 0; s < 2; ++s) {
        offA[s] = (wm * WM + fr) * 128 + (((s * 4 + fq) ^ (fr & 7)) << 4);
        offB[s] = 32768 + (wn * 64 + fr) * 128 + (((s * 4 + fq) ^ (fr & 7)) << 4);
    }
#pragma unroll
    for (int i = 0; i < MF; ++i)
#pragma unroll
        for (int j = 0; j < 4; ++j) acc[i][j] = (f32x4){0.f, 0.f, 0.f, 0.f};
    const int nk = g.K >> 6;
#define GEMM_STAGE(kt, buf) do { \
        _Pragma("unroll") for (int _p = 0; _p < MF; ++_p) \
            __builtin_amdgcn_global_load_lds((const unsigned*)(gA + _p * stepA + (size_t)(kt) * 64), (LAS unsigned*)(lds + (buf) * GEMM_STAGE_BYTES + _p * 8192 + ldsw), 16, 0, 0); \
        _Pragma("unroll") for (int _p = 0; _p < 2; ++_p) \
            __builtin_amdgcn_global_load_lds((const unsigned*)(gB + _p * stepB + (size_t)(kt) * 64), (LAS unsigned*)(lds + (buf) * GEMM_STAGE_BYTES + 32768 + _p * 8192 + ldsw), 16, 0, 0); \
    } while (0)
    GEMM_STAGE(0, 0);
    if (nk > 1) GEMM_STAGE(1, 1);
    int cur = 0;
    for (int kt = 0; kt < nk; ++kt) {
        if (kt + 1 < nk) { if (MF == 4) asm volatile("s_waitcnt vmcnt(6)" ::: "memory"); else asm volatile("s_waitcnt vmcnt(5)" ::: "memory"); }
        else asm volatile("s_waitcnt vmcnt(0)" ::: "memory");
        asm volatile("s_waitcnt lgkmcnt(0)" ::: "memory");
        __builtin_amdgcn_s_barrier();
        asm volatile("" ::: "memory");
        if (kt + 2 < nk) { const int nb = cur >= 1 ? cur - 1 : 2; GEMM_STAGE(kt + 2, nb); }
        const LAS unsigned char* lb = lds + cur * GEMM_STAGE_BYTES;
#pragma unroll
        for (int s = 0; s < 2; ++s) {
            h16x8 af[MF], bf[4];
#pragma unroll
            for (int i = 0; i < MF; ++i) af[i] = *(const LAS h16x8*)(lb + offA[s] + i * 2048);
#pragma unroll
            for (int j = 0; j < 4; ++j) bf[j] = *(const LAS h16x8*)(lb + offB[s] + j * 2048);
#pragma unroll
            for (int i = 0; i < MF; ++i)
#pragma unroll
                for (int j = 0; j < 4; ++j) acc[i][j] = __builtin_amdgcn_mfma_f32_16x16x32_f16(bf[j], af[i], acc[i][j], 0, 0, 0);
        }
        cur = cur == 2 ? 0 : cur + 1;
    }
    asm volatile("s_waitcnt lgkmcnt(0)" ::: "memory");
    __builtin_amdgcn_s_barrier();
    asm volatile("" ::: "memory");
#undef GEMM_STAGE
}

constexpr int GEMMW_STAGE = 57344;
__device__ __forceinline__ void gemm_tile_wide(const Ctx& c, const GemmTile& g, f32x4 (&acc)[3][8]) {
    LAS unsigned char* lds = c.lds;
    const int tid = c.tid, lane = c.lane, wave = c.wave;
    const int wm = wave >> 1, wn = wave & 1;
    const int srow = tid >> 3, schunk = (tid & 7) ^ (srow & 7);
    const h16* gA = g.A + (size_t)(g.m0 + srow) * g.lda + schunk * 8;
    const h16* gB = g.Bt + (size_t)(g.n0 + srow) * g.ldb + schunk * 8;
    const size_t stepA = (size_t)64 * g.lda, stepB = (size_t)64 * g.ldb;
    const unsigned ldsw = (unsigned)wave * 1024u;
    const int fr = lane & 15, fq = lane >> 4;
    int offA[2], offB[2];
#pragma unroll
    for (int s = 0; s < 2; ++s) {
        offA[s] = (wm * 48 + fr) * 128 + (((s * 4 + fq) ^ (fr & 7)) << 4);
        offB[s] = 24576 + (wn * 128 + fr) * 128 + (((s * 4 + fq) ^ (fr & 7)) << 4);
    }
#pragma unroll
    for (int i = 0; i < 3; ++i)
#pragma unroll
        for (int j = 0; j < 8; ++j) acc[i][j] = (f32x4){0.f, 0.f, 0.f, 0.f};
    const int nk = g.K >> 6;
#define GW_STAGE(kt, buf) do { \
        _Pragma("unroll") for (int _p = 0; _p < 3; ++_p) \
            __builtin_amdgcn_global_load_lds((const unsigned*)(gA + _p * stepA + (size_t)(kt) * 64), (LAS unsigned*)(lds + (buf) * GEMMW_STAGE + _p * 8192 + ldsw), 16, 0, 0); \
        _Pragma("unroll") for (int _p = 0; _p < 4; ++_p) \
            __builtin_amdgcn_global_load_lds((const unsigned*)(gB + _p * stepB + (size_t)(kt) * 64), (LAS unsigned*)(lds + (buf) * GEMMW_STAGE + 24576 + _p * 8192 + ldsw), 16, 0, 0); \
    } while (0)
    GW_STAGE(0, 0);
    for (int kt = 0; kt < nk; ++kt) {
        asm volatile("s_waitcnt vmcnt(0)" ::: "memory");
        asm volatile("s_waitcnt lgkmcnt(0)" ::: "memory");
        __builtin_amdgcn_s_barrier();
        asm volatile("" ::: "memory");
        const int cur = kt & 1;
        if (kt + 1 < nk) GW_STAGE(kt + 1, cur ^ 1);
        const LAS unsigned char* lb = lds + cur * GEMMW_STAGE;
#pragma unroll
        for (int s = 0; s < 2; ++s) {
            h16x8 af[3], bf[8];
#pragma unroll
            for (int i = 0; i < 3; ++i) af[i] = *(const LAS h16x8*)(lb + offA[s] + i * 2048);
#pragma unroll
            for (int j = 0; j < 8; ++j) bf[j] = *(const LAS h16x8*)(lb + offB[s] + j * 2048);
#pragma unroll
            for (int i = 0; i < 3; ++i)
#pragma unroll
                for (int j = 0; j < 8; ++j) acc[i][j] = __builtin_amdgcn_mfma_f32_16x16x32_f16(bf[j], af[i], acc[i][j], 0, 0, 0);
        }
    }
    asm volatile("s_waitcnt lgkmcnt(0)" ::: "memory");
    __builtin_amdgcn_s_barrier();
    asm volatile("" ::: "memory");
#undef GW_STAGE
}

__device__ __forceinline__ void tr_item(const float* W, int ldw, int nvalid, int k0, int n0, h16* dst, int ldd, int drow0, LAS float* scr, int lane) {
    const int c4 = lane & 7, kr = lane >> 3;
    const bool ok = (n0 + 4 * c4) < nvalid;
#pragma unroll
    for (int i = 0; i < 8; ++i) {
        const int kk = kr + 8 * i;
        const f32x4 v = ok ? *(const f32x4*)(W + (size_t)(k0 + kk) * ldw + n0 + 4 * c4) : (f32x4){0.f, 0.f, 0.f, 0.f};
        LAS float* s = scr + kk * 33 + 4 * c4;
        s[0] = v[0]; s[1] = v[1]; s[2] = v[2]; s[3] = v[3];
    }
    asm volatile("s_waitcnt lgkmcnt(0)" ::: "memory");
    const int cch = lane & 7;
#pragma unroll
    for (int j = 0; j < 4; ++j) {
        const int n = (lane >> 3) + 8 * j; const LAS float* s = scr + (8 * cch) * 33 + n;
        h16x8 o;
#pragma unroll
        for (int e = 0; e < 8; ++e) o[e] = (h16)s[e * 33];
        *(h16x8*)(dst + (size_t)(drow0 + n) * ldd + k0 + 8 * cch) = o;
    }
    asm volatile("s_waitcnt lgkmcnt(0)" ::: "memory");
}
struct TrJob { const float* src; int K, N, ldw, nvalid; h16* dst; int ldd, kind, base; };
__device__ __forceinline__ int tr_job(const Params& p, int j, TrJob& J) {
    unsigned char* ws = p.ws;
    switch (j) {
    case 0: J = {p.in[I_WIN], 1024, 2176, 2064, 2064, (h16*)(ws + WS_WIN), 1024, 0, 0}; break;
    case 1: J = {p.in[I_WOUT], 1024, 1024, 1024, 1024, (h16*)(ws + WS_WOUT), 1024, 0, 0}; break;
    case 2: case 3: J = {p.in[I_WG] + (size_t)(j - 2) * 1024 * 2816, 1024, 2816, 2816, 2816, (h16*)(ws + WS_WGU) + (size_t)(j - 2) * 5632 * 1024, 1024, 1, 0}; break;
    case 4: case 5: J = {p.in[I_WU] + (size_t)(j - 4) * 1024 * 2816, 1024, 2816, 2816, 2816, (h16*)(ws + WS_WGU) + (size_t)(j - 4) * 5632 * 1024, 1024, 2, 0}; break;
    case 6: case 7: J = {p.in[I_WD] + (size_t)(j - 6) * 2816 * 1024, 2816, 1024, 1024, 1024, (h16*)(ws + WS_WDN) + (size_t)(j - 6) * 1024 * 2816, 2816, 0, 0}; break;
    case 8: J = {p.in[I_WR], 1024, 1024, 1024, 1024, (h16*)(ws + WS_WRKV), 1024, 0, 0}; break;
    case 9: J = {p.in[I_WK], 1024, 1024, 1024, 1024, (h16*)(ws + WS_WRKV), 1024, 0, 1024}; break;
    case 10: J = {p.in[I_WV], 1024, 1024, 1024, 1024, (h16*)(ws + WS_WRKV), 1024, 0, 2048}; break;
    case 11: case 12: J = {p.in[I_W1] + (size_t)(j - 11) * 1024 * 64, 1024, 64, 64, 64, (h16*)(ws + WS_WRKV), 1024, 0, 3072 + 64 * (j - 11)}; break;
    case 13: case 14: J = {p.in[I_A1] + (size_t)(j - 13) * 1024 * 64, 1024, 64, 64, 64, (h16*)(ws + WS_WRKV), 1024, 0, 3072 + 128 + 64 * (j - 13)}; break;
    case 15: J = {p.in[I_G1], 1024, 128, 128, 128, (h16*)(ws + WS_WRKV), 1024, 0, 3072 + 256}; break;
    case 16: J = {p.in[I_WO], 1024, 1024, 1024, 1024, (h16*)(ws + WS_WO), 1024, 0, 0}; break;
    case 17: case 18: J = {p.in[I_W2] + (size_t)(j - 17) * 64 * 1024, 64, 1024, 1024, 1024, (h16*)(ws + WS_W2T) + (size_t)(j - 17) * 1024 * 64, 64, 0, 0}; break;
    case 19: case 20: J = {p.in[I_A2] + (size_t)(j - 19) * 64 * 1024, 64, 1024, 1024, 1024, (h16*)(ws + WS_A2T) + (size_t)(j - 19) * 1024 * 64, 64, 0, 0}; break;
    default: J = {p.in[I_G2], 128, 1024, 1024, 1024, (h16*)(ws + WS_G2T), 128, 0, 0}; break;
    }
    return (J.K / 64) * (J.N / 32);
}
constexpr int N_TRJOBS = 22;

__device__ __forceinline__ void ada_unit(const Params& p, const Ctx& c, int u) {
    LAS float* sc = (LAS float*)c.lds;
    LAS float* red = (LAS float*)(c.lds + 16384);
    const int layer = u / 96, cb = u % 96;
    __syncthreads();
    for (int i = c.tid; i < 3072; i += NTHREADS) {
        const int k = i >> 10, d = i & 1023;
        const float v = (k == 0) ? p.in[I_CCTX][d] : p.in[I_C][(k - 1) * 1024 + d];
        sc[i] = silu_f(v);
    }
    __syncthreads();
    const int tx = c.tid & 15, dg = c.tid >> 4;
    const float* w = p.in[I_MODW] + (size_t)layer * 1024 * 6144 + (size_t)(dg * 32) * 6144 + cb * 64 + tx * 4;
    f32x4 a0 = {0, 0, 0, 0}, a1 = a0, a2 = a0;
#pragma unroll 8
    for (int d = 0; d < 32; ++d) {
        const f32x4 wv = *(const f32x4*)(w + (size_t)d * 6144);
        const int dd = dg * 32 + d;
        a0 += wv * sc[dd]; a1 += wv * sc[1024 + dd]; a2 += wv * sc[2048 + dd];
    }
    *(LAS f32x4*)(red + (dg * 3 + 0) * 64 + tx * 4) = a0;
    *(LAS f32x4*)(red + (dg * 3 + 1) * 64 + tx * 4) = a1;
    *(LAS f32x4*)(red + (dg * 3 + 2) * 64 + tx * 4) = a2;
    __syncthreads();
    if (c.tid < 192) {
        const int k = c.tid >> 6, col = c.tid & 63;
        float s = p.in[I_MODB][layer * 6144 + cb * 64 + col];
#pragma unroll 8
        for (int g = 0; g < 32; ++g) s += red[(g * 3 + k) * 64 + col];
        ((float*)(p.ws + WS_ADA))[(layer * 3 + k) * 6144 + cb * 64 + col] = s;
    }
}

constexpr int N_CONV_ITEMS = 11392, N_CONV_UNITS = N_CONV_ITEMS / 64;
__device__ __forceinline__ void conv_unit(const Params& p, const Ctx& c, int u) {
    LAS float* scr = (LAS float*)(c.lds + c.wave * 16384);
    __syncthreads();
    for (int e = 0; e < 8; ++e) {
        int it = u * 64 + c.wave * 8 + e;
        int j = 1; TrJob J; int cnt = tr_job(p, j, J);
        while (it >= cnt) { it -= cnt; ++j; cnt = tr_job(p, j, J); }
        const int nblk = J.N / 32, kb = it / nblk, nb = it % nblk, n0 = nb * 32;
        const int drow0 = J.kind == 0 ? J.base + n0 : (J.kind == 1 ? 2 * n0 : 2 * n0 + 32);
        tr_item(J.src, J.ldw, J.nvalid, kb * 64, n0, J.dst, J.ldd, drow0, scr, c.lane);
    }
    __syncthreads();
}
__device__ __forceinline__ void phase0(const Params& p, const Ctx& c) {
    for (int u = c.bid; u < 192; u += c.G) ada_unit(p, c, u);
    __syncthreads();
    {
        LAS float* scr = (LAS float*)(c.lds + c.wave * 16384);
        const int gw = c.bid * NWAVES + c.wave, NGW = c.G * NWAVES;
        TrJob J; const int cnt = tr_job(p, 0, J);
        const int nblk = J.N / 32;
        for (int it = gw; it < cnt; it += NGW) {
            const int kb = it / nblk, nb = it % nblk, n0 = nb * 32;
            tr_item(J.src, J.ldw, J.nvalid, kb * 64, n0, J.dst, J.ldd, J.base + n0, scr, c.lane);
        }
    }
    { float* rs_ = (float*)(p.ws + WS_ROWSS); for (int i = c.bid * NTHREADS + c.tid; i < 2 * NTOK; i += c.G * NTHREADS) rs_[i] = 0.f; }
    const int gt = c.bid * NTHREADS + c.tid, NGT = c.G * NTHREADS;
    float* rc = (float*)(p.ws + WS_ROPE); float* rs = rc + 32768;
    for (int i = gt; i < 32768; i += NGT) {
        const int tok = i >> 5, f = i & 31;
        const float pos = (float)((f < 16) ? (tok >> 6) : (tok & 63));
        const float inv = powf(10000.f, -(float)(f & 15) / 16.f);
        const float ang = pos * inv;
        rc[i] = cosf(ang); rs[i] = sinf(ang);
    }
    h16* k16l = (h16*)(p.ws + WS_K16L); h16* vt16l = (h16*)(p.ws + WS_VT16L);
    for (int i = gt; i < 65536; i += NGT) {
        const int d = i & 63, kvh = (i >> 6) & 1, key = (i >> 7) & 255, b = i >> 15;
        k16l[((size_t)(b * 2 + kvh) * 1280 + key) * 64 + d] = (h16)p.in[I_CK][i];
        vt16l[((size_t)(b * 2 + kvh) * 64 + d) * 1280 + key] = (h16)p.in[I_CV][i];
    }
}

__device__ __forceinline__ void load_row(const float* r, int lane, f32x4 (&v)[4]) {
#pragma unroll
    for (int j = 0; j < 4; ++j) v[j] = *(const f32x4*)(r + 256 * j + 4 * lane);
}
__device__ __forceinline__ float row_rstd(const f32x4 (&v)[4]) {
    float s = 0.f;
#pragma unroll
    for (int j = 0; j < 4; ++j) s += v[j].x * v[j].x + v[j].y * v[j].y + v[j].z * v[j].z + v[j].w * v[j].w;
    return rsqrtf(wave_sum(s) * (1.f / 1024.f) + 1e-6f);
}
__device__ __forceinline__ const float* xin_row(const Params& p, int row) {
    return row < NCTX ? p.in[I_XP] + (size_t)row * D : p.in[I_XS] + (size_t)(row - NCTX) * D;
}
__device__ __forceinline__ void phase_normmod(const Params& p, const Ctx& c, bool from_input, const float* g, int layer, int ch_sh, int ch_sc) {
    const int gw = c.bid * NWAVES + c.wave, NGW = c.G * NWAVES;
    const float* ada = (const float*)(p.ws + WS_ADA);
    h16* hA = (h16*)(p.ws + WS_HA);
    for (int row = gw; row < NTOK; row += NGW) {
        const float* xr = from_input ? xin_row(p, row) : (const float*)(p.ws + WS_X) + (size_t)row * D;
        f32x4 v[4]; load_row(xr, c.lane, v);
        const float rstd = row_rstd(v);
        const float* a = ada + (size_t)(layer * 3 + stream_of(row)) * 6144;
#pragma unroll
        for (int j = 0; j < 4; ++j) {
            const int col = 256 * j + 4 * c.lane;
            const f32x4 gg = *(const f32x4*)(g + col), sh = *(const f32x4*)(a + ch_sh * 1024 + col), sc = *(const f32x4*)(a + ch_sc * 1024 + col);
            const f32x4 o = v[j] * rstd * gg * (sc + 1.f) + sh;
            *(h16x4*)(hA + (size_t)row * D + col) = cvt4(o);
        }
    }
}

__device__ __forceinline__ void phase_postproj(const Params& p, const Ctx& c) {
    const int gw = c.bid * NWAVES + c.wave, NGW = c.G * NWAVES, lane = c.lane;
    const float* proj = (const float*)(p.ws + WS_PROJ);
    float* xbc = (float*)(p.ws + WS_XBC);
    float* dtv = (float*)(p.ws + WS_DT);
    for (int it = gw; it < 384 * 3; it += NGW) {
        const int seg = it / 3, cb = it % 3, row0 = seg * 16, ch = cb * 256 + lane * 4;
        const int T = row0 >= NCTX ? 1024 : 256, t0 = (row0 >= NCTX ? row0 - NCTX : row0) & (T - 1);
        f32x4 x[20];
#pragma unroll
        for (int r = 0; r < 20; ++r) {
            const int tt = t0 + r - 2;
            x[r] = (tt >= 0 && tt < T) ? *(const f32x4*)(proj + (size_t)(row0 + r - 2) * PROJ_LD + 1280 + ch) : (f32x4){0.f, 0.f, 0.f, 0.f};
        }
        f32x4 w[5];
#pragma unroll
        for (int i = 0; i < 5; ++i) w[i] = *(const f32x4*)(p.in[I_CONVW] + i * 768 + ch);
        const f32x4 bias = *(const f32x4*)(p.in[I_CONVB] + ch);
#pragma unroll
        for (int r = 0; r < 16; ++r) {
            f32x4 a = bias;
#pragma unroll
            for (int i = 0; i < 5; ++i) a += w[i] * x[r + i];
            f32x4 o; o[0] = silu_f(a[0]); o[1] = silu_f(a[1]); o[2] = silu_f(a[2]); o[3] = silu_f(a[3]);
            *(f32x4*)(xbc + (size_t)(row0 + r) * 768 + ch) = o;
        }
    }
    for (int it = gw; it < NTOK / 4; it += NGW) {
        const int row = it * 4 + (lane >> 4), e = lane & 15;
        dtv[row * 16 + e] = softplus_f(proj[(size_t)row * PROJ_LD + 2048 + e] + p.in[I_DTB][e]);
    }
}

__device__ __forceinline__ void phase_ssdcombine(const Params& p, const Ctx& c) {
    const int gw = c.bid * NWAVES + c.wave, NGW = c.G * NWAVES, lane = c.lane;
    {
        const float* ada = (const float*)(p.ws + WS_ADA); float* fb = (float*)(p.ws + WS_FBIAS);
        for (int it = gw; it < 2 * 5632; it += NGW) {
            const int l = it / 5632, n = it % 5632;
            const h16* wr = (const h16*)(p.ws + WS_WGU) + ((size_t)l * 5632 + n) * 1024 + lane * 16;
            const h16x8 w0 = *(const h16x8*)wr, w1 = *(const h16x8*)(wr + 8);
            float a0 = 0.f, a1 = 0.f, a2 = 0.f;
#pragma unroll
            for (int e = 0; e < 16; ++e) {
                const float w = (float)(e < 8 ? w0[e & 7] : w1[e & 7]); const int k = lane * 16 + e;
                a0 += w * ada[(size_t)(l * 3 + 0) * 6144 + 3072 + k]; a1 += w * ada[(size_t)(l * 3 + 1) * 6144 + 3072 + k]; a2 += w * ada[(size_t)(l * 3 + 2) * 6144 + 3072 + k];
            }
            a0 = wave_sum(a0); a1 = wave_sum(a1); a2 = wave_sum(a2);
            if (lane == 0) { fb[(size_t)(l * 3 + 0) * 5632 + n] = a0; fb[(size_t)(l * 3 + 1) * 5632 + n] = a1; fb[(size_t)(l * 3 + 2) * 5632 + n] = a2; }
        }
    }
    const float* ssdy = (const float*)(p.ws + WS_SSDY);
    const float* xbc = (const float*)(p.ws + WS_XBC);
    const float* proj = (const float*)(p.ws + WS_PROJ);
    h16* cat = (h16*)(p.ws + WS_CAT);
    for (int row = gw; row < NTOK; row += NGW) {
        const int c0 = lane * 8, h = lane >> 3;
        const float dsk = p.in[I_SSDD][h];
        float y[8]; float ss = 0.f;
#pragma unroll
        for (int e = 0; e < 2; ++e) {
            const f32x4 yf = *(const f32x4*)(ssdy + (size_t)row * 512 + c0 + 4 * e), yb = *(const f32x4*)(ssdy + (size_t)(NTOK + row) * 512 + c0 + 4 * e);
            const f32x4 xs = *(const f32x4*)(xbc + (size_t)row * 768 + c0 + 4 * e), z = *(const f32x4*)(proj + (size_t)row * PROJ_LD + 768 + c0 + 4 * e);
#pragma unroll
            for (int q = 0; q < 4; ++q) { const float v = (yf[q] + yb[q] + dsk * xs[q]) * silu_f(z[q]); y[4 * e + q] = v; ss += v * v; }
        }
        const float rstd = rsqrtf(wave_sum(ss) * (1.f / 512.f) + 1e-6f);
        h16x8 o;
#pragma unroll
        for (int e = 0; e < 8; ++e) o[e] = (h16)(y[e] * rstd * p.in[I_SSDG][c0 + e]);
        *(h16x8*)(cat + (size_t)row * D + 512 + c0) = o;
    }
}

__device__ __forceinline__ void phase_rwkvmix(const Params& p, const Ctx& c) {
    const int gw = c.bid * NWAVES + c.wave, NGW = c.G * NWAVES, lane = c.lane;
    const float* X = (const float*)(p.ws + WS_X);
    const float* ada = (const float*)(p.ws + WS_ADA);
    const float* g = p.in[I_NMG] + 1024;
    h16* xm = (h16*)(p.ws + WS_XMIX);
    for (int row = gw; row < NTOK; row += NGW) {
        const bool lat = row >= NCTX;
        const int r2 = lat ? row - NCTX : row;
        const int t = lat ? (r2 & 1023) : (r2 & 255), T = lat ? 1024 : 256;
        const float* a = ada + (size_t)(3 + stream_of(row)) * 6144;
        f32x4 h0[4], hp[4], hn[4];
        load_row(X + (size_t)row * D, lane, h0);
        const float r0 = row_rstd(h0);
        const bool hasp = t > 0, hasn = t < T - 1;
        float rp = 0.f, rn = 0.f;
        if (hasp) { load_row(X + (size_t)(row - 1) * D, lane, hp); rp = row_rstd(hp); }
        if (hasn) { load_row(X + (size_t)(row + 1) * D, lane, hn); rn = row_rstd(hn); }
#pragma unroll
        for (int j = 0; j < 4; ++j) {
            const int col = 256 * j + 4 * lane;
            const f32x4 gg = *(const f32x4*)(g + col), sh = *(const f32x4*)(a + col), sc = *(const f32x4*)(a + 1024 + col);
            const f32x4 m = gg * (sc + 1.f);
            const f32x4 hh = h0[j] * r0 * m + sh;
            f32x4 dp = -hh, dn = -hh;
            if (hasp) dp = (hp[j] * rp * m + sh) - hh;
            if (hasn) dn = (hn[j] * rn * m + sh) - hh;
#pragma unroll
            for (int i = 0; i < 6; ++i) {
                const f32x4 m0 = *(const f32x4*)(p.in[I_MU] + i * 1024 + col), m1 = *(const f32x4*)(p.in[I_MU] + (6 + i) * 1024 + col);
                *(h16x4*)(xm + ((size_t)i * NTOK + row) * D + col) = cvt4(hh + dp * m0 + dn * m1);
            }
        }
    }
}

template <int N> __device__ __forceinline__ float dpp_row_shr1(float x) {
    return __builtin_bit_cast(float, __builtin_amdgcn_update_dpp(0x3f800000, __builtin_bit_cast(int, x), 0x110 + N, 0xf, 0xf, false));
}
__device__ __forceinline__ float dpp_bcast15(float x) {
    return __builtin_bit_cast(float, __builtin_amdgcn_update_dpp(0, __builtin_bit_cast(int, x), 0x150 + 15, 0xf, 0xf, false));
}
template <int J> struct TriSolve {
    static __device__ __forceinline__ void run(float (&Tm)[4], const float (&nL)[16]) {
#pragma unroll
        for (int cc = 0; cc < 4; ++cc) { float src_ = Tm[cc]; fmac_bc_safe<J>(Tm[cc], src_, nL[J]); }
        if constexpr (J < 14) TriSolve<J + 1>::run(Tm, nL);
    }
};
#define P13_ST(T_, ptr_, val_) do { T_ v__ = (val_); if (dry) asm volatile("" :: "v"(v__)); else *(T_*)(ptr_) = v__; } while (0)
__device__ __forceinline__ void phase_rwkvprep(const Params& p, const Ctx& c, bool dry) {
    const int gw = c.bid * NWAVES + c.wave, NGW = c.G * NWAVES, lane = c.lane;
    const int i = lane & 15, g = lane >> 4;
    LAS unsigned char* scr = c.lds + c.wave * 8192;
    const h16* r16 = (const h16*)(p.ws + WS_R16); const h16* k16 = (const h16*)(p.ws + WS_K16);
    float* bonus = (float*)(p.ws + WS_BONUS);
    const int h = gw & 15, npair = 2 * 384, pstep = NGW >> 4;
    f32x4 kkw4[4], ka4v[4], rk4v[4];
#pragma unroll
    for (int q = 0; q < 4; ++q) {
        kkw4[q] = *(const f32x4*)(p.in[I_KKW] + h * 64 + 16 * q + 4 * g); ka4v[q] = *(const f32x4*)(p.in[I_KA] + h * 64 + 16 * q + 4 * g); rk4v[q] = *(const f32x4*)(p.in[I_RK] + h * 64 + 16 * q + 4 * g);
    }
    h16x4 nk4[4], nr4[4], nd4[4], na4[4];
#define P13_LOAD(pi_) do { const int rbg_ = (pi_) % 384, dir_ = (pi_) / 384, row_ = rbg_ * 16 + (dir_ ? 15 - i : i); \
        const h16* dec_ = (const h16*)(p.ws + WS_DEC16) + (size_t)dir_ * NTOK * D; const h16* a16_ = (const h16*)(p.ws + WS_A16) + (size_t)dir_ * NTOK * D; \
        _Pragma("unroll") for (int q_ = 0; q_ < 4; ++q_) { const size_t o_ = (size_t)row_ * D + h * 64 + 16 * q_ + 4 * g; \
            nk4[q_] = *(const h16x4*)(k16 + o_); nr4[q_] = *(const h16x4*)(r16 + o_); nd4[q_] = *(const h16x4*)(dec_ + o_); na4[q_] = *(const h16x4*)(a16_ + o_); } } while (0)
    if ((gw >> 4) < npair) P13_LOAD(gw >> 4);
    for (int pi = gw >> 4; pi < npair; pi += pstep) {
        const int rbg = pi % 384, dir = pi / 384, item = (dir * 384 + rbg) * 16 + h;
        const int row0 = rbg * 16, row = row0 + (dir ? 15 - i : i);
        h16* dec = (h16*)(p.ws + WS_DEC16) + (size_t)dir * NTOK * D; h16* a16 = (h16*)(p.ws + WS_A16) + (size_t)dir * NTOK * D;
        float kv[16], rv[16], wv[16], av[16];
#pragma unroll
        for (int q = 0; q < 4; ++q) {
            asm volatile("" : "+v"(nk4[q]), "+v"(nr4[q]), "+v"(nd4[q]), "+v"(na4[q]));
#pragma unroll
            for (int jj = 0; jj < 4; ++jj) { kv[4 * q + jj] = (float)nk4[q][jj]; rv[4 * q + jj] = (float)nr4[q][jj]; wv[4 * q + jj] = 1.f - (float)nd4[q][jj]; av[4 * q + jj] = (float)na4[q][jj]; }
        }
        { const int pn_ = (pi + pstep < npair) ? pi + pstep : pi; P13_LOAD(pn_); }
        float kap[16], ss = 0.f;
#pragma unroll
        for (int q = 0; q < 4; ++q) {
            const f32x4 kkw = kkw4[q];
#pragma unroll
            for (int jj = 0; jj < 4; ++jj) { kap[4 * q + jj] = kv[4 * q + jj] * kkw[jj]; ss += kap[4 * q + jj] * kap[4 * q + jj]; }
        }
        ss = rowsum4(ss);
        const float rn = rsqrtf(ss + 1e-12f);
        float bon = 0.f;
        float beta[16], kt[16];
#pragma unroll
        for (int q = 0; q < 4; ++q) {
            const f32x4 ka4 = ka4v[q], rk4 = rk4v[q];
#pragma unroll
            for (int jj = 0; jj < 4; ++jj) {
                const int m = 4 * q + jj;
                kap[m] *= rn; beta[m] = kap[m] * av[m]; kt[m] = kv[m] * (1.f + (av[m] - 1.f) * ka4[jj]);
                bon += rv[m] * kt[m] * rk4[jj];
            }
        }
        bon = rowsum4(bon);
        if (g == 0) P13_ST(float, bonus + ((size_t)dir * NTOK + row) * 16 + h, bon);
        f32x4 A1 = {0.f, 0.f, 0.f, 0.f}, Lm = A1, N1 = A1, N2 = A1;
        h16 kapo[16], rho[16], kbo[16], bbo[16], kho[16], bho[16];
        float gcv[16];
#pragma unroll
        for (int m = 0; m < 16; ++m) {
            float G = wv[m];
            G *= dpp_row_shr1<1>(G); G *= dpp_row_shr1<2>(G); G *= dpp_row_shr1<4>(G); G *= dpp_row_shr1<8>(G);
            const float Gex = dpp_row_shr1<1>(G), GC = dpp_bcast15(G), rG = __builtin_amdgcn_rcpf(G);
            const float kh = kap[m] * Gex, rh = rv[m] * G, k_h = kt[m] * rG, b_h = beta[m] * rG;
            kapo[m] = (h16)kh; rho[m] = (h16)rh; kbo[m] = (h16)(k_h * GC); bbo[m] = (h16)(b_h * GC); gcv[m] = GC;
            kho[m] = (h16)fminf(fmaxf(k_h, -60000.f), 60000.f); bho[m] = (h16)fminf(fmaxf(b_h, -60000.f), 60000.f);
        }
#pragma unroll
        for (int s = 0; s < 2; ++s) {
            h16x8 ka8, rh8, kh8, bh8;
#pragma unroll
            for (int e = 0; e < 8; ++e) { ka8[e] = kapo[8 * s + e]; rh8[e] = rho[8 * s + e]; kh8[e] = kho[8 * s + e]; bh8[e] = bho[8 * s + e]; }
            A1 = __builtin_amdgcn_mfma_f32_16x16x32_f16(kh8, ka8, A1, 0, 0, 0);
            Lm = __builtin_amdgcn_mfma_f32_16x16x32_f16(bh8, ka8, Lm, 0, 0, 0);
            N1 = __builtin_amdgcn_mfma_f32_16x16x32_f16(kh8, rh8, N1, 0, 0, 0);
            N2 = __builtin_amdgcn_mfma_f32_16x16x32_f16(bh8, rh8, N2, 0, 0, 0);
        }
#pragma unroll
        for (int r = 0; r < 4; ++r) { const int j = 4 * g + r; if (!(j < i)) { A1[r] = 0.f; Lm[r] = 0.f; } if (!(j <= i)) { N1[r] = 0.f; N2[r] = 0.f; } }
        LAS float* Lb = (LAS float*)(scr + 4096);
        *(LAS f32x4*)(Lb + i * 16 + 4 * g) = Lm;
        LAS h16* kbT = (LAS h16*)scr;
#pragma unroll
        for (int m = 0; m < 16; ++m) {
            const int f = m >> 2, kc = 4 * g + (m & 3);
            const int u = ((f * 16 + kc) * 4 + (i >> 2)) * 8 + (i & 3);
            kbT[u] = kbo[m]; kbT[u + 4] = bbo[m];
        }
        asm volatile("s_waitcnt lgkmcnt(0)" ::: "memory");
        float nL[16];
#pragma unroll
        for (int q = 0; q < 4; ++q) { const f32x4 v = *(const LAS f32x4*)(Lb + i * 16 + 4 * q); nL[4 * q] = -v[0]; nL[4 * q + 1] = -v[1]; nL[4 * q + 2] = -v[2]; nL[4 * q + 3] = -v[3]; }
        float Tm[4];
#pragma unroll
        for (int cc = 0; cc < 4; ++cc) Tm[cc] = (i == 4 * g + cc) ? 1.f : 0.f;
        asm volatile("s_nop 1" : "+v"(Tm[0]), "+v"(Tm[1]), "+v"(Tm[2]), "+v"(Tm[3]));
        TriSolve<0>::run(Tm, nL);
        unsigned char* item_o = p.ws + WS_OPS2 + (size_t)item * OPS2_ITEM;
        {
            h16x8 o;
#pragma unroll
            for (int s = 0; s < 2; ++s) {
#pragma unroll
                for (int e = 0; e < 8; ++e) o[e] = kapo[8 * s + e];
                P13_ST(h16x8, dec + (size_t)(row0 + i) * D + h * 64 + (g * 2 + s) * 8, o);
#pragma unroll
                for (int e = 0; e < 8; ++e) o[e] = rho[8 * s + e];
                P13_ST(h16x8, a16 + (size_t)(row0 + i) * D + h * 64 + (g * 2 + s) * 8, o);
            }
        }
#pragma unroll
        for (int q = 0; q < 4; ++q) P13_ST(u32x4, item_o + (q * 64 + lane) * 16, *(const LAS u32x4*)(scr + (q * 64 + lane) * 16));
        P13_ST(h16x4, item_o + 4096 + (i * 4 + g) * 8, cvt4(A1));
        { f32x4 t4 = {Tm[0], Tm[1], Tm[2], Tm[3]}; P13_ST(h16x4, item_o + 4608 + (i * 4 + g) * 8, cvt4(t4)); }
        { h16x8 o; for (int r = 0; r < 4; ++r) { o[r] = (h16)N1[r]; o[4 + r] = (h16)N2[r]; } P13_ST(h16x8, item_o + 5120 + (i * 4 + g) * 16, o); }
        if (i == 0) {
#pragma unroll
            for (int q = 0; q < 4; ++q) P13_ST(f32x4, item_o + 6144 + (16 * q + 4 * g) * 4, ((f32x4){gcv[4 * q], gcv[4 * q + 1], gcv[4 * q + 2], gcv[4 * q + 3]}));
        }
        asm volatile("s_waitcnt lgkmcnt(0)" ::: "memory");
    }
}

__device__ __forceinline__ void phase_rwkvpost(const Params& p, const Ctx& c) {
    const int gw = c.bid * NWAVES + c.wave, NGW = c.G * NWAVES, lane = c.lane;
    const h16* y16 = (const h16*)(p.ws + WS_Y16); const h16* v16 = (const h16*)(p.ws + WS_V16); const h16* g16 = (const h16*)(p.ws + WS_G16);
    const float* bonus = (const float*)(p.ws + WS_BONUS);
    h16* hA = (h16*)(p.ws + WS_HA);
    for (int row = gw; row < NTOK; row += NGW) {
        const int c0 = lane * 16;
        float y[16]; float s = 0.f;
#pragma unroll
        for (int e = 0; e < 2; ++e) {
            const h16x8 a = *(const h16x8*)(y16 + (size_t)row * D + c0 + 8 * e), b = *(const h16x8*)(y16 + ((size_t)NTOK + row) * D + c0 + 8 * e);
#pragma unroll
            for (int q = 0; q < 8; ++q) { y[8 * e + q] = (float)a[q] + (float)b[q]; s += y[8 * e + q]; }
        }
        s += __shfl_xor(s, 1); s += __shfl_xor(s, 2);
        const float mean = s * (1.f / 64.f);
        float vs = 0.f;
#pragma unroll
        for (int e = 0; e < 16; ++e) { y[e] -= mean; vs += y[e] * y[e]; }
        vs += __shfl_xor(vs, 1); vs += __shfl_xor(vs, 2);
        const float rstd = rsqrtf(vs * (1.f / 64.f) + 64e-5f);
        const float bon = bonus[row * 16 + (lane >> 2)] + bonus[((size_t)NTOK + row) * 16 + (lane >> 2)];
#pragma unroll
        for (int e = 0; e < 2; ++e) {
            const h16x8 vv = *(const h16x8*)(v16 + (size_t)row * D + c0 + 8 * e), gv = *(const h16x8*)(g16 + (size_t)row * D + c0 + 8 * e);
            h16x8 o;
#pragma unroll
            for (int q = 0; q < 8; ++q) {
                const int cc = c0 + 8 * e + q;
                const float yn = y[8 * e + q] * rstd * p.in[I_LNG][cc] + p.in[I_LNB][cc];
                o[q] = (h16)((yn + bon * (float)vv[q]) * (float)gv[q]);
            }
            *(h16x8*)(hA + (size_t)row * D + c0 + 8 * e) = o;
        }
    }
}

__device__ __forceinline__ void phase_final(const Params& p, const Ctx& c) {
    const int gw = c.bid * NWAVES + c.wave, NGW = c.G * NWAVES;
    const float* X = (const float*)(p.ws + WS_X);
    for (int row = gw; row < NTOK; row += NGW) {
        f32x4 v[4]; load_row(X + (size_t)row * D, c.lane, v);
        const float rstd = row_rstd(v);
#pragma unroll
        for (int j = 0; j < 4; ++j) {
            const int col = 256 * j + 4 * c.lane;
            *(f32x4*)(p.out + O_Y + (size_t)row * D + col) = v[j] * rstd * *(const f32x4*)(p.in[I_FNG] + col);
        }
    }
}

__device__ __forceinline__ void attn_unit(const Params& p, const Ctx& c, bool lat, int b, int kvh, int qb) {
    const int lane = c.lane, wave = c.wave, tid = c.tid;
    const int nkeys = lat ? 1280 : 256;
    const h16* Kg = lat ? (const h16*)(p.ws + WS_K16L) + (size_t)(b * 2 + kvh) * 1280 * 64 : (const h16*)(p.ws + WS_K16C) + (size_t)(b * 2 + kvh) * 256 * 64;
    const h16* Vg = lat ? (const h16*)(p.ws + WS_VT16L) + (size_t)(b * 2 + kvh) * 64 * 1280 : (const h16*)(p.ws + WS_VT16C) + (size_t)(b * 2 + kvh) * 64 * 256;
    const int row0 = (lat ? NCTX + b * 1024 : b * 256) + qb * 32 + (wave & 1) * 16;
    const int head = kvh * 4 + (wave >> 1);
    const int fr = lane & 15, fq = lane >> 4;
    const h16* q16 = (const h16*)(p.ws + WS_Q16);
    h16x8 qf[2];
#pragma unroll
    for (int s = 0; s < 2; ++s) qf[s] = *(const h16x8*)(q16 + (size_t)(row0 + fr) * 512 + head * 64 + s * 32 + fq * 8);
    LAS unsigned char* ldsK = c.lds; LAS unsigned char* ldsV = c.lds + 8192;
    float m = -1e30f, l = 0.f;
    f32x4 O[4];
#pragma unroll
    for (int f = 0; f < 4; ++f) O[f] = (f32x4){0.f, 0.f, 0.f, 0.f};
    const int srow = tid >> 3, sch = tid & 7;
    const int sdst = srow * 128 + ((sch ^ (srow & 7)) << 4);
    const int ntile = nkeys / 64;
    u32x4 kv = *(const u32x4*)(Kg + (size_t)srow * 64 + sch * 8);
    u32x4 vv = *(const u32x4*)(Vg + (size_t)srow * nkeys + sch * 8);
    for (int kt = 0; kt < ntile; ++kt) {
        __syncthreads();
        *(LAS u32x4*)(ldsK + sdst) = kv;
        *(LAS u32x4*)(ldsV + sdst) = vv;
        __syncthreads();
        if (kt + 1 < ntile) {
            kv = *(const u32x4*)(Kg + (size_t)((kt + 1) * 64 + srow) * 64 + sch * 8);
            vv = *(const u32x4*)(Vg + (size_t)srow * nkeys + (kt + 1) * 64 + sch * 8);
        }
        f32x4 sacc[4];
#pragma unroll
        for (int f = 0; f < 4; ++f) {
            sacc[f] = (f32x4){0.f, 0.f, 0.f, 0.f};
#pragma unroll
            for (int s = 0; s < 2; ++s) {
                const h16x8 kf = *(const LAS h16x8*)(ldsK + (f * 16 + fr) * 128 + (((s * 4 + fq) ^ (fr & 7)) << 4));
                sacc[f] = __builtin_amdgcn_mfma_f32_16x16x32_f16(kf, qf[s], sacc[f], 0, 0, 0);
            }
        }
        float mx = -1e30f;
#pragma unroll
        for (int f = 0; f < 4; ++f)
#pragma unroll
            for (int r = 0; r < 4; ++r) mx = fmaxf(mx, sacc[f][r]);
        mx = fmaxf(mx, __shfl_xor(mx, 16)); mx = fmaxf(mx, __shfl_xor(mx, 32));
        const float mn = fmaxf(m, mx);
        const float alpha = __expf(m - mn);
        m = mn;
        float ps = 0.f;
#pragma unroll
        for (int f = 0; f < 4; ++f)
#pragma unroll
            for (int r = 0; r < 4; ++r) { const float e = __expf(sacc[f][r] - mn); sacc[f][r] = e; ps += e; }
        l = l * alpha + ps;
#pragma unroll
        for (int f = 0; f < 4; ++f) O[f] *= alpha;
#pragma unroll
        for (int s2 = 0; s2 < 2; ++s2) {
            h16x8 pf;
#pragma unroll
            for (int r = 0; r < 4; ++r) { pf[r] = (h16)sacc[2 * s2][r]; pf[4 + r] = (h16)sacc[2 * s2 + 1][r]; }
#pragma unroll
            for (int fd = 0; fd < 4; ++fd) {
                const int d = fd * 16 + fr;
                const h16x4 lo = *(const LAS h16x4*)(ldsV + d * 128 + (((4 * s2 + (fq >> 1)) ^ (d & 7)) << 4) + (fq & 1) * 8);
                const h16x4 hi = *(const LAS h16x4*)(ldsV + d * 128 + (((4 * s2 + 2 + (fq >> 1)) ^ (d & 7)) << 4) + (fq & 1) * 8);
                h16x8 vf; vf[0] = lo[0]; vf[1] = lo[1]; vf[2] = lo[2]; vf[3] = lo[3]; vf[4] = hi[0]; vf[5] = hi[1]; vf[6] = hi[2]; vf[7] = hi[3];
                O[fd] = __builtin_amdgcn_mfma_f32_16x16x32_f16(vf, pf, O[fd], 0, 0, 0);
            }
        }
    }
    l += __shfl_xor(l, 16); l += __shfl_xor(l, 32);
    const float inv = 1.f / l;
    h16* cat = (h16*)(p.ws + WS_CAT);
#pragma unroll
    for (int fd = 0; fd < 4; ++fd)
        *(h16x4*)(cat + (size_t)(row0 + fr) * D + head * 64 + fd * 16 + 4 * fq) = cvt4(O[fd] * inv);
    __syncthreads();
}

__device__ __forceinline__ void ssd_unit(const Params& p, const Ctx& c, bool lat, int b, int h, int dir) {
    const int lane = c.lane, wave = c.wave, tid = c.tid;
    const int fr = lane & 15, fq = lane >> 4;
    const int T = lat ? 1024 : 256, rowbase = lat ? NCTX + b * 1024 : b * 256, grp = h >> 2;
    const float* xbc = (const float*)(p.ws + WS_XBC);
    const float* dtv = (const float*)(p.ws + WS_DT);
    float* ssdy = (float*)(p.ws + WS_SSDY) + (size_t)dir * NTOK * 512;
    const float Aneg = -__expf(p.in[I_ALOG][dir * 8 + h]);
    LAS unsigned char* Bn = c.lds; LAS unsigned char* Cn = c.lds + 16384; LAS unsigned char* xdtT = c.lds + 32768; LAS unsigned char* BdT = c.lds + 49152;
    LAS unsigned char* himg = c.lds + 65536; LAS float* acs = (LAS float*)(c.lds + 73728); LAS float* dtl = (LAS float*)(c.lds + 74240);
    const int fn = wave & 3, fp0 = 2 * (wave >> 2);
    f32x4 hst[2];
    const size_t sbase = (size_t)(b * 8 + h) * 4096;
#pragma unroll
    for (int e = 0; e < 2; ++e) {
        const int pp = 16 * (fp0 + e) + fr, n0 = 16 * fn + 4 * fq;
        hst[e] = lat ? *(const f32x4*)((dir ? p.in[I_SSDB] : p.in[I_SSDF]) + sbase + pp * 64 + n0) : (f32x4){0.f, 0.f, 0.f, 0.f};
    }
    __syncthreads();
#pragma unroll
    for (int e = 0; e < 2; ++e) {
        const int pp = 16 * (fp0 + e) + fr;
        *(LAS h16x4*)(himg + pp * 128 + (((2 * fn + (fq >> 1)) ^ (pp & 7)) << 4) + (fq & 1) * 8) = cvt4(hst[e]);
    }
    const int nchunk = T / 128;
    f32x4 pB[4], pC[4], pX[4]; float pd0 = 0.f, pd1 = 0.f;
    const int prow = tid >> 2, pq4 = tid & 3, pch = tid & 63, plb = tid >> 6;
    LAS unsigned char* Xn = c.lds + 75776;
#define SSD_PREFETCH(ck_) do { const int r0_ = dir ? rowbase + T - 1 - (ck_) * 128 : rowbase + (ck_) * 128, sg_ = dir ? -1 : 1; \
        const float* g_ = xbc + (size_t)(r0_ + sg_ * prow) * 768 + 16 * pq4; \
        _Pragma("unroll") for (int e_ = 0; e_ < 4; ++e_) { pB[e_] = *(const f32x4*)(g_ + 512 + grp * 64 + 4 * e_); pC[e_] = *(const f32x4*)(g_ + 640 + grp * 64 + 4 * e_); pX[e_] = *(const f32x4*)(g_ + h * 64 + 4 * e_); } \
        if (wave == 0) { pd0 = dtv[(r0_ + sg_ * (2 * lane)) * 16 + dir * 8 + h]; pd1 = dtv[(r0_ + sg_ * (2 * lane + 1)) * 16 + dir * 8 + h]; } } while (0)
    SSD_PREFETCH(0);
    for (int ck = 0; ck < nchunk; ++ck) {
        const int r0 = dir ? rowbase + T - 1 - ck * 128 : rowbase + ck * 128, sg = dir ? -1 : 1;
        if (wave == 0) {
            const float d0 = pd0, d1 = pd1;
            const float a0 = d0 * Aneg, a1 = d1 * Aneg;
            float s = a0 + a1;
#pragma unroll
            for (int o = 1; o < 64; o <<= 1) { const float t = __shfl_up(s, o); if (lane >= o) s += t; }
            const float ex = s - (a0 + a1);
            acs[2 * lane] = ex + a0; acs[2 * lane + 1] = ex + a0 + a1; dtl[2 * lane] = d0; dtl[2 * lane + 1] = d1;
        }
        {
            const int o0_ = prow * 128 + (((2 * pq4) ^ (prow & 7)) << 4), o1_ = prow * 128 + (((2 * pq4 + 1) ^ (prow & 7)) << 4);
            h16x8 o0, o1;
#pragma unroll
            for (int e = 0; e < 4; ++e) { o0[e] = (h16)pB[0][e]; o0[4 + e] = (h16)pB[1][e]; o1[e] = (h16)pB[2][e]; o1[4 + e] = (h16)pB[3][e]; }
            *(LAS h16x8*)(Bn + o0_) = o0; *(LAS h16x8*)(Bn + o1_) = o1;
#pragma unroll
            for (int e = 0; e < 4; ++e) { o0[e] = (h16)pC[0][e]; o0[4 + e] = (h16)pC[1][e]; o1[e] = (h16)pC[2][e]; o1[4 + e] = (h16)pC[3][e]; }
            *(LAS h16x8*)(Cn + o0_) = o0; *(LAS h16x8*)(Cn + o1_) = o1;
#pragma unroll
            for (int e = 0; e < 4; ++e) { o0[e] = (h16)pX[0][e]; o0[4 + e] = (h16)pX[1][e]; o1[e] = (h16)pX[2][e]; o1[4 + e] = (h16)pX[3][e]; }
            *(LAS h16x8*)(Xn + o0_) = o0; *(LAS h16x8*)(Xn + o1_) = o1;
        }
        __syncthreads();
        {
            const float aend = acs[127];
#pragma unroll 1
            for (int j = 0; j < 2; ++j) {
                const int l0 = 8 * plb + 64 * j;
                h16x8 ox, ob;
#pragma unroll
                for (int e = 0; e < 8; ++e) {
                    const int l = l0 + e, ad = l * 128 + (((pch >> 3) ^ (l & 7)) << 4) + (pch & 7) * 2;
                    ox[e] = (h16)((float)*(const LAS h16*)(Xn + ad) * dtl[l]);
                    ob[e] = (h16)((float)*(const LAS h16*)(Bn + ad) * __expf(aend - acs[l]));
                }
                const int off = pch * 256 + (((l0 >> 3) ^ (pch & 15)) << 4);
                *(LAS h16x8*)(xdtT + off) = ox; *(LAS h16x8*)(BdT + off) = ob;
            }
        }
        if (ck + 1 < nchunk) SSD_PREFETCH(ck + 1);
        __syncthreads();
        const int l = 16 * wave + fr;
        const float al = acs[l];
        f32x4 accy[4];
#pragma unroll
        for (int fd = 0; fd < 4; ++fd) accy[fd] = (f32x4){0.f, 0.f, 0.f, 0.f};
        h16x8 cf[2];
#pragma unroll
        for (int s2 = 0; s2 < 2; ++s2) cf[s2] = *(const LAS h16x8*)(Cn + l * 128 + (((4 * s2 + fq) ^ (l & 7)) << 4));
#pragma unroll
        for (int fd = 0; fd < 4; ++fd) {
            const int pp = 16 * fd + fr;
#pragma unroll
            for (int s2 = 0; s2 < 2; ++s2) {
                const h16x8 hf = *(const LAS h16x8*)(himg + pp * 128 + (((4 * s2 + fq) ^ (pp & 7)) << 4));
                accy[fd] = __builtin_amdgcn_mfma_f32_16x16x32_f16(hf, cf[s2], accy[fd], 0, 0, 0);
            }
        }
        {
            const float el = __expf(al);
#pragma unroll
            for (int fd = 0; fd < 4; ++fd) accy[fd] *= el;
        }
        for (int q = 0; 2 * q <= wave; ++q) {
            h16x8 pf;
#pragma unroll
            for (int e = 0; e < 2; ++e) {
                const int f = 2 * q + e;
                f32x4 sa = {0.f, 0.f, 0.f, 0.f};
                if (f <= wave) {
                    const int s = 16 * f + fr;
#pragma unroll
                    for (int s2 = 0; s2 < 2; ++s2) {
                        const h16x8 bf = *(const LAS h16x8*)(Bn + s * 128 + (((4 * s2 + fq) ^ (s & 7)) << 4));
                        sa = __builtin_amdgcn_mfma_f32_16x16x32_f16(bf, cf[s2], sa, 0, 0, 0);
                    }
                    const f32x4 as = *(const LAS f32x4*)(acs + 16 * f + 4 * fq);
#pragma unroll
                    for (int r = 0; r < 4; ++r) { const int ss = 16 * f + 4 * fq + r; sa[r] = (ss <= l) ? sa[r] * __expf(al - as[r]) : 0.f; }
                }
#pragma unroll
                for (int r = 0; r < 4; ++r) pf[4 * e + r] = (h16)sa[r];
            }
#pragma unroll
            for (int fd = 0; fd < 4; ++fd) {
                const int pp = 16 * fd + fr;
                const h16x4 lo = *(const LAS h16x4*)(xdtT + pp * 256 + (((4 * q + (fq >> 1)) ^ (pp & 15)) << 4) + (fq & 1) * 8);
                const h16x4 hi = *(const LAS h16x4*)(xdtT + pp * 256 + (((4 * q + 2 + (fq >> 1)) ^ (pp & 15)) << 4) + (fq & 1) * 8);
                h16x8 xf; xf[0] = lo[0]; xf[1] = lo[1]; xf[2] = lo[2]; xf[3] = lo[3]; xf[4] = hi[0]; xf[5] = hi[1]; xf[6] = hi[2]; xf[7] = hi[3];
                accy[fd] = __builtin_amdgcn_mfma_f32_16x16x32_f16(xf, pf, accy[fd], 0, 0, 0);
            }
        }
        {
            float* yo = ssdy + (size_t)(r0 + sg * l) * 512 + h * 64 + 4 * fq;
#pragma unroll
            for (int fd = 0; fd < 4; ++fd) *(f32x4*)(yo + 16 * fd) = accy[fd];
        }
        {
            const float cd = __expf(acs[127]);
            const int nn = 16 * fn + fr;
#pragma unroll
            for (int e = 0; e < 2; ++e) {
                const int pp = 16 * (fp0 + e) + fr;
                f32x4 st = {0.f, 0.f, 0.f, 0.f};
#pragma unroll
                for (int ks = 0; ks < 4; ++ks) {
                    const h16x8 bf = *(const LAS h16x8*)(BdT + nn * 256 + (((4 * ks + fq) ^ (nn & 15)) << 4));
                    const h16x8 xf = *(const LAS h16x8*)(xdtT + pp * 256 + (((4 * ks + fq) ^ (pp & 15)) << 4));
                    st = __builtin_amdgcn_mfma_f32_16x16x32_f16(bf, xf, st, 0, 0, 0);
                }
                hst[e] = hst[e] * cd + st;
            }
        }
        __syncthreads();
#pragma unroll
        for (int e = 0; e < 2; ++e) {
            const int pp = 16 * (fp0 + e) + fr;
            *(LAS h16x4*)(himg + pp * 128 + (((2 * fn + (fq >> 1)) ^ (pp & 7)) << 4) + (fq & 1) * 8) = cvt4(hst[e]);
        }
    }
#undef SSD_PREFETCH
    if (!lat) {
#pragma unroll
        for (int e = 0; e < 2; ++e) {
            const int pp = 16 * (fp0 + e) + fr, n0 = 16 * fn + 4 * fq;
            *(f32x4*)(p.out + (dir ? O_SSDB : O_SSDF) + sbase + pp * 64 + n0) = hst[e];
        }
    }
    __syncthreads();
}
__device__ __forceinline__ int next_unit(const Params& p, const Ctx& c, int q) {
    volatile LAS int* slot = (volatile LAS int*)(c.lds + LDS_MISC + 64);
    __syncthreads();
    if (c.tid == 0) *slot = (int)atomicAdd((unsigned*)(p.ws + WS_CTL) + 4096 + 64 * q, 1u);
    __syncthreads();
    return *slot;
}
__device__ __forceinline__ void phase_mix0(const Params& p, const Ctx& c, int q) {
    for (int u = next_unit(p, c, q); u < 672 + N_CONV_UNITS; u = next_unit(p, c, q)) {
        if (u >= 672) { if (q == 0) conv_unit(p, c, u - 672); continue; }
        if (u < 32) ssd_unit(p, c, true, u >> 4, (u >> 1) & 7, u & 1);
        else if (u < 160) { const int v = u - 32; attn_unit(p, c, true, v >> 6, (v >> 5) & 1, v & 31); }
        else if (u < 416) { const int v = u - 160; ssd_unit(p, c, false, v >> 4, (v >> 1) & 7, v & 1); }
        else { const int v = u - 416; attn_unit(p, c, false, v >> 4, (v >> 3) & 1, v & 7); }
    }
}

constexpr int RW_SLOT = 12544, RW_NS = 5, RW_PF = 4;
template <int ABL>
__device__ __forceinline__ void rwkv_unit(const Params& p, const Ctx& c, bool lat, int b, int h, int dirsel) {
    const int lane = c.lane, wave = c.wave;
    const int dir = dirsel >= 0 ? dirsel : (wave >> 2), q = wave & 3, fr = lane & 15, g = lane >> 4;
    const int T = lat ? 1024 : 256, rowbase = lat ? NCTX + b * 1024 : b * 256, nchunk = T / 16;
    if (dirsel >= 0 && wave >= 4) {
        __syncthreads();
        for (int ck = 0; ck < nchunk; ++ck) { if (ABL != 2) __builtin_amdgcn_s_barrier(); }
        __syncthreads();
        return;
    }
    const unsigned char* kapg = p.ws + WS_DEC16 + (size_t)dir * NTOK * D * 2; const unsigned char* rhg = p.ws + WS_A16 + (size_t)dir * NTOK * D * 2;
    const unsigned char* vg = p.ws + WS_V16;
    h16* y16 = (h16*)(p.ws + WS_Y16) + (size_t)dir * NTOK * D;
    LAS unsigned char* ring = c.lds + dir * (RW_NS * RW_SLOT);
    f32x4 St[4];
    const size_t soff = ((size_t)(b * 16 + h) * 64 + 16 * q + fr) * 64 + 4 * g;
#pragma unroll
    for (int f = 0; f < 4; ++f) St[f] = lat ? *(const f32x4*)((dir ? p.in[I_RWB] : p.in[I_RWF]) + soff + 16 * f) : (f32x4){0.f, 0.f, 0.f, 0.f};
    const int e0 = q * 64 + lane;
    auto issue = [&](int ck) {
        const int rbg = (rowbase >> 4) + (dir ? nchunk - 1 - ck : ck), row0 = rbg * 16;
        LAS unsigned char* slot = ring + (ck % RW_NS) * RW_SLOT;
        const unsigned char* item = p.ws + WS_OPS2 + (size_t)((dir * 384 + rbg) * 16 + h) * OPS2_ITEM;
        {
            const int e = e0 & 127, t = e >> 3, pc = e & 7;
            const unsigned char* s_ = (e0 < 128 ? kapg : rhg) + ((size_t)(row0 + t) * D + h * 64) * 2 + pc * 16;
            __builtin_amdgcn_global_load_lds((const unsigned*)s_, (LAS unsigned*)(slot + q * 1024), 16, 0, 0);
        }
        __builtin_amdgcn_global_load_lds((const unsigned*)(item + e0 * 16), (LAS unsigned*)(slot + 4096 + q * 1024), 16, 0, 0);
        {
            const int e = e0;
            const unsigned char* s_;
            if (e < 144) s_ = item + 4096 + e * 16;
            else { const int ve = e - 144, t = ve >> 3, pc = ve & 7; s_ = vg + ((size_t)(row0 + (dir ? 15 - t : t)) * D + h * 64) * 2 + pc * 16; }
            __builtin_amdgcn_global_load_lds((const unsigned*)s_, (LAS unsigned*)(slot + 8192 + q * 1024), 16, 0, 0);
        }
        if (q == 0 && lane < 16) {
            const int ve = 112 + lane, t = ve >> 3, pc = ve & 7;
            const unsigned char* s_ = vg + ((size_t)(row0 + (dir ? 15 - t : t)) * D + h * 64) * 2 + pc * 16;
            __builtin_amdgcn_global_load_lds((const unsigned*)s_, (LAS unsigned*)(slot + 12288), 16, 0, 0);
        }
    };
    __syncthreads();
    if (ABL != 1 && ABL != 2) for (int ck = 0; ck < RW_PF && ck < nchunk; ++ck) issue(ck);
    for (int ck = 0; ck < nchunk; ++ck) {
        if (ck + RW_PF > nchunk) asm volatile("s_waitcnt vmcnt(0)" ::: "memory");
        else if (q == 0) asm volatile("s_waitcnt vmcnt(12)" ::: "memory");
        else asm volatile("s_waitcnt vmcnt(9)" ::: "memory");
        asm volatile("s_waitcnt lgkmcnt(0)" ::: "memory");
        if (ABL != 2) __builtin_amdgcn_s_barrier();
        asm volatile("" ::: "memory");
        if (ABL != 1 && ABL != 2) if (ck + RW_PF < nchunk) issue(ck + RW_PF);
        const LAS unsigned char* slot = ring + (ck % RW_NS) * RW_SLOT;
        const int rbg = (rowbase >> 4) + (dir ? nchunk - 1 - ck : ck), row0 = rbg * 16;
        h16x8 Sh[2];
#pragma unroll
        for (int s = 0; s < 2; ++s)
#pragma unroll
            for (int r = 0; r < 4; ++r) { Sh[s][r] = (h16)St[2 * s][r]; Sh[s][4 + r] = (h16)St[2 * s + 1][r]; }
        const h16x8 ka0 = *(const LAS h16x8*)(slot + (fr * 4 + g) * 32), ka1 = *(const LAS h16x8*)(slot + (fr * 4 + g) * 32 + 16);
        const h16x8 rh0 = *(const LAS h16x8*)(slot + 2048 + (fr * 4 + g) * 32), rh1 = *(const LAS h16x8*)(slot + 2048 + (fr * 4 + g) * 32 + 16);
        const h16x4 a1 = *(const LAS h16x4*)(slot + 8192 + (fr * 4 + g) * 8), t4 = *(const LAS h16x4*)(slot + 8704 + (fr * 4 + g) * 8);
        const h16x8 nn = *(const LAS h16x8*)(slot + 9216 + (fr * 4 + g) * 16);
        h16x8 vu, a1op, top;
#pragma unroll
        for (int jj = 0; jj < 4; ++jj) {
            vu[jj] = *(const LAS h16*)(slot + 10496 + (4 * g + jj) * 128 + (16 * q + fr) * 2);
            a1op[jj] = a1[jj]; a1op[4 + jj] = (h16)0.f; top[jj] = t4[jj]; top[4 + jj] = (h16)0.f; vu[4 + jj] = (h16)0.f;
        }
        f32x4 X = {0.f, 0.f, 0.f, 0.f};
        X = __builtin_amdgcn_mfma_f32_16x16x32_f16(ka0, Sh[0], X, 0, 0, 0);
        X = __builtin_amdgcn_mfma_f32_16x16x32_f16(ka1, Sh[1], X, 0, 0, 0);
        X = __builtin_amdgcn_mfma_f32_16x16x32_f16(a1op, vu, X, 0, 0, 0);
        h16x8 xo;
#pragma unroll
        for (int r = 0; r < 4; ++r) { xo[r] = (h16)X[r]; xo[4 + r] = (h16)0.f; }
        f32x4 U = {0.f, 0.f, 0.f, 0.f};
        U = __builtin_amdgcn_mfma_f32_16x16x32_f16(top, xo, U, 0, 0, 0);
#pragma unroll
        for (int r = 0; r < 4; ++r) vu[4 + r] = (h16)(-U[r]);
        f32x4 Y = {0.f, 0.f, 0.f, 0.f};
        Y = __builtin_amdgcn_mfma_f32_16x16x32_f16(rh0, Sh[0], Y, 0, 0, 0);
        Y = __builtin_amdgcn_mfma_f32_16x16x32_f16(rh1, Sh[1], Y, 0, 0, 0);
        Y = __builtin_amdgcn_mfma_f32_16x16x32_f16(nn, vu, Y, 0, 0, 0);
#pragma unroll
        for (int f = 0; f < 4; ++f) {
            const f32x4 gc = *(const LAS f32x4*)(slot + 10240 + (16 * f + 4 * g) * 4);
            const h16x8 kb = *(const LAS h16x8*)(slot + 4096 + ((f * 16 + fr) * 4 + g) * 16);
            St[f] = __builtin_amdgcn_mfma_f32_16x16x32_f16(kb, vu, St[f] * gc, 0, 0, 0);
        }
#pragma unroll
        for (int r = 0; r < 4; ++r) if (ABL == 3) asm volatile("" :: "v"(Y[r])); else { const int t = 4 * g + r; y16[(size_t)(row0 + (dir ? 15 - t : t)) * D + h * 64 + 16 * q + fr] = (h16)Y[r]; }
    }
    if (!lat) {
#pragma unroll
        for (int f = 0; f < 4; ++f) *(f32x4*)(p.out + (dir ? O_RWB : O_RWF) + soff + 16 * f) = St[f];
    }
    asm volatile("s_waitcnt vmcnt(0) lgkmcnt(0)" ::: "memory");
    __syncthreads();
}
template <int ABL>
__device__ __forceinline__ void phase_rwkvscan(const Params& p, const Ctx& c, int qn) {
    for (int u = next_unit(p, c, qn); u < 320; u = next_unit(p, c, qn)) {
        if (u < 64) rwkv_unit<ABL>(p, c, true, u >> 5, (u >> 1) & 15, u & 1);
        else { const int v = u - 64; rwkv_unit<ABL>(p, c, false, v >> 4, v & 15, -1); }
    }
}

__device__ __forceinline__ const float* ada_chunk(const Params& p, int layer, int row, int chunk) {
    return (const float*)(p.ws + WS_ADA) + (size_t)(layer * 3 + stream_of(row)) * 6144 + chunk * 1024;
}
__device__ __forceinline__ void phase_gemm_inproj(const Params& p, const Ctx& c) {
    float* proj = (float*)(p.ws + WS_PROJ);
    const float* rc = (const float*)(p.ws + WS_ROPE); const float* rs = rc + 32768;
    const int fr = c.lane & 15, fq = c.lane >> 4, wm = c.wave >> 1, wn = c.wave & 1;
    for (int u = c.bid; u < 24 * 17; u += c.G) {
        const int pm = u % 24, pn = u / 24;
        GemmTile g{(const h16*)(p.ws + WS_HA), D, (const h16*)(p.ws + WS_WIN), D, D, pm * 256, pn * 128};
        f32x4 acc[4][4]; gemm_tile<256>(c, g, acc);
        if (pn >= 6) {
#pragma unroll
            for (int i = 0; i < 4; ++i)
#pragma unroll
                for (int j = 0; j < 4; ++j)
                    *(f32x4*)(proj + (size_t)(g.m0 + wm * 64 + 16 * i + fr) * PROJ_LD + g.n0 + wn * 64 + 16 * j + 4 * fq) = acc[i][j];
            continue;
        }
#pragma unroll
        for (int i = 0; i < 4; ++i) {
            const int row = g.m0 + wm * 64 + 16 * i + fr;
            const bool lat = row >= NCTX;
            const int r2 = lat ? row - NCTX : row;
            const int b = lat ? (r2 >> 10) : (r2 >> 8), t = lat ? (r2 & 1023) : (r2 & 255);
            if (pn < 5) {
                float ss = 0.f;
#pragma unroll
                for (int j = 0; j < 4; ++j) ss += acc[i][j][0] * acc[i][j][0] + acc[i][j][1] * acc[i][j][1] + acc[i][j][2] * acc[i][j][2] + acc[i][j][3] * acc[i][j][3];
                ss = rowsum4(ss);
                const float rstd = rsqrtf(ss * (1.f / 64.f) + 1e-6f);
                const float* gw_ = (pn < 4) ? p.in[I_QG] : p.in[I_KG];
                f32x4 xn[4];
#pragma unroll
                for (int j = 0; j < 4; ++j) xn[j] = acc[i][j] * rstd * *(const f32x4*)(gw_ + 16 * j + 4 * fq);
                if (lat) {
#pragma unroll
                    for (int j = 0; j < 2; ++j) {
                        const f32x4 cs = *(const f32x4*)(rc + t * 32 + 16 * j + 4 * fq), sn = *(const f32x4*)(rs + t * 32 + 16 * j + 4 * fq);
                        const f32x4 x1 = xn[j], x2 = xn[j + 2];
                        xn[j] = x1 * cs - x2 * sn; xn[j + 2] = x1 * sn + x2 * cs;
                    }
                }
                if (pn < 4) {
                    h16* q16 = (h16*)(p.ws + WS_Q16) + (size_t)row * 512 + (2 * pn + wn) * 64 + 4 * fq;
#pragma unroll
                    for (int j = 0; j < 4; ++j) *(h16x4*)(q16 + 16 * j) = cvt4(xn[j] * 0.125f);
                } else {
                    h16* kd = lat ? (h16*)(p.ws + WS_K16L) + ((size_t)(b * 2 + wn) * 1280 + 256 + t) * 64 + 4 * fq
                                  : (h16*)(p.ws + WS_K16C) + ((size_t)(b * 2 + wn) * 256 + t) * 64 + 4 * fq;
#pragma unroll
                    for (int j = 0; j < 4; ++j) {
                        *(h16x4*)(kd + 16 * j) = cvt4(xn[j]);
                        if (!lat) *(f32x4*)(p.out + O_K + (size_t)row * 128 + wn * 64 + 16 * j + 4 * fq) = xn[j];
                    }
                }
            } else {
                h16* vt = lat ? (h16*)(p.ws + WS_VT16L) + (size_t)(b * 2 + wn) * 64 * 1280 + 256 + t
                              : (h16*)(p.ws + WS_VT16C) + (size_t)(b * 2 + wn) * 64 * 256 + t;
                const int ld = lat ? 1280 : 256;
#pragma unroll
                for (int j = 0; j < 4; ++j) {
#pragma unroll
                    for (int r = 0; r < 4; ++r) vt[(size_t)(16 * j + 4 * fq + r) * ld] = (h16)acc[i][j][r];
                    if (!lat) *(f32x4*)(p.out + O_V + (size_t)row * 128 + wn * 64 + 16 * j + 4 * fq) = acc[i][j];
                }
            }
        }
    }
}
__device__ __forceinline__ void phase_gemm_res(const Params& p, const Ctx& c, const h16* A, int lda, const h16* Bt, int K, int layer, int gate_chunk, bool init, bool dry, bool ffn_pre) {
    float* X = (float*)(p.ws + WS_X);
    float* Xw = dry ? (float*)(p.ws + WS_PROJ) : X;
    const int fr = c.lane & 15, fq = c.lane >> 4, wm = c.wave >> 1, wn = c.wave & 1;
    for (int u = c.bid; u < 32 * 8; u += c.G) {
        const int pm = u & 31, pn = u >> 5;
        GemmTile g{A, lda, Bt, K, K, pm * 192, pn * 128};
        f32x4 acc[3][4]; gemm_tile<192>(c, g, acc);
#pragma unroll
        for (int i = 0; i < 3; ++i) {
            const int row = g.m0 + wm * 48 + 16 * i + fr;
            const float* gt = ada_chunk(p, layer, row, gate_chunk);
            const float* base = init ? xin_row(p, row) : X + (size_t)row * D;
            float ss = 0.f;
            const float* scp = ada_chunk(p, layer, row, 4);
#pragma unroll
            for (int j = 0; j < 4; ++j) {
                const int col = g.n0 + wn * 64 + 16 * j + 4 * fq;
                const f32x4 xn = *(const f32x4*)(base + col) + *(const f32x4*)(gt + col) * acc[i][j];
                *(f32x4*)(Xw + (size_t)row * D + col) = xn;
                if (ffn_pre) {
                    ss += xn[0] * xn[0] + xn[1] * xn[1] + xn[2] * xn[2] + xn[3] * xn[3];
                    const f32x4 pre = xn * *(const f32x4*)(p.in[I_NFG] + layer * 1024 + col) * (*(const f32x4*)(scp + col) + 1.f);
                    *(h16x4*)((h16*)(p.ws + (layer ? WS_XMIX : WS_HA)) + (size_t)row * D + col) = cvt4(pre);
                }
            }
            if (ffn_pre) { ss = rowsum4(ss); if (fq == 0 && !dry) atomicAdd((float*)(p.ws + WS_ROWSS) + layer * NTOK + row, ss); }
        }
    }
}
__device__ __forceinline__ void phase_gemm_gu(const Params& p, const Ctx& c, int layer) {
    h16* hid = (h16*)(p.ws + WS_HID);
    const int fr = c.lane & 15, fq = c.lane >> 4, wm = c.wave >> 1, wn = c.wave & 1;
    for (int u = c.bid; u < 32 * 22; u += c.G) {
        const int pm = u & 31, pn = u >> 5;
        GemmTile g{(const h16*)(p.ws + (layer ? WS_XMIX : WS_HA)), D, (const h16*)(p.ws + WS_WGU) + (size_t)layer * 5632 * 1024, D, D, pm * 192, pn * 256};
        f32x4 acc[3][8]; gemm_tile_wide(c, g, acc);
#pragma unroll
        for (int i = 0; i < 3; ++i) {
            const int row = g.m0 + wm * 48 + 16 * i + fr;
            const float rstd = rsqrtf(((const float*)(p.ws + WS_ROWSS))[layer * NTOK + row] * (1.f / 1024.f) + 1e-6f);
#pragma unroll
            for (int cc = 0; cc < 2; ++cc) {
                const int nb0 = g.n0 + wn * 128 + 64 * cc + 4 * fq, hc0 = (g.n0 + wn * 128 + 64 * cc) / 2 + 4 * fq;
                const float* fb = (const float*)(p.ws + WS_FBIAS) + (size_t)(layer * 3 + stream_of(row)) * 5632 + nb0;
#pragma unroll
                for (int j = 0; j < 2; ++j) {
                    const f32x4 bg = *(const f32x4*)(fb + 16 * j), bu = *(const f32x4*)(fb + 16 * (j + 2));
                    f32x4 o;
#pragma unroll
                    for (int r = 0; r < 4; ++r) o[r] = silu_f(acc[i][4 * cc + j][r] * rstd + bg[r]) * (acc[i][4 * cc + j + 2][r] * rstd + bu[r]);
                    *(h16x4*)(hid + (size_t)row * FF + hc0 + 16 * j) = cvt4(o);
                }
            }
        }
    }
}
__device__ __forceinline__ void phase_gemm_rkv(const Params& p, const Ctx& c) {
    h16* lora = (h16*)(p.ws + WS_LORA16);
    const h16* xm = (const h16*)(p.ws + WS_XMIX);
    const int fr = c.lane & 15, fq = c.lane >> 4, wm = c.wave >> 1, wn = c.wave & 1;
    for (int u = c.bid; u < 24 * 27; u += c.G) {
        const int pm = u % 24, pn = u / 24;
        const int ai = pn < 8 ? 0 : pn < 16 ? 2 : pn < 24 ? 3 : pn == 24 ? 1 : pn == 25 ? 4 : 5;
        GemmTile g{xm + (size_t)ai * NTOK * D, D, (const h16*)(p.ws + WS_WRKV), D, D, pm * 256, pn * 128};
        f32x4 acc[4][4]; gemm_tile<256>(c, g, acc);
#pragma unroll
        for (int i = 0; i < 4; ++i) {
            const int row = g.m0 + wm * 64 + 16 * i + fr;
#pragma unroll
            for (int j = 0; j < 4; ++j) {
                const int col = g.n0 + wn * 64 + 16 * j + 4 * fq;
                f32x4 v = acc[i][j];
                if (pn < 24) *(h16x4*)((h16*)(p.ws + (pn < 8 ? WS_R16 : pn < 16 ? WS_K16 : WS_V16)) + (size_t)row * D + (col & 1023)) = cvt4(v);
                else {
                    if (pn == 24) { for (int r = 0; r < 4; ++r) v[r] = 2.f * sigmoid_f(2.f * v[r]) - 1.f; }
                    else if (pn == 26) { for (int r = 0; r < 4; ++r) v[r] = sigmoid_f(v[r]); }
                    *(h16x4*)(lora + (size_t)row * 384 + col - 3072) = cvt4(v);
                }
            }
        }
    }
}
__device__ __forceinline__ void phase_gemm_lora2(const Params& p, const Ctx& c) {
    const h16* lora = (const h16*)(p.ws + WS_LORA16);
    h16* dec16 = (h16*)(p.ws + WS_DEC16); h16* a16 = (h16*)(p.ws + WS_A16); h16* g16 = (h16*)(p.ws + WS_G16);
    const int fr = c.lane & 15, fq = c.lane >> 4, wm = c.wave >> 1, wn = c.wave & 1;
    for (int u = c.bid; u < 24 * 40; u += c.G) {
        const int pm = u % 24, pn = u / 24, gq = pn >> 3, n0 = (pn & 7) * 128;
        const int K = gq < 4 ? 64 : 128;
        const h16* A = lora + (gq < 2 ? 64 * gq : gq < 4 ? 128 + 64 * (gq - 2) : 256);
        const h16* Bt = gq < 2 ? (const h16*)(p.ws + WS_W2T) + (size_t)gq * 65536 : gq < 4 ? (const h16*)(p.ws + WS_A2T) + (size_t)(gq - 2) * 65536 : (const h16*)(p.ws + WS_G2T);
        GemmTile g{A, 384, Bt, K, K, pm * 256, n0};
        f32x4 acc[4][4]; gemm_tile<256>(c, g, acc);
#pragma unroll
        for (int i = 0; i < 4; ++i) {
            const int row = g.m0 + wm * 64 + 16 * i + fr;
#pragma unroll
            for (int j = 0; j < 4; ++j) {
                const int col = n0 + wn * 64 + 16 * j + 4 * fq;
                f32x4 v = acc[i][j];
                if (gq < 2) {
                    const f32x4 w0 = *(const f32x4*)(p.in[I_W0] + gq * 1024 + col);
                    for (int r = 0; r < 4; ++r) { const float wl = w0[r] + v[r]; const float uu = 0.60653066f * sigmoid_f(wl); v[r] = 1.f - __expf(-uu); }
                    *(h16x4*)(dec16 + ((size_t)gq * NTOK + row) * D + col) = cvt4(v);
                } else if (gq < 4) {
                    const f32x4 a0 = *(const f32x4*)(p.in[I_A0] + (gq - 2) * 1024 + col);
                    for (int r = 0; r < 4; ++r) v[r] = sigmoid_f(a0[r] + v[r]);
                    *(h16x4*)(a16 + ((size_t)(gq - 2) * NTOK + row) * D + col) = cvt4(v);
                } else *(h16x4*)(g16 + (size_t)row * D + col) = cvt4(v);
            }
        }
    }
}

#ifdef ONLY_PHASE
#define PH_ON(k) ((k) == ONLY_PHASE)
#else
#define PH_ON(k) true
#endif
#ifndef ABL_MODE
#define ABL_MODE 0
#endif
#ifndef REP_MASK
#define REP_MASK 0u
#endif
#define NREP(k) (((REP_MASK >> (k)) & 1u) ? 2 : 1)
#define PHASE(k, call) do { if (PH_ON(k) && lo <= (k) && (k) < hi) { _Pragma("unroll") for (int rep = NREP(k) - 1; rep >= 0; --rep) { const bool dry = rep > 0; (void)dry; call; if ((k) + 1 < hi || dry) xcd_barrier(bar); } } } while (0)

__global__ void __launch_bounds__(NTHREADS, 2) mk_fwd(Params p) {
    extern __shared__ __attribute__((aligned(16))) unsigned char lds_raw[];
    Ctx c;
    c.lds = (LAS unsigned char*)lds_raw;
    c.tid = threadIdx.x; c.lane = c.tid & 63; c.wave = __builtin_amdgcn_readfirstlane(c.tid >> 6);
    c.bid = blockIdx.x; c.G = gridDim.x;
    volatile LAS unsigned* misc = (volatile LAS unsigned*)(c.lds + LDS_MISC);
    if (c.tid < 64) misc[c.tid] = 0u;
    __syncthreads();
    const int lo = p.ph_lo, hi = p.ph_hi;
    XcdBarrier bar; bar.bar = (unsigned*)(p.ws + WS_CTL); bar.x = 0; bar.st = nullptr;
    if (hi - lo > 1) bar = xcd_barrier_post((unsigned*)(p.ws + WS_CTL), misc + 8);
    PHASE(0, phase0(p, c));
    PHASE(1, phase_normmod(p, c, true, p.in[I_NMG], 0, 0, 1));
    PHASE(2, phase_gemm_inproj(p, c));
    PHASE(3, phase_postproj(p, c));
    PHASE(4, phase_mix0(p, c, dry ? 2 : 0));
    PHASE(5, phase_ssdcombine(p, c));
    PHASE(6, phase_gemm_res(p, c, (const h16*)(p.ws + WS_CAT), D, (const h16*)(p.ws + WS_WOUT), D, 0, 2, true, dry, true));
    PHASE(8, phase_gemm_gu(p, c, 0));
    PHASE(9, phase_gemm_res(p, c, (const h16*)(p.ws + WS_HID), FF, (const h16*)(p.ws + WS_WDN), FF, 0, 5, false, dry, false));
    PHASE(10, phase_rwkvmix(p, c));
    PHASE(11, phase_gemm_rkv(p, c));
    PHASE(12, phase_gemm_lora2(p, c));
    PHASE(13, phase_rwkvprep(p, c, dry));
    PHASE(14, if (dry) phase_rwkvscan<ABL_MODE>(p, c, 3); else phase_rwkvscan<0>(p, c, 1));
    PHASE(15, phase_rwkvpost(p, c));
    PHASE(16, phase_gemm_res(p, c, (const h16*)(p.ws + WS_HA), D, (const h16*)(p.ws + WS_WO), D, 1, 2, false, dry, true));
    PHASE(18, phase_gemm_gu(p, c, 1));
    PHASE(19, phase_gemm_res(p, c, (const h16*)(p.ws + WS_HID), FF, (const h16*)(p.ws + WS_WDN) + (size_t)1024 * 2816, FF, 1, 5, false, dry, false));
    PHASE(20, phase_final(p, c));
}

extern "C" void kernel_launch(void* const* d_in, const int* in_sizes, int n_in, void* d_out, int out_size, void* d_ws, size_t ws_size, hipStream_t stream) {
    static int grid = 0;
    if (grid == 0) {
        if (n_in != 46 || ws_size < WS_END) { fprintf(stderr, "kernel_launch: unexpected n_in %d or ws_size %zu\n", n_in, ws_size); grid = -1; return; }
        int dev = 0, cus = 0, per_cu = 0;
        (void)hipGetDevice(&dev);
        (void)hipDeviceGetAttribute(&cus, hipDeviceAttributeMultiprocessorCount, dev);
        if (hipFuncSetAttribute((const void*)mk_fwd, hipFuncAttributeMaxDynamicSharedMemorySize, LDS_BYTES) != hipSuccess) { fprintf(stderr, "kernel_launch: hipFuncSetAttribute failed\n"); grid = -1; return; }
        if (hipOccupancyMaxActiveBlocksPerMultiprocessor(&per_cu, (const void*)mk_fwd, NTHREADS, LDS_BYTES) != hipSuccess || per_cu < 1) { fprintf(stderr, "kernel_launch: occupancy query says %d\n", per_cu); }
        (void)hipGetLastError();
        grid = cus;
    }
    if (grid < 0) return;
    (void)hipMemsetAsync((char*)d_ws + WS_CTL, 0, CTL_ZERO_BYTES, stream);
    Params p{};
    for (int i = 0; i < 46; ++i) p.in[i] = (const float*)d_in[i];
    p.out = (float*)d_out; p.ws = (unsigned char*)d_ws;
#if MK_N_LAUNCHES == 1
    p.ph_lo = 0; p.ph_hi = NPH;
    hipLaunchKernelGGL(mk_fwd, dim3(grid), dim3(NTHREADS), LDS_BYTES, stream, p);
#else
    for (int ph = 0; ph < NPH; ++ph) { p.ph_lo = ph; p.ph_hi = ph + 1; hipLaunchKernelGGL(mk_fwd, dim3(grid), dim3(NTHREADS), LDS_BYTES, stream, p); }
#endif
}
```

```cpp
#include <hip/hip_runtime.h>
#include <cstdio>
#include <cstdint>

#ifndef MK_N_LAUNCHES
#define MK_N_LAUNCHES 1
#endif

#define LAS __attribute__((address_space(3)))
#define GAS __attribute__((address_space(1)))
typedef _Float16 h16;
typedef _Float16 h16x2 __attribute__((ext_vector_type(2)));
typedef _Float16 h16x4 __attribute__((ext_vector_type(4)));
typedef _Float16 h16x8 __attribute__((ext_vector_type(8)));
typedef float f32x4 __attribute__((ext_vector_type(4)));
typedef float f32x2 __attribute__((ext_vector_type(2)));
typedef unsigned u32x4 __attribute__((ext_vector_type(4)));

constexpr int D = 1024, NTOK = 6144, NCTX = 4096, FF = 2816;
constexpr int PROJ_LD = 2176;
constexpr int NPH = 21;
constexpr int NWAVES = 8, NTHREADS = 512;

constexpr size_t MiB = 1u << 20;
constexpr size_t WS_CTL = 0, CTL_ZERO_BYTES = 32768;
constexpr size_t WS_WIN = 1 * MiB;
constexpr size_t WS_WOUT = 6 * MiB;
constexpr size_t WS_WGU = 8 * MiB;
constexpr size_t WS_WDN = 30 * MiB;
constexpr size_t WS_WRKV = 41 * MiB;
constexpr size_t WS_WO = 48 * MiB;
constexpr size_t WS_W2T = 50 * MiB;
constexpr size_t WS_A2T = WS_W2T + 262144;
constexpr size_t WS_G2T = WS_A2T + 262144;
constexpr size_t WS_ADA = 51 * MiB;
constexpr size_t WS_ROPE = WS_ADA + 262144;
constexpr size_t WS_ROWSS = WS_ADA + 524288;
constexpr size_t WS_FBIAS = WS_ADA + 589824;
constexpr size_t WS_X = 52 * MiB;
constexpr size_t WS_HA = 76 * MiB;
constexpr size_t WS_HID = 88 * MiB;
constexpr size_t WS_PROJ = 121 * MiB;
constexpr size_t WS_Q16 = 172 * MiB;
constexpr size_t WS_K16C = 178 * MiB;
constexpr size_t WS_VT16C = 179 * MiB;
constexpr size_t WS_K16L = 180 * MiB;
constexpr size_t WS_VT16L = 181 * MiB;
constexpr size_t WS_CAT = 182 * MiB;
constexpr size_t WS_XBC = 194 * MiB;
constexpr size_t WS_DT = 212 * MiB;
constexpr size_t WS_DA = WS_DT + 6144 * 16 * 4;
constexpr size_t WS_SSDY = 213 * MiB;
constexpr size_t WS_G16 = 1 * MiB;
constexpr size_t WS_BONUS = 13 * MiB;
constexpr size_t WS_LORA16 = 76 * MiB;
constexpr size_t WS_R16 = 88 * MiB;
constexpr size_t WS_K16 = 100 * MiB;
constexpr size_t WS_Y16 = 88 * MiB;
constexpr size_t WS_V16 = 112 * MiB;
constexpr size_t WS_XMIX = 124 * MiB;
constexpr size_t WS_DEC16 = 124 * MiB;
constexpr size_t WS_A16 = 148 * MiB;
constexpr size_t WS_OPS2 = 172 * MiB;
constexpr size_t OPS2_ITEM = 6400;
constexpr size_t WS_END = 256 * MiB;

constexpr size_t O_Y = 0, O_K = 6291456, O_V = 6815744, O_SSDF = 7340032, O_SSDB = 7864320, O_RWF = 8388608, O_RWB = 9437184;

constexpr int LDS_BYTES = 148480;
constexpr int LDS_MISC = 147456;

struct Params {
    const float* in[46];
    float* out;
    unsigned char* ws;
    int ph_lo, ph_hi;
};
enum { I_XP = 0, I_XS, I_CK, I_CV, I_SSDF, I_SSDB, I_RWF, I_RWB, I_C, I_CCTX, I_MODW, I_MODB, I_NMG, I_NFG, I_WG, I_WU, I_WD,
       I_WIN, I_WOUT, I_QG, I_KG, I_CONVW, I_CONVB, I_DTB, I_ALOG, I_SSDD, I_SSDG, I_MU, I_WR, I_WK, I_WV, I_W0, I_W1, I_W2,
       I_A0, I_A1, I_A2, I_G1, I_G2, I_KKW, I_KA, I_RK, I_LNG, I_LNB, I_WO, I_FNG };

struct Ctx { int tid, lane, wave, bid, G; LAS unsigned char* lds; };

__device__ __forceinline__ float wave_sum(float v) {
#pragma unroll
    for (int o = 1; o < 64; o <<= 1) v += __shfl_xor(v, o);
    return v;
}
__device__ __forceinline__ float sigmoid_f(float x) { return __builtin_amdgcn_rcpf(1.f + __expf(-x)); }
__device__ __forceinline__ float silu_f(float x) { return x * sigmoid_f(x); }
__device__ __forceinline__ float softplus_f(float x) { return fmaxf(x, 0.f) + log1pf(__expf(-fabsf(x))); }
__device__ __forceinline__ int stream_of(int row) { return row < NCTX ? 0 : 1 + ((row - NCTX) >> 10); }
__device__ __forceinline__ h16x4 cvt4(f32x4 v) { h16x4 o; o.x = (h16)v.x; o.y = (h16)v.y; o.z = (h16)v.z; o.w = (h16)v.w; return o; }

template <int M> __device__ __forceinline__ void fmac_bc(float& d, float a, float b) {
    asm("v_fmac_f32_dpp %0, %1, %2 row_newbcast:%3 row_mask:0xf bank_mask:0xf" : "+v"(d) : "v"(a), "v"(b), "n"(M));
}
template <int M> __device__ __forceinline__ void fmac_bc_safe(float& d, float a, float b) {
    asm volatile("s_nop 1\n\tv_fmac_f32_dpp %0, %1, %2 row_newbcast:%3 row_mask:0xf bank_mask:0xf\n\ts_nop 1" : "+v"(d) : "v"(a), "v"(b), "n"(M));
}
template <int M> __device__ __forceinline__ void mul_bc(float& d, float a) {
    asm("v_mul_f32_dpp %0, %1, %0 row_newbcast:%2 row_mask:0xf bank_mask:0xf" : "+v"(d) : "v"(a), "n"(M));
}
__device__ __forceinline__ float rowsum4(float x) {
    float a = x, b = x;
    asm volatile("s_nop 1\n\tv_permlane16_swap_b32 %0, %1\n\ts_nop 1" : "+v"(a), "+v"(b));
    x = a + b; a = x; b = x;
    asm volatile("s_nop 1\n\tv_permlane32_swap_b32 %0, %1\n\ts_nop 1" : "+v"(a), "+v"(b));
    return a + b;
}

#define XB_TMO      128
#define XB_XCNT(j)  (256  + 64 * (j))
#define XB_XSUB(j)  (1280 + 64 * (j))
#define XB_XGEN(j)  (2304 + 64 * (j))
#define XB_TOP      3328
#define XB_TOPGEN   3392
#define XCD_BAR_WORDS 3456
#define XB_SPIN_CAP (1u << 22)
__device__ __forceinline__ unsigned xb_ld(unsigned* p)              { return __hip_atomic_load(p, __ATOMIC_RELAXED, __HIP_MEMORY_SCOPE_AGENT); }
__device__ __forceinline__ unsigned xb_add(unsigned* p, unsigned v) { return __hip_atomic_fetch_add(p, v, __ATOMIC_RELAXED, __HIP_MEMORY_SCOPE_AGENT); }
__device__ __forceinline__ unsigned xb_xcc_id() { return (unsigned)__builtin_amdgcn_s_getreg((3 << 11) | 20) & 0xFu; }
#define XB_SPIN(cond, bar) do { unsigned _sp = 0; while (cond) { __builtin_amdgcn_s_sleep(1); \
    if ((++_sp & 255u) == 0u) { if (xb_ld(&(bar)[XB_TMO])) break; if (_sp > XB_SPIN_CAP) { atomicAdd(&(bar)[XB_TMO], 1u); break; } } } } while (0)
struct XcdBarrier { unsigned* bar; unsigned x; volatile LAS unsigned* st; };
__device__ __forceinline__ XcdBarrier xcd_barrier_post(unsigned* bar, volatile LAS unsigned* st) {
    XcdBarrier b; b.bar = bar; b.x = xb_xcc_id(); b.st = st;
    if (threadIdx.x == 0) (void)xb_add(&bar[XB_XCNT(b.x)], 1u);
    return b;
}
__device__ __forceinline__ void xcd_barrier_complete(unsigned* bar, unsigned x, unsigned& nloc, unsigned& nx) {
    const unsigned G = gridDim.x * gridDim.y * gridDim.z;
    unsigned sum, cnt, mine, sp = 0u;
    for (;;) {
        sum = 0u; cnt = 0u; mine = 0u;
#pragma unroll
        for (unsigned j = 0; j < 16; ++j) { const unsigned c = xb_ld(&bar[XB_XCNT(j)]); sum += c; cnt += (c > 0u) ? 1u : 0u; mine = (j == x) ? c : mine; }
        if (sum == G) break;
        __builtin_amdgcn_s_sleep(1);
        if ((++sp & 255u) == 0u) { if (xb_ld(&bar[XB_TMO])) break; if (sp > XB_SPIN_CAP) { atomicAdd(&bar[XB_TMO], 1u); break; } }
    }
    nloc = mine > 0u ? mine : 1u; nx = cnt > 0u ? cnt : 1u;
}
__device__ __forceinline__ void xcd_barrier(const XcdBarrier& b) {
    asm volatile("s_waitcnt vmcnt(0)" ::: "memory");
    __syncthreads();
    if (threadIdx.x == 0) {
        unsigned* bar = b.bar;
        __builtin_amdgcn_s_waitcnt(0);
        unsigned nloc = b.st[0], nx = b.st[1];
        if (nloc == 0u) { xcd_barrier_complete(bar, b.x, nloc, nx); b.st[0] = nloc; b.st[1] = nx; }
        const unsigned old = xb_add(&bar[XB_XSUB(b.x)], 1u);
        const unsigned gen = old / nloc;
        if (old + 1u == (gen + 1u) * nloc) {
            __builtin_amdgcn_fence(__ATOMIC_RELEASE, "agent");
            asm volatile("s_waitcnt vmcnt(0)" ::: "memory");
            const unsigned og = xb_add(&bar[XB_TOP], 1u);
            const unsigned tg = og / nx;
            if (og + 1u == (tg + 1u) * nx) xb_add(&bar[XB_TOPGEN], 1u);
            else XB_SPIN(xb_ld(&bar[XB_TOPGEN]) == tg, bar);
            __builtin_amdgcn_fence(__ATOMIC_ACQUIRE, "agent");
            xb_add(&bar[XB_XGEN(b.x)], 1u);
            asm volatile("s_waitcnt vmcnt(0)" ::: "memory");
        } else {
            XB_SPIN(xb_ld(&bar[XB_XGEN(b.x)]) == gen, bar);
            __builtin_amdgcn_fence(__ATOMIC_ACQUIRE, "agent");
            asm volatile("s_waitcnt vmcnt(0)" ::: "memory");
        }
    }
    __syncthreads();
}

struct GemmTile { const h16* A; int lda; const h16* Bt; int ldb; int K; int m0, n0; };
constexpr int GEMM_STAGE_BYTES = 49152;

template <int BM>
__device__ __forceinline__ void gemm_tile(const Ctx& c, const GemmTile& g, f32x4 (&acc)[BM / 64][4]) {
    constexpr int MF = BM / 64, WM = BM / 4;
    LAS unsigned char* lds = c.lds;
    const int tid = c.tid, lane = c.lane, wave = c.wave;
    const int wm = wave >> 1, wn = wave & 1;
    const int srow = tid >> 3, schunk = (tid & 7) ^ (srow & 7);
    const h16* gA = g.A + (size_t)(g.m0 + srow) * g.lda + schunk * 8;
    const h16* gB = g.Bt + (size_t)(g.n0 + srow) * g.ldb + schunk * 8;
    const size_t stepA = (size_t)64 * g.lda, stepB = (size_t)64 * g.ldb;
    const unsigned ldsw = (unsigned)wave * 1024u;
    const int fr = lane & 15, fq = lane >> 4;
    int offA[2], offB[2];
#pragma unroll
    for (int s = 0; s < 2; ++s) {
        offA[s] = (wm * WM + fr) * 128 + (((s * 4 + fq) ^ (fr & 7)) << 4);
        offB[s] = 32768 + (wn * 64 + fr) * 128 + (((s * 4 + fq) ^ (fr & 7)) << 4);
    }
#pragma unroll
    for (int i = 0; i < MF; ++i)
#pragma unroll
        for (int j = 0; j < 4; ++j) acc[i][j] = (f32x4){0.f, 0.f, 0.f, 0.f};
    const int nk = g.K >> 6;
#define GEMM_STAGE(kt, buf) do { \
        _Pragma("unroll") for (int _p = 0; _p < MF; ++_p) \
            __builtin_amdgcn_global_load_lds((const unsigned*)(gA + _p * stepA + (size_t)(kt) * 64), (LAS unsigned*)(lds + (buf) * GEMM_STAGE_BYTES + _p * 8192 + ldsw), 16, 0, 0); \
        _Pragma("unroll") for (int _p = 0; _p < 2; ++_p) \
            __builtin_amdgcn_global_load_lds((const unsigned*)(gB + _p * stepB + (size_t)(kt) * 64), (LAS unsigned*)(lds + (buf) * GEMM_STAGE_BYTES + 32768 + _p * 8192 + ldsw), 16, 0, 0); \
    } while (0)
#define GEMM_RD(F_a, F_b, lb_, s_) do { \
        _Pragma("unroll") for (int i = 0; i < MF; ++i) F_a[i] = *(const LAS h16x8*)((lb_) + offA[s_] + i * 2048); \
        _Pragma("unroll") for (int j = 0; j < 4; ++j) F_b[j] = *(const LAS h16x8*)((lb_) + offB[s_] + j * 2048); } while (0)
#define GEMM_MM(F_a, F_b) do { \
        _Pragma("unroll") for (int i = 0; i < MF; ++i) _Pragma("unroll") for (int j = 0; j < 4; ++j) \
            acc[i][j] = __builtin_amdgcn_mfma_f32_16x16x32_f16(F_b[j], F_a[i], acc[i][j], 0, 0, 0); } while (0)
#define GEMM_BAR() do { asm volatile("s_waitcnt lgkmcnt(0)" ::: "memory"); __builtin_amdgcn_s_barrier(); asm volatile("" ::: "memory"); } while (0)
    GEMM_STAGE(0, 0);
    if (nk > 1) { GEMM_STAGE(1, 1); if (MF == 4) asm volatile("s_waitcnt vmcnt(6)" ::: "memory"); else asm volatile("s_waitcnt vmcnt(5)" ::: "memory"); }
    else asm volatile("s_waitcnt vmcnt(0)" ::: "memory");
    GEMM_BAR();
    h16x8 a0[MF], b0[4], a1[MF], b1[4];
    GEMM_RD(a0, b0, lds, 0);
    int cur = 0;
    for (int kt = 0; kt < nk; ++kt) {
        asm volatile("s_waitcnt vmcnt(0)" ::: "memory");
        __builtin_amdgcn_s_barrier();
        asm volatile("" ::: "memory");
        const int nx = cur == 2 ? 0 : cur + 1;
        if (kt + 2 < nk) { const int nb = cur >= 1 ? cur - 1 : 2; GEMM_STAGE(kt + 2, nb); }
        const LAS unsigned char* lb = lds + cur * GEMM_STAGE_BYTES;
        __builtin_amdgcn_sched_barrier(0);
#pragma unroll
        for (int j = 0; j < 4; ++j) acc[0][j] = __builtin_amdgcn_mfma_f32_16x16x32_f16(b0[j], a0[0], acc[0][j], 0, 0, 0);
        __builtin_amdgcn_sched_barrier(0);
        GEMM_RD(a1, b1, lb, 1);
        __builtin_amdgcn_sched_barrier(0);
#pragma unroll
        for (int i = 1; i < MF; ++i)
#pragma unroll
            for (int j = 0; j < 4; ++j) acc[i][j] = __builtin_amdgcn_mfma_f32_16x16x32_f16(b0[j], a0[i], acc[i][j], 0, 0, 0);
        __builtin_amdgcn_sched_barrier(0);
#pragma unroll
        for (int j = 0; j < 4; ++j) acc[0][j] = __builtin_amdgcn_mfma_f32_16x16x32_f16(b1[j], a1[0], acc[0][j], 0, 0, 0);
        __builtin_amdgcn_sched_barrier(0);
        if (kt + 1 < nk) { const LAS unsigned char* ln = lds + nx * GEMM_STAGE_BYTES; GEMM_RD(a0, b0, ln, 0); }
        __builtin_amdgcn_sched_barrier(0);
#pragma unroll
        for (int i = 1; i < MF; ++i)
#pragma unroll
            for (int j = 0; j < 4; ++j) acc[i][j] = __builtin_amdgcn_mfma_f32_16x16x32_f16(b1[j], a1[i], acc[i][j], 0, 0, 0);
        __builtin_amdgcn_sched_barrier(0);
        cur = nx;
    }
    GEMM_BAR();
#undef GEMM_STAGE
#undef GEMM_RD
#undef GEMM_MM
#undef GEMM_BAR
}

constexpr int GEMMW_STAGE = 57344;
__device__ __forceinline__ void gemm_tile_wide(const Ctx& c, const GemmTile& g, f32x4 (&acc)[3][8]) {
    LAS unsigned char* lds = c.lds;
    const int tid = c.tid, lane = c.lane, wave = c.wave;
    const int wm = wave >> 1, wn = wave & 1;
    const int srow = tid >> 3, schunk = (tid & 7) ^ (srow & 7);
    const h16* gA = g.A + (size_t)(g.m0 + srow) * g.lda + schunk * 8;
    const h16* gB = g.Bt + (size_t)(g.n0 + srow) * g.ldb + schunk * 8;
    const size_t stepA = (size_t)64 * g.lda, stepB = (size_t)64 * g.ldb;
    const unsigned ldsw = (unsigned)wave * 1024u;
    const int fr = lane & 15, fq = lane >> 4;
    int offA[2], offB[2];
#pragma unroll
    for (int s = 0; s < 2; ++s) {
        offA[s] = (wm * 48 + fr) * 128 + (((s * 4 + fq) ^ (fr & 7)) << 4);
        offB[s] = 24576 + (wn * 128 + fr) * 128 + (((s * 4 + fq) ^ (fr & 7)) << 4);
    }
#pragma unroll
    for (int i = 0; i < 3; ++i)
#pragma unroll
        for (int j = 0; j < 8; ++j) acc[i][j] = (f32x4){0.f, 0.f, 0.f, 0.f};
    const int nk = g.K >> 6;
#define GW_STAGE(kt, buf) do { \
        _Pragma("unroll") for (int _p = 0; _p < 3; ++_p) \
            __builtin_amdgcn_global_load_lds((const unsigned*)(gA + _p * stepA + (size_t)(kt) * 64), (LAS unsigned*)(lds + (buf) * GEMMW_STAGE + _p * 8192 + ldsw), 16, 0, 0); \
        _Pragma("unroll") for (int _p = 0; _p < 4; ++_p) \
            __builtin_amdgcn_global_load_lds((const unsigned*)(gB + _p * stepB + (size_t)(kt) * 64), (LAS unsigned*)(lds + (buf) * GEMMW_STAGE + 24576 + _p * 8192 + ldsw), 16, 0, 0); \
    } while (0)
    GW_STAGE(0, 0);
    for (int kt = 0; kt < nk; ++kt) {
        asm volatile("s_waitcnt vmcnt(0)" ::: "memory");
        asm volatile("s_waitcnt lgkmcnt(0)" ::: "memory");
        __builtin_amdgcn_s_barrier();
        asm volatile("" ::: "memory");
        const int cur = kt & 1;
        if (kt + 1 < nk) GW_STAGE(kt + 1, cur ^ 1);
        const LAS unsigned char* lb = lds + cur * GEMMW_STAGE;
#pragma unroll
        for (int s = 0; s < 2; ++s) {
            h16x8 af[3], bf[8];
#pragma unroll
            for (int i = 0; i < 3; ++i) af[i] = *(const LAS h16x8*)(lb + offA[s] + i * 2048);
#pragma unroll
            for (int j = 0; j < 8; ++j) bf[j] = *(const LAS h16x8*)(lb + offB[s] + j * 2048);
#pragma unroll
            for (int i = 0; i < 3; ++i)
#pragma unroll
                for (int j = 0; j < 8; ++j) acc[i][j] = __builtin_amdgcn_mfma_f32_16x16x32_f16(bf[j], af[i], acc[i][j], 0, 0, 0);
        }
    }
    asm volatile("s_waitcnt lgkmcnt(0)" ::: "memory");
    __builtin_amdgcn_s_barrier();
    asm volatile("" ::: "memory");
#undef GW_STAGE
}

__device__ __forceinline__ void tr_item(const float* W, int ldw, int nvalid, int k0, int n0, h16* dst, int ldd, int drow0, LAS float* scr, int lane) {
    const int c4 = lane & 7, kr = lane >> 3;
    const bool ok = (n0 + 4 * c4) < nvalid;
#pragma unroll
    for (int i = 0; i < 8; ++i) {
        const int kk = kr + 8 * i;
        const f32x4 v = ok ? *(const f32x4*)(W + (size_t)(k0 + kk) * ldw + n0 + 4 * c4) : (f32x4){0.f, 0.f, 0.f, 0.f};
        LAS float* s = scr + kk * 33 + 4 * c4;
        s[0] = v[0]; s[1] = v[1]; s[2] = v[2]; s[3] = v[3];
    }
    asm volatile("s_waitcnt lgkmcnt(0)" ::: "memory");
    const int cch = lane & 7;
#pragma unroll
    for (int j = 0; j < 4; ++j) {
        const int n = (lane >> 3) + 8 * j; const LAS float* s = scr + (8 * cch) * 33 + n;
        h16x8 o;
#pragma unroll
        for (int e = 0; e < 8; ++e) o[e] = (h16)s[e * 33];
        *(h16x8*)(dst + (size_t)(drow0 + n) * ldd + k0 + 8 * cch) = o;
    }
    asm volatile("s_waitcnt lgkmcnt(0)" ::: "memory");
}
struct TrJob { const float* src; int K, N, ldw, nvalid; h16* dst; int ldd, kind, base; };
__device__ __forceinline__ int tr_job(const Params& p, int j, TrJob& J) {
    unsigned char* ws = p.ws;
    switch (j) {
    case 0: J = {p.in[I_WIN], 1024, 2176, 2064, 2064, (h16*)(ws + WS_WIN), 1024, 0, 0}; break;
    case 1: J = {p.in[I_WOUT], 1024, 1024, 1024, 1024, (h16*)(ws + WS_WOUT), 1024, 0, 0}; break;
    case 2: case 3: J = {p.in[I_WG] + (size_t)(j - 2) * 1024 * 2816, 1024, 2816, 2816, 2816, (h16*)(ws + WS_WGU) + (size_t)(j - 2) * 5632 * 1024, 1024, 1, 0}; break;
    case 4: case 5: J = {p.in[I_WU] + (size_t)(j - 4) * 1024 * 2816, 1024, 2816, 2816, 2816, (h16*)(ws + WS_WGU) + (size_t)(j - 4) * 5632 * 1024, 1024, 2, 0}; break;
    case 6: case 7: J = {p.in[I_WD] + (size_t)(j - 6) * 2816 * 1024, 2816, 1024, 1024, 1024, (h16*)(ws + WS_WDN) + (size_t)(j - 6) * 1024 * 2816, 2816, 0, 0}; break;
    case 8: J = {p.in[I_WR], 1024, 1024, 1024, 1024, (h16*)(ws + WS_WRKV), 1024, 0, 0}; break;
    case 9: J = {p.in[I_WK], 1024, 1024, 1024, 1024, (h16*)(ws + WS_WRKV), 1024, 0, 1024}; break;
    case 10: J = {p.in[I_WV], 1024, 1024, 1024, 1024, (h16*)(ws + WS_WRKV), 1024, 0, 2048}; break;
    case 11: case 12: J = {p.in[I_W1] + (size_t)(j - 11) * 1024 * 64, 1024, 64, 64, 64, (h16*)(ws + WS_WRKV), 1024, 0, 3072 + 64 * (j - 11)}; break;
    case 13: case 14: J = {p.in[I_A1] + (size_t)(j - 13) * 1024 * 64, 1024, 64, 64, 64, (h16*)(ws + WS_WRKV), 1024, 0, 3072 + 128 + 64 * (j - 13)}; break;
    case 15: J = {p.in[I_G1], 1024, 128, 128, 128, (h16*)(ws + WS_WRKV), 1024, 0, 3072 + 256}; break;
    case 16: J = {p.in[I_WO], 1024, 1024, 1024, 1024, (h16*)(ws + WS_WO), 1024, 0, 0}; break;
    case 17: case 18: J = {p.in[I_W2] + (size_t)(j - 17) * 64 * 1024, 64, 1024, 1024, 1024, (h16*)(ws + WS_W2T) + (size_t)(j - 17) * 1024 * 64, 64, 0, 0}; break;
    case 19: case 20: J = {p.in[I_A2] + (size_t)(j - 19) * 64 * 1024, 64, 1024, 1024, 1024, (h16*)(ws + WS_A2T) + (size_t)(j - 19) * 1024 * 64, 64, 0, 0}; break;
    default: J = {p.in[I_G2], 128, 1024, 1024, 1024, (h16*)(ws + WS_G2T), 128, 0, 0}; break;
    }
    return (J.K / 64) * (J.N / 32);
}
constexpr int N_TRJOBS = 22;

__device__ __forceinline__ void ada_unit(const Params& p, const Ctx& c, int u) {
    LAS float* sc = (LAS float*)c.lds;
    LAS float* red = (LAS float*)(c.lds + 16384);
    const int layer = u / 96, cb = u % 96;
    __syncthreads();
    for (int i = c.tid; i < 3072; i += NTHREADS) {
        const int k = i >> 10, d = i & 1023;
        const float v = (k == 0) ? p.in[I_CCTX][d] : p.in[I_C][(k - 1) * 1024 + d];
        sc[i] = silu_f(v);
    }
    __syncthreads();
    const int tx = c.tid & 15, dg = c.tid >> 4;
    const float* w = p.in[I_MODW] + (size_t)layer * 1024 * 6144 + (size_t)(dg * 32) * 6144 + cb * 64 + tx * 4;
    f32x4 a0 = {0, 0, 0, 0}, a1 = a0, a2 = a0;
#pragma unroll 8
    for (int d = 0; d < 32; ++d) {
        const f32x4 wv = *(const f32x4*)(w + (size_t)d * 6144);
        const int dd = dg * 32 + d;
        a0 += wv * sc[dd]; a1 += wv * sc[1024 + dd]; a2 += wv * sc[2048 + dd];
    }
    *(LAS f32x4*)(red + (dg * 3 + 0) * 64 + tx * 4) = a0;
    *(LAS f32x4*)(red + (dg * 3 + 1) * 64 + tx * 4) = a1;
    *(LAS f32x4*)(red + (dg * 3 + 2) * 64 + tx * 4) = a2;
    __syncthreads();
    if (c.tid < 192) {
        const int k = c.tid >> 6, col = c.tid & 63;
        float s = p.in[I_MODB][layer * 6144 + cb * 64 + col];
#pragma unroll 8
        for (int g = 0; g < 32; ++g) s += red[(g * 3 + k) * 64 + col];
        ((float*)(p.ws + WS_ADA))[(layer * 3 + k) * 6144 + cb * 64 + col] = s;
    }
}

constexpr int N_CONV_ITEMS = 11392, N_CONV_UNITS = N_CONV_ITEMS / 64;
__device__ __forceinline__ void conv_unit(const Params& p, const Ctx& c, int u) {
    LAS float* scr = (LAS float*)(c.lds + c.wave * 16384);
    __syncthreads();
    for (int e = 0; e < 8; ++e) {
        int it = u * 64 + c.wave * 8 + e;
        int j = 1; TrJob J; int cnt = tr_job(p, j, J);
        while (it >= cnt) { it -= cnt; ++j; cnt = tr_job(p, j, J); }
        const int nblk = J.N / 32, kb = it / nblk, nb = it % nblk, n0 = nb * 32;
        const int drow0 = J.kind == 0 ? J.base + n0 : (J.kind == 1 ? 2 * n0 : 2 * n0 + 32);
        tr_item(J.src, J.ldw, J.nvalid, kb * 64, n0, J.dst, J.ldd, drow0, scr, c.lane);
    }
    __syncthreads();
}
__device__ __forceinline__ void phase0(const Params& p, const Ctx& c) {
    for (int u = c.bid; u < 192; u += c.G) ada_unit(p, c, u);
    __syncthreads();
    {
        LAS float* scr = (LAS float*)(c.lds + c.wave * 16384);
        const int gw = c.bid * NWAVES + c.wave, NGW = c.G * NWAVES;
        TrJob J; const int cnt = tr_job(p, 0, J);
        const int nblk = J.N / 32;
        for (int it = gw; it < cnt; it += NGW) {
            const int kb = it / nblk, nb = it % nblk, n0 = nb * 32;
            tr_item(J.src, J.ldw, J.nvalid, kb * 64, n0, J.dst, J.ldd, J.base + n0, scr, c.lane);
        }
    }
    { float* rs_ = (float*)(p.ws + WS_ROWSS); for (int i = c.bid * NTHREADS + c.tid; i < 2 * NTOK; i += c.G * NTHREADS) rs_[i] = 0.f; }
    const int gt = c.bid * NTHREADS + c.tid, NGT = c.G * NTHREADS;
    float* rc = (float*)(p.ws + WS_ROPE); float* rs = rc + 32768;
    for (int i = gt; i < 32768; i += NGT) {
        const int tok = i >> 5, f = i & 31;
        const float pos = (float)((f < 16) ? (tok >> 6) : (tok & 63));
        const float inv = powf(10000.f, -(float)(f & 15) / 16.f);
        const float ang = pos * inv;
        rc[i] = cosf(ang); rs[i] = sinf(ang);
    }
    h16* k16l = (h16*)(p.ws + WS_K16L); h16* vt16l = (h16*)(p.ws + WS_VT16L);
    for (int i = gt; i < 65536; i += NGT) {
        const int d = i & 63, kvh = (i >> 6) & 1, key = (i >> 7) & 255, b = i >> 15;
        k16l[((size_t)(b * 2 + kvh) * 1280 + key) * 64 + d] = (h16)p.in[I_CK][i];
        vt16l[((size_t)(b * 2 + kvh) * 64 + d) * 1280 + key] = (h16)p.in[I_CV][i];
    }
}

__device__ __forceinline__ void load_row(const float* r, int lane, f32x4 (&v)[4]) {
#pragma unroll
    for (int j = 0; j < 4; ++j) v[j] = *(const f32x4*)(r + 256 * j + 4 * lane);
}
__device__ __forceinline__ float row_rstd(const f32x4 (&v)[4]) {
    float s = 0.f;
#pragma unroll
    for (int j = 0; j < 4; ++j) s += v[j].x * v[j].x + v[j].y * v[j].y + v[j].z * v[j].z + v[j].w * v[j].w;
    return rsqrtf(wave_sum(s) * (1.f / 1024.f) + 1e-6f);
}
__device__ __forceinline__ const float* xin_row(const Params& p, int row) {
    return row < NCTX ? p.in[I_XP] + (size_t)row * D : p.in[I_XS] + (size_t)(row - NCTX) * D;
}
__device__ __forceinline__ void phase_normmod(const Params& p, const Ctx& c, bool from_input, const float* g, int layer, int ch_sh, int ch_sc) {
    const int gw = c.bid * NWAVES + c.wave, NGW = c.G * NWAVES;
    const float* ada = (const float*)(p.ws + WS_ADA);
    h16* hA = (h16*)(p.ws + WS_HA);
    for (int row = gw; row < NTOK; row += NGW) {
        const float* xr = from_input ? xin_row(p, row) : (const float*)(p.ws + WS_X) + (size_t)row * D;
        f32x4 v[4]; load_row(xr, c.lane, v);
        const float rstd = row_rstd(v);
        const float* a = ada + (size_t)(layer * 3 + stream_of(row)) * 6144;
#pragma unroll
        for (int j = 0; j < 4; ++j) {
            const int col = 256 * j + 4 * c.lane;
            const f32x4 gg = *(const f32x4*)(g + col), sh = *(const f32x4*)(a + ch_sh * 1024 + col), sc = *(const f32x4*)(a + ch_sc * 1024 + col);
            const f32x4 o = v[j] * rstd * gg * (sc + 1.f) + sh;
            *(h16x4*)(hA + (size_t)row * D + col) = cvt4(o);
        }
    }
}

__device__ __forceinline__ void phase_postproj(const Params& p, const Ctx& c) {
    const int gw = c.bid * NWAVES + c.wave, NGW = c.G * NWAVES, lane = c.lane;
    const float* proj = (const float*)(p.ws + WS_PROJ);
    float* xbc = (float*)(p.ws + WS_XBC);
    float* dtv = (float*)(p.ws + WS_DT);
    for (int it = gw; it < 384 * 3; it += NGW) {
        const int seg = it / 3, cb = it % 3, row0 = seg * 16, ch = cb * 256 + lane * 4;
        const int T = row0 >= NCTX ? 1024 : 256, t0 = (row0 >= NCTX ? row0 - NCTX : row0) & (T - 1);
        f32x4 x[20];
#pragma unroll
        for (int r = 0; r < 20; ++r) {
            const int tt = t0 + r - 2;
            x[r] = (tt >= 0 && tt < T) ? *(const f32x4*)(proj + (size_t)(row0 + r - 2) * PROJ_LD + 1280 + ch) : (f32x4){0.f, 0.f, 0.f, 0.f};
        }
        f32x4 w[5];
#pragma unroll
        for (int i = 0; i < 5; ++i) w[i] = *(const f32x4*)(p.in[I_CONVW] + i * 768 + ch);
        const f32x4 bias = *(const f32x4*)(p.in[I_CONVB] + ch);
#pragma unroll
        for (int r = 0; r < 16; ++r) {
            f32x4 a = bias;
#pragma unroll
            for (int i = 0; i < 5; ++i) a += w[i] * x[r + i];
            f32x4 o; o[0] = silu_f(a[0]); o[1] = silu_f(a[1]); o[2] = silu_f(a[2]); o[3] = silu_f(a[3]);
            *(f32x4*)(xbc + (size_t)(row0 + r) * 768 + ch) = o;
        }
    }
    for (int it = gw; it < NTOK / 4; it += NGW) {
        const int row = it * 4 + (lane >> 4), e = lane & 15;
        dtv[row * 16 + e] = softplus_f(proj[(size_t)row * PROJ_LD + 2048 + e] + p.in[I_DTB][e]);
    }
}

__device__ __forceinline__ void phase_ssdcombine(const Params& p, const Ctx& c) {
    const int gw = c.bid * NWAVES + c.wave, NGW = c.G * NWAVES, lane = c.lane;
    {
        const float* ada = (const float*)(p.ws + WS_ADA); float* fb = (float*)(p.ws + WS_FBIAS);
        for (int it = gw; it < 2 * 5632; it += NGW) {
            const int l = it / 5632, n = it % 5632;
            const h16* wr = (const h16*)(p.ws + WS_WGU) + ((size_t)l * 5632 + n) * 1024 + lane * 16;
            const h16x8 w0 = *(const h16x8*)wr, w1 = *(const h16x8*)(wr + 8);
            float a0 = 0.f, a1 = 0.f, a2 = 0.f;
#pragma unroll
            for (int e = 0; e < 16; ++e) {
                const float w = (float)(e < 8 ? w0[e & 7] : w1[e & 7]); const int k = lane * 16 + e;
                a0 += w * ada[(size_t)(l * 3 + 0) * 6144 + 3072 + k]; a1 += w * ada[(size_t)(l * 3 + 1) * 6144 + 3072 + k]; a2 += w * ada[(size_t)(l * 3 + 2) * 6144 + 3072 + k];
            }
            a0 = wave_sum(a0); a1 = wave_sum(a1); a2 = wave_sum(a2);
            if (lane == 0) { fb[(size_t)(l * 3 + 0) * 5632 + n] = a0; fb[(size_t)(l * 3 + 1) * 5632 + n] = a1; fb[(size_t)(l * 3 + 2) * 5632 + n] = a2; }
        }
    }
    const float* ssdy = (const float*)(p.ws + WS_SSDY);
    const float* xbc = (const float*)(p.ws + WS_XBC);
    const float* proj = (const float*)(p.ws + WS_PROJ);
    h16* cat = (h16*)(p.ws + WS_CAT);
    for (int row = gw; row < NTOK; row += NGW) {
        const int c0 = lane * 8, h = lane >> 3;
        const float dsk = p.in[I_SSDD][h];
        float y[8]; float ss = 0.f;
#pragma unroll
        for (int e = 0; e < 2; ++e) {
            const f32x4 yf = *(const f32x4*)(ssdy + (size_t)row * 512 + c0 + 4 * e), yb = *(const f32x4*)(ssdy + (size_t)(NTOK + row) * 512 + c0 + 4 * e);
            const f32x4 xs = *(const f32x4*)(xbc + (size_t)row * 768 + c0 + 4 * e), z = *(const f32x4*)(proj + (size_t)row * PROJ_LD + 768 + c0 + 4 * e);
#pragma unroll
            for (int q = 0; q < 4; ++q) { const float v = (yf[q] + yb[q] + dsk * xs[q]) * silu_f(z[q]); y[4 * e + q] = v; ss += v * v; }
        }
        const float rstd = rsqrtf(wave_sum(ss) * (1.f / 512.f) + 1e-6f);
        h16x8 o;
#pragma unroll
        for (int e = 0; e < 8; ++e) o[e] = (h16)(y[e] * rstd * p.in[I_SSDG][c0 + e]);
        *(h16x8*)(cat + (size_t)row * D + 512 + c0) = o;
    }
}

__device__ __forceinline__ void phase_rwkvmix(const Params& p, const Ctx& c) {
    const int gw = c.bid * NWAVES + c.wave, NGW = c.G * NWAVES, lane = c.lane;
    const float* X = (const float*)(p.ws + WS_X);
    const float* ada = (const float*)(p.ws + WS_ADA);
    const float* g = p.in[I_NMG] + 1024;
    h16* xm = (h16*)(p.ws + WS_XMIX);
    for (int row = gw; row < NTOK; row += NGW) {
        const bool lat = row >= NCTX;
        const int r2 = lat ? row - NCTX : row;
        const int t = lat ? (r2 & 1023) : (r2 & 255), T = lat ? 1024 : 256;
        const float* a = ada + (size_t)(3 + stream_of(row)) * 6144;
        f32x4 h0[4], hp[4], hn[4];
        load_row(X + (size_t)row * D, lane, h0);
        const float r0 = row_rstd(h0);
        const bool hasp = t > 0, hasn = t < T - 1;
        float rp = 0.f, rn = 0.f;
        if (hasp) { load_row(X + (size_t)(row - 1) * D, lane, hp); rp = row_rstd(hp); }
        if (hasn) { load_row(X + (size_t)(row + 1) * D, lane, hn); rn = row_rstd(hn); }
#pragma unroll
        for (int j = 0; j < 4; ++j) {
            const int col = 256 * j + 4 * lane;
            const f32x4 gg = *(const f32x4*)(g + col), sh = *(const f32x4*)(a + col), sc = *(const f32x4*)(a + 1024 + col);
            const f32x4 m = gg * (sc + 1.f);
            const f32x4 hh = h0[j] * r0 * m + sh;
            f32x4 dp = -hh, dn = -hh;
            if (hasp) dp = (hp[j] * rp * m + sh) - hh;
            if (hasn) dn = (hn[j] * rn * m + sh) - hh;
#pragma unroll
            for (int i = 0; i < 6; ++i) {
                const f32x4 m0 = *(const f32x4*)(p.in[I_MU] + i * 1024 + col), m1 = *(const f32x4*)(p.in[I_MU] + (6 + i) * 1024 + col);
                *(h16x4*)(xm + ((size_t)i * NTOK + row) * D + col) = cvt4(hh + dp * m0 + dn * m1);
            }
        }
    }
}

template <int N> __device__ __forceinline__ float dpp_row_shr1(float x) {
    return __builtin_bit_cast(float, __builtin_amdgcn_update_dpp(0x3f800000, __builtin_bit_cast(int, x), 0x110 + N, 0xf, 0xf, false));
}
__device__ __forceinline__ float dpp_bcast15(float x) {
    return __builtin_bit_cast(float, __builtin_amdgcn_update_dpp(0, __builtin_bit_cast(int, x), 0x150 + 15, 0xf, 0xf, false));
}
template <int J> struct TriSolve {
    static __device__ __forceinline__ void run(float (&Tm)[4], const float (&nL)[16]) {
#pragma unroll
        for (int cc = 0; cc < 4; ++cc) { float src_ = Tm[cc]; fmac_bc_safe<J>(Tm[cc], src_, nL[J]); }
        if constexpr (J < 14) TriSolve<J + 1>::run(Tm, nL);
    }
};
#define P13_ST(T_, ptr_, val_) do { T_ v__ = (val_); if (dry) asm volatile("" :: "v"(v__)); else *(T_*)(ptr_) = v__; } while (0)
__device__ __forceinline__ void phase_rwkvprep(const Params& p, const Ctx& c, bool dry) {
    const int gw = c.bid * NWAVES + c.wave, NGW = c.G * NWAVES, lane = c.lane;
    const int i = lane & 15, g = lane >> 4;
    LAS unsigned char* scr = c.lds + c.wave * 8192;
    const h16* r16 = (const h16*)(p.ws + WS_R16); const h16* k16 = (const h16*)(p.ws + WS_K16);
    float* bonus = (float*)(p.ws + WS_BONUS);
    const int h = gw & 15, npair = 2 * 384, pstep = NGW >> 4;
    f32x4 kkw4[4], ka4v[4], rk4v[4];
#pragma unroll
    for (int q = 0; q < 4; ++q) {
        kkw4[q] = *(const f32x4*)(p.in[I_KKW] + h * 64 + 16 * q + 4 * g); ka4v[q] = *(const f32x4*)(p.in[I_KA] + h * 64 + 16 * q + 4 * g); rk4v[q] = *(const f32x4*)(p.in[I_RK] + h * 64 + 16 * q + 4 * g);
    }
    h16x4 nk4[4], nr4[4], nd4[4], na4[4];
#define P13_LOAD(pi_) do { const int rbg_ = (pi_) % 384, dir_ = (pi_) / 384, row_ = rbg_ * 16 + (dir_ ? 15 - i : i); \
        const h16* dec_ = (const h16*)(p.ws + WS_DEC16) + (size_t)dir_ * NTOK * D; const h16* a16_ = (const h16*)(p.ws + WS_A16) + (size_t)dir_ * NTOK * D; \
        _Pragma("unroll") for (int q_ = 0; q_ < 4; ++q_) { const size_t o_ = (size_t)row_ * D + h * 64 + 16 * q_ + 4 * g; \
            nk4[q_] = *(const h16x4*)(k16 + o_); nr4[q_] = *(const h16x4*)(r16 + o_); nd4[q_] = *(const h16x4*)(dec_ + o_); na4[q_] = *(const h16x4*)(a16_ + o_); } } while (0)
    if ((gw >> 4) < npair) P13_LOAD(gw >> 4);
    for (int pi = gw >> 4; pi < npair; pi += pstep) {
        const int rbg = pi % 384, dir = pi / 384, item = (dir * 384 + rbg) * 16 + h;
        const int row0 = rbg * 16, row = row0 + (dir ? 15 - i : i);
        h16* dec = (h16*)(p.ws + WS_DEC16) + (size_t)dir * NTOK * D; h16* a16 = (h16*)(p.ws + WS_A16) + (size_t)dir * NTOK * D;
        float kv[16], rv[16], wv[16], av[16];
#pragma unroll
        for (int q = 0; q < 4; ++q) {
            asm volatile("" : "+v"(nk4[q]), "+v"(nr4[q]), "+v"(nd4[q]), "+v"(na4[q]));
#pragma unroll
            for (int jj = 0; jj < 4; ++jj) { kv[4 * q + jj] = (float)nk4[q][jj]; rv[4 * q + jj] = (float)nr4[q][jj]; wv[4 * q + jj] = 1.f - (float)nd4[q][jj]; av[4 * q + jj] = (float)na4[q][jj]; }
        }
        { const int pn_ = (pi + pstep < npair) ? pi + pstep : pi; P13_LOAD(pn_); }
        float kap[16], ss = 0.f;
#pragma unroll
        for (int q = 0; q < 4; ++q) {
            const f32x4 kkw = kkw4[q];
#pragma unroll
            for (int jj = 0; jj < 4; ++jj) { kap[4 * q + jj] = kv[4 * q + jj] * kkw[jj]; ss += kap[4 * q + jj] * kap[4 * q + jj]; }
        }
        ss = rowsum4(ss);
        const float rn = rsqrtf(ss + 1e-12f);
        float bon = 0.f;
        float beta[16], kt[16];
#pragma unroll
        for (int q = 0; q < 4; ++q) {
            const f32x4 ka4 = ka4v[q], rk4 = rk4v[q];
#pragma unroll
            for (int jj = 0; jj < 4; ++jj) {
                const int m = 4 * q + jj;
                kap[m] *= rn; beta[m] = kap[m] * av[m]; kt[m] = kv[m] * (1.f + (av[m] - 1.f) * ka4[jj]);
                bon += rv[m] * kt[m] * rk4[jj];
            }
        }
        bon = rowsum4(bon);
        if (g == 0) P13_ST(float, bonus + ((size_t)dir * NTOK + row) * 16 + h, bon);
        f32x4 A1 = {0.f, 0.f, 0.f, 0.f}, Lm = A1, N1 = A1, N2 = A1;
        h16 kapo[16], rho[16], kbo[16], bbo[16], kho[16], bho[16];
        float gcv[16];
#pragma unroll
        for (int m = 0; m < 16; ++m) {
            float G = wv[m];
            G *= dpp_row_shr1<1>(G); G *= dpp_row_shr1<2>(G); G *= dpp_row_shr1<4>(G); G *= dpp_row_shr1<8>(G);
            const float Gex = dpp_row_shr1<1>(G), GC = dpp_bcast15(G), rG = __builtin_amdgcn_rcpf(G);
            const float kh = kap[m] * Gex, rh = rv[m] * G, k_h = kt[m] * rG, b_h = beta[m] * rG;
            kapo[m] = (h16)kh; rho[m] = (h16)rh; kbo[m] = (h16)(k_h * GC); bbo[m] = (h16)(b_h * GC); gcv[m] = GC;
            kho[m] = (h16)fminf(fmaxf(k_h, -60000.f), 60000.f); bho[m] = (h16)fminf(fmaxf(b_h, -60000.f), 60000.f);
        }
#pragma unroll
        for (int s = 0; s < 2; ++s) {
            h16x8 ka8, rh8, kh8, bh8;
#pragma unroll
            for (int e = 0; e < 8; ++e) { ka8[e] = kapo[8 * s + e]; rh8[e] = rho[8 * s + e]; kh8[e] = kho[8 * s + e]; bh8[e] = bho[8 * s + e]; }
            A1 = __builtin_amdgcn_mfma_f32_16x16x32_f16(kh8, ka8, A1, 0, 0, 0);
            Lm = __builtin_amdgcn_mfma_f32_16x16x32_f16(bh8, ka8, Lm, 0, 0, 0);
            N1 = __builtin_amdgcn_mfma_f32_16x16x32_f16(kh8, rh8, N1, 0, 0, 0);
            N2 = __builtin_amdgcn_mfma_f32_16x16x32_f16(bh8, rh8, N2, 0, 0, 0);
        }
#pragma unroll
        for (int r = 0; r < 4; ++r) { const int j = 4 * g + r; if (!(j < i)) { A1[r] = 0.f; Lm[r] = 0.f; } if (!(j <= i)) { N1[r] = 0.f; N2[r] = 0.f; } }
        LAS float* Lb = (LAS float*)(scr + 4096);
        *(LAS f32x4*)(Lb + i * 16 + 4 * g) = Lm;
        LAS h16* kbT = (LAS h16*)scr;
#pragma unroll
        for (int m = 0; m < 16; ++m) {
            const int f = m >> 2, kc = 4 * g + (m & 3);
            const int u = ((f * 16 + kc) * 4 + (i >> 2)) * 8 + (i & 3);
            kbT[u] = kbo[m]; kbT[u + 4] = bbo[m];
        }
        asm volatile("s_waitcnt lgkmcnt(0)" ::: "memory");
        float nL[16];
#pragma unroll
        for (int q = 0; q < 4; ++q) { const f32x4 v = *(const LAS f32x4*)(Lb + i * 16 + 4 * q); nL[4 * q] = -v[0]; nL[4 * q + 1] = -v[1]; nL[4 * q + 2] = -v[2]; nL[4 * q + 3] = -v[3]; }
        float Tm[4];
#pragma unroll
        for (int cc = 0; cc < 4; ++cc) Tm[cc] = (i == 4 * g + cc) ? 1.f : 0.f;
        asm volatile("s_nop 1" : "+v"(Tm[0]), "+v"(Tm[1]), "+v"(Tm[2]), "+v"(Tm[3]));
        TriSolve<0>::run(Tm, nL);
        unsigned char* item_o = p.ws + WS_OPS2 + (size_t)item * OPS2_ITEM;
        {
            h16x8 o;
#pragma unroll
            for (int s = 0; s < 2; ++s) {
#pragma unroll
                for (int e = 0; e < 8; ++e) o[e] = kapo[8 * s + e];
                P13_ST(h16x8, dec + (size_t)(row0 + i) * D + h * 64 + (g * 2 + s) * 8, o);
#pragma unroll
                for (int e = 0; e < 8; ++e) o[e] = rho[8 * s + e];
                P13_ST(h16x8, a16 + (size_t)(row0 + i) * D + h * 64 + (g * 2 + s) * 8, o);
            }
        }
#pragma unroll
        for (int q = 0; q < 4; ++q) P13_ST(u32x4, item_o + (q * 64 + lane) * 16, *(const LAS u32x4*)(scr + (q * 64 + lane) * 16));
        P13_ST(h16x4, item_o + 4096 + (i * 4 + g) * 8, cvt4(A1));
        { f32x4 t4 = {Tm[0], Tm[1], Tm[2], Tm[3]}; P13_ST(h16x4, item_o + 4608 + (i * 4 + g) * 8, cvt4(t4)); }
        { h16x8 o; for (int r = 0; r < 4; ++r) { o[r] = (h16)N1[r]; o[4 + r] = (h16)N2[r]; } P13_ST(h16x8, item_o + 5120 + (i * 4 + g) * 16, o); }
        if (i == 0) {
#pragma unroll
            for (int q = 0; q < 4; ++q) P13_ST(f32x4, item_o + 6144 + (16 * q + 4 * g) * 4, ((f32x4){gcv[4 * q], gcv[4 * q + 1], gcv[4 * q + 2], gcv[4 * q + 3]}));
        }
        asm volatile("s_waitcnt lgkmcnt(0)" ::: "memory");
    }
}

__device__ __forceinline__ void phase_rwkvpost(const Params& p, const Ctx& c) {
    const int gw = c.bid * NWAVES + c.wave, NGW = c.G * NWAVES, lane = c.lane;
    const h16* y16 = (const h16*)(p.ws + WS_Y16); const h16* v16 = (const h16*)(p.ws + WS_V16); const h16* g16 = (const h16*)(p.ws + WS_G16);
    const float* bonus = (const float*)(p.ws + WS_BONUS);
    h16* hA = (h16*)(p.ws + WS_HA);
    for (int row = gw; row < NTOK; row += NGW) {
        const int c0 = lane * 16;
        float y[16]; float s = 0.f;
#pragma unroll
        for (int e = 0; e < 2; ++e) {
            const h16x8 a = *(const h16x8*)(y16 + (size_t)row * D + c0 + 8 * e), b = *(const h16x8*)(y16 + ((size_t)NTOK + row) * D + c0 + 8 * e);
#pragma unroll
            for (int q = 0; q < 8; ++q) { y[8 * e + q] = (float)a[q] + (float)b[q]; s += y[8 * e + q]; }
        }
        s += __shfl_xor(s, 1); s += __shfl_xor(s, 2);
        const float mean = s * (1.f / 64.f);
        float vs = 0.f;
#pragma unroll
        for (int e = 0; e < 16; ++e) { y[e] -= mean; vs += y[e] * y[e]; }
        vs += __shfl_xor(vs, 1); vs += __shfl_xor(vs, 2);
        const float rstd = rsqrtf(vs * (1.f / 64.f) + 64e-5f);
        const float bon = bonus[row * 16 + (lane >> 2)] + bonus[((size_t)NTOK + row) * 16 + (lane >> 2)];
#pragma unroll
        for (int e = 0; e < 2; ++e) {
            const h16x8 vv = *(const h16x8*)(v16 + (size_t)row * D + c0 + 8 * e), gv = *(const h16x8*)(g16 + (size_t)row * D + c0 + 8 * e);
            h16x8 o;
#pragma unroll
            for (int q = 0; q < 8; ++q) {
                const int cc = c0 + 8 * e + q;
                const float yn = y[8 * e + q] * rstd * p.in[I_LNG][cc] + p.in[I_LNB][cc];
                o[q] = (h16)((yn + bon * (float)vv[q]) * (float)gv[q]);
            }
            *(h16x8*)(hA + (size_t)row * D + c0 + 8 * e) = o;
        }
    }
}

__device__ __forceinline__ void phase_final(const Params& p, const Ctx& c) {
    const int gw = c.bid * NWAVES + c.wave, NGW = c.G * NWAVES;
    const float* X = (const float*)(p.ws + WS_X);
    for (int row = gw; row < NTOK; row += NGW) {
        f32x4 v[4]; load_row(X + (size_t)row * D, c.lane, v);
        const float rstd = row_rstd(v);
#pragma unroll
        for (int j = 0; j < 4; ++j) {
            const int col = 256 * j + 4 * c.lane;
            *(f32x4*)(p.out + O_Y + (size_t)row * D + col) = v[j] * rstd * *(const f32x4*)(p.in[I_FNG] + col);
        }
    }
}

__device__ __forceinline__ void attn_unit(const Params& p, const Ctx& c, bool lat, int b, int kvh, int qb) {
    const int lane = c.lane, wave = c.wave, tid = c.tid;
    const int nkeys = lat ? 1280 : 256;
    const h16* Kg = lat ? (const h16*)(p.ws + WS_K16L) + (size_t)(b * 2 + kvh) * 1280 * 64 : (const h16*)(p.ws + WS_K16C) + (size_t)(b * 2 + kvh) * 256 * 64;
    const h16* Vg = lat ? (const h16*)(p.ws + WS_VT16L) + (size_t)(b * 2 + kvh) * 64 * 1280 : (const h16*)(p.ws + WS_VT16C) + (size_t)(b * 2 + kvh) * 64 * 256;
    const int row0 = (lat ? NCTX + b * 1024 : b * 256) + qb * 32 + (wave & 1) * 16;
    const int head = kvh * 4 + (wave >> 1);
    const int fr = lane & 15, fq = lane >> 4;
    const h16* q16 = (const h16*)(p.ws + WS_Q16);
    h16x8 qf[2];
#pragma unroll
    for (int s = 0; s < 2; ++s) qf[s] = *(const h16x8*)(q16 + (size_t)(row0 + fr) * 512 + head * 64 + s * 32 + fq * 8);
    LAS unsigned char* ldsK = c.lds; LAS unsigned char* ldsV = c.lds + 8192;
    float m = -1e30f, l = 0.f;
    f32x4 O[4];
#pragma unroll
    for (int f = 0; f < 4; ++f) O[f] = (f32x4){0.f, 0.f, 0.f, 0.f};
    const int srow = tid >> 3, sch = tid & 7;
    const int sdst = srow * 128 + ((sch ^ (srow & 7)) << 4);
    const int ntile = nkeys / 64;
    u32x4 kv = *(const u32x4*)(Kg + (size_t)srow * 64 + sch * 8);
    u32x4 vv = *(const u32x4*)(Vg + (size_t)srow * nkeys + sch * 8);
    for (int kt = 0; kt < ntile; ++kt) {
        __syncthreads();
        *(LAS u32x4*)(ldsK + sdst) = kv;
        *(LAS u32x4*)(ldsV + sdst) = vv;
        __syncthreads();
        if (kt + 1 < ntile) {
            kv = *(const u32x4*)(Kg + (size_t)((kt + 1) * 64 + srow) * 64 + sch * 8);
            vv = *(const u32x4*)(Vg + (size_t)srow * nkeys + (kt + 1) * 64 + sch * 8);
        }
        f32x4 sacc[4];
#pragma unroll
        for (int f = 0; f < 4; ++f) {
            sacc[f] = (f32x4){0.f, 0.f, 0.f, 0.f};
#pragma unroll
            for (int s = 0; s < 2; ++s) {
                const h16x8 kf = *(const LAS h16x8*)(ldsK + (f * 16 + fr) * 128 + (((s * 4 + fq) ^ (fr & 7)) << 4));
                sacc[f] = __builtin_amdgcn_mfma_f32_16x16x32_f16(kf, qf[s], sacc[f], 0, 0, 0);
            }
        }
        float mx = -1e30f;
#pragma unroll
        for (int f = 0; f < 4; ++f)
#pragma unroll
            for (int r = 0; r < 4; ++r) mx = fmaxf(mx, sacc[f][r]);
        mx = fmaxf(mx, __shfl_xor(mx, 16)); mx = fmaxf(mx, __shfl_xor(mx, 32));
        const float mn = fmaxf(m, mx);
        const float alpha = __expf(m - mn);
        m = mn;
        float ps = 0.f;
#pragma unroll
        for (int f = 0; f < 4; ++f)
#pragma unroll
            for (int r = 0; r < 4; ++r) { const float e = __expf(sacc[f][r] - mn); sacc[f][r] = e; ps += e; }
        l = l * alpha + ps;
#pragma unroll
        for (int f = 0; f < 4; ++f) O[f] *= alpha;
#pragma unroll
        for (int s2 = 0; s2 < 2; ++s2) {
            h16x8 pf;
#pragma unroll
            for (int r = 0; r < 4; ++r) { pf[r] = (h16)sacc[2 * s2][r]; pf[4 + r] = (h16)sacc[2 * s2 + 1][r]; }
#pragma unroll
            for (int fd = 0; fd < 4; ++fd) {
                const int d = fd * 16 + fr;
                const h16x4 lo = *(const LAS h16x4*)(ldsV + d * 128 + (((4 * s2 + (fq >> 1)) ^ (d & 7)) << 4) + (fq & 1) * 8);
                const h16x4 hi = *(const LAS h16x4*)(ldsV + d * 128 + (((4 * s2 + 2 + (fq >> 1)) ^ (d & 7)) << 4) + (fq & 1) * 8);
                h16x8 vf; vf[0] = lo[0]; vf[1] = lo[1]; vf[2] = lo[2]; vf[3] = lo[3]; vf[4] = hi[0]; vf[5] = hi[1]; vf[6] = hi[2]; vf[7] = hi[3];
                O[fd] = __builtin_amdgcn_mfma_f32_16x16x32_f16(vf, pf, O[fd], 0, 0, 0);
            }
        }
    }
    l += __shfl_xor(l, 16); l += __shfl_xor(l, 32);
    const float inv = 1.f / l;
    h16* cat = (h16*)(p.ws + WS_CAT);
#pragma unroll
    for (int fd = 0; fd < 4; ++fd)
        *(h16x4*)(cat + (size_t)(row0 + fr) * D + head * 64 + fd * 16 + 4 * fq) = cvt4(O[fd] * inv);
    __syncthreads();
}

__device__ __forceinline__ void ssd_unit(const Params& p, const Ctx& c, bool lat, int b, int h, int dir) {
    const int lane = c.lane, wave = c.wave, tid = c.tid;
    const int fr = lane & 15, fq = lane >> 4;
    const int T = lat ? 1024 : 256, rowbase = lat ? NCTX + b * 1024 : b * 256, grp = h >> 2;
    const float* xbc = (const float*)(p.ws + WS_XBC);
    const float* dtv = (const float*)(p.ws + WS_DT);
    float* ssdy = (float*)(p.ws + WS_SSDY) + (size_t)dir * NTOK * 512;
    const float Aneg = -__expf(p.in[I_ALOG][dir * 8 + h]);
    LAS unsigned char* Bn = c.lds; LAS unsigned char* Cn = c.lds + 16384; LAS unsigned char* xdtT = c.lds + 32768; LAS unsigned char* BdT = c.lds + 49152;
    LAS unsigned char* himg = c.lds + 65536; LAS float* acs = (LAS float*)(c.lds + 73728); LAS float* dtl = (LAS float*)(c.lds + 74240);
    const int fn = wave & 3, fp0 = 2 * (wave >> 2);
    f32x4 hst[2];
    const size_t sbase = (size_t)(b * 8 + h) * 4096;
#pragma unroll
    for (int e = 0; e < 2; ++e) {
        const int pp = 16 * (fp0 + e) + fr, n0 = 16 * fn + 4 * fq;
        hst[e] = lat ? *(const f32x4*)((dir ? p.in[I_SSDB] : p.in[I_SSDF]) + sbase + pp * 64 + n0) : (f32x4){0.f, 0.f, 0.f, 0.f};
    }
    __syncthreads();
#pragma unroll
    for (int e = 0; e < 2; ++e) {
        const int pp = 16 * (fp0 + e) + fr;
        *(LAS h16x4*)(himg + pp * 128 + (((2 * fn + (fq >> 1)) ^ (pp & 7)) << 4) + (fq & 1) * 8) = cvt4(hst[e]);
    }
    const int nchunk = T / 128;
    f32x4 pB[4], pC[4], pX[4]; float pd0 = 0.f, pd1 = 0.f;
    const int prow = tid >> 2, pq4 = tid & 3, pch = tid & 63, plb = tid >> 6;
    LAS unsigned char* Xn = c.lds + 75776;
#define SSD_PREFETCH(ck_) do { const int r0_ = dir ? rowbase + T - 1 - (ck_) * 128 : rowbase + (ck_) * 128, sg_ = dir ? -1 : 1; \
        const float* g_ = xbc + (size_t)(r0_ + sg_ * prow) * 768 + 16 * pq4; \
        _Pragma("unroll") for (int e_ = 0; e_ < 4; ++e_) { pB[e_] = *(const f32x4*)(g_ + 512 + grp * 64 + 4 * e_); pC[e_] = *(const f32x4*)(g_ + 640 + grp * 64 + 4 * e_); pX[e_] = *(const f32x4*)(g_ + h * 64 + 4 * e_); } \
        if (wave == 0) { pd0 = dtv[(r0_ + sg_ * (2 * lane)) * 16 + dir * 8 + h]; pd1 = dtv[(r0_ + sg_ * (2 * lane + 1)) * 16 + dir * 8 + h]; } } while (0)
    SSD_PREFETCH(0);
    for (int ck = 0; ck < nchunk; ++ck) {
        const int r0 = dir ? rowbase + T - 1 - ck * 128 : rowbase + ck * 128, sg = dir ? -1 : 1;
        if (wave == 0) {
            const float d0 = pd0, d1 = pd1;
            const float a0 = d0 * Aneg, a1 = d1 * Aneg;
            float s = a0 + a1;
#pragma unroll
            for (int o = 1; o < 64; o <<= 1) { const float t = __shfl_up(s, o); if (lane >= o) s += t; }
            const float ex = s - (a0 + a1);
            acs[2 * lane] = ex + a0; acs[2 * lane + 1] = ex + a0 + a1; dtl[2 * lane] = d0; dtl[2 * lane + 1] = d1;
        }
        {
            const int o0_ = prow * 128 + (((2 * pq4) ^ (prow & 7)) << 4), o1_ = prow * 128 + (((2 * pq4 + 1) ^ (prow & 7)) << 4);
            h16x8 o0, o1;
#pragma unroll
            for (int e = 0; e < 4; ++e) { o0[e] = (h16)pB[0][e]; o0[4 + e] = (h16)pB[1][e]; o1[e] = (h16)pB[2][e]; o1[4 + e] = (h16)pB[3][e]; }
            *(LAS h16x8*)(Bn + o0_) = o0; *(LAS h16x8*)(Bn + o1_) = o1;
#pragma unroll
            for (int e = 0; e < 4; ++e) { o0[e] = (h16)pC[0][e]; o0[4 + e] = (h16)pC[1][e]; o1[e] = (h16)pC[2][e]; o1[4 + e] = (h16)pC[3][e]; }
            *(LAS h16x8*)(Cn + o0_) = o0; *(LAS h16x8*)(Cn + o1_) = o1;
#pragma unroll
            for (int e = 0; e < 4; ++e) { o0[e] = (h16)pX[0][e]; o0[4 + e] = (h16)pX[1][e]; o1[e] = (h16)pX[2][e]; o1[4 + e] = (h16)pX[3][e]; }
            *(LAS h16x8*)(Xn + o0_) = o0; *(LAS h16x8*)(Xn + o1_) = o1;
        }
        __syncthreads();
        {
            const float aend = acs[127];
#pragma unroll 1
            for (int j = 0; j < 2; ++j) {
                const int l0 = 8 * plb + 64 * j;
                h16x8 ox, ob;
#pragma unroll
                for (int e = 0; e < 8; ++e) {
                    const int l = l0 + e, ad = l * 128 + (((pch >> 3) ^ (l & 7)) << 4) + (pch & 7) * 2;
                    ox[e] = (h16)((float)*(const LAS h16*)(Xn + ad) * dtl[l]);
                    ob[e] = (h16)((float)*(const LAS h16*)(Bn + ad) * __expf(aend - acs[l]));
                }
                const int off = pch * 256 + (((l0 >> 3) ^ (pch & 15)) << 4);
                *(LAS h16x8*)(xdtT + off) = ox; *(LAS h16x8*)(BdT + off) = ob;
            }
        }
        if (ck + 1 < nchunk) SSD_PREFETCH(ck + 1);
        __syncthreads();
        const int l = 16 * wave + fr;
        const float al = acs[l];
        f32x4 accy[4];
#pragma unroll
        for (int fd = 0; fd < 4; ++fd) accy[fd] = (f32x4){0.f, 0.f, 0.f, 0.f};
        h16x8 cf[2];
#pragma unroll
        for (int s2 = 0; s2 < 2; ++s2) cf[s2] = *(const LAS h16x8*)(Cn + l * 128 + (((4 * s2 + fq) ^ (l & 7)) << 4));
#pragma unroll
        for (int fd = 0; fd < 4; ++fd) {
            const int pp = 16 * fd + fr;
#pragma unroll
            for (int s2 = 0; s2 < 2; ++s2) {
                const h16x8 hf = *(const LAS h16x8*)(himg + pp * 128 + (((4 * s2 + fq) ^ (pp & 7)) << 4));
                accy[fd] = __builtin_amdgcn_mfma_f32_16x16x32_f16(hf, cf[s2], accy[fd], 0, 0, 0);
            }
        }
        {
            const float el = __expf(al);
#pragma unroll
            for (int fd = 0; fd < 4; ++fd) accy[fd] *= el;
        }
        for (int q = 0; 2 * q <= wave; ++q) {
            h16x8 pf;
#pragma unroll
            for (int e = 0; e < 2; ++e) {
                const int f = 2 * q + e;
                f32x4 sa = {0.f, 0.f, 0.f, 0.f};
                if (f <= wave) {
                    const int s = 16 * f + fr;
#pragma unroll
                    for (int s2 = 0; s2 < 2; ++s2) {
                        const h16x8 bf = *(const LAS h16x8*)(Bn + s * 128 + (((4 * s2 + fq) ^ (s & 7)) << 4));
                        sa = __builtin_amdgcn_mfma_f32_16x16x32_f16(bf, cf[s2], sa, 0, 0, 0);
                    }
                    const f32x4 as = *(const LAS f32x4*)(acs + 16 * f + 4 * fq);
#pragma unroll
                    for (int r = 0; r < 4; ++r) { const int ss = 16 * f + 4 * fq + r; sa[r] = (ss <= l) ? sa[r] * __expf(al - as[r]) : 0.f; }
                }
#pragma unroll
                for (int r = 0; r < 4; ++r) pf[4 * e + r] = (h16)sa[r];
            }
#pragma unroll
            for (int fd = 0; fd < 4; ++fd) {
                const int pp = 16 * fd + fr;
                const h16x4 lo = *(const LAS h16x4*)(xdtT + pp * 256 + (((4 * q + (fq >> 1)) ^ (pp & 15)) << 4) + (fq & 1) * 8);
                const h16x4 hi = *(const LAS h16x4*)(xdtT + pp * 256 + (((4 * q + 2 + (fq >> 1)) ^ (pp & 15)) << 4) + (fq & 1) * 8);
                h16x8 xf; xf[0] = lo[0]; xf[1] = lo[1]; xf[2] = lo[2]; xf[3] = lo[3]; xf[4] = hi[0]; xf[5] = hi[1]; xf[6] = hi[2]; xf[7] = hi[3];
                accy[fd] = __builtin_amdgcn_mfma_f32_16x16x32_f16(xf, pf, accy[fd], 0, 0, 0);
            }
        }
        {
            float* yo = ssdy + (size_t)(r0 + sg * l) * 512 + h * 64 + 4 * fq;
#pragma unroll
            for (int fd = 0; fd < 4; ++fd) *(f32x4*)(yo + 16 * fd) = accy[fd];
        }
        {
            const float cd = __expf(acs[127]);
            const int nn = 16 * fn + fr;
#pragma unroll
            for (int e = 0; e < 2; ++e) {
                const int pp = 16 * (fp0 + e) + fr;
                f32x4 st = {0.f, 0.f, 0.f, 0.f};
#pragma unroll
                for (int ks = 0; ks < 4; ++ks) {
                    const h16x8 bf = *(const LAS h16x8*)(BdT + nn * 256 + (((4 * ks + fq) ^ (nn & 15)) << 4));
                    const h16x8 xf = *(const LAS h16x8*)(xdtT + pp * 256 + (((4 * ks + fq) ^ (pp & 15)) << 4));
                    st = __builtin_amdgcn_mfma_f32_16x16x32_f16(bf, xf, st, 0, 0, 0);
                }
                hst[e] = hst[e] * cd + st;
            }
        }
        __syncthreads();
#pragma unroll
        for (int e = 0; e < 2; ++e) {
            const int pp = 16 * (fp0 + e) + fr;
            *(LAS h16x4*)(himg + pp * 128 + (((2 * fn + (fq >> 1)) ^ (pp & 7)) << 4) + (fq & 1) * 8) = cvt4(hst[e]);
        }
    }
#undef SSD_PREFETCH
    if (!lat) {
#pragma unroll
        for (int e = 0; e < 2; ++e) {
            const int pp = 16 * (fp0 + e) + fr, n0 = 16 * fn + 4 * fq;
            *(f32x4*)(p.out + (dir ? O_SSDB : O_SSDF) + sbase + pp * 64 + n0) = hst[e];
        }
    }
    __syncthreads();
}
__device__ __forceinline__ int next_unit(const Params& p, const Ctx& c, int q) {
    volatile LAS int* slot = (volatile LAS int*)(c.lds + LDS_MISC + 64);
    __syncthreads();
    if (c.tid == 0) *slot = (int)atomicAdd((unsigned*)(p.ws + WS_CTL) + 4096 + 64 * q, 1u);
    __syncthreads();
    return *slot;
}
__device__ __forceinline__ void phase_mix0(const Params& p, const Ctx& c, int q) {
    for (int u = next_unit(p, c, q); u < 672 + N_CONV_UNITS; u = next_unit(p, c, q)) {
        if (u >= 672) { if (q == 0) conv_unit(p, c, u - 672); continue; }
        if (u < 32) ssd_unit(p, c, true, u >> 4, (u >> 1) & 7, u & 1);
        else if (u < 160) { const int v = u - 32; attn_unit(p, c, true, v >> 6, (v >> 5) & 1, v & 31); }
        else if (u < 416) { const int v = u - 160; ssd_unit(p, c, false, v >> 4, (v >> 1) & 7, v & 1); }
        else { const int v = u - 416; attn_unit(p, c, false, v >> 4, (v >> 3) & 1, v & 7); }
    }
}

constexpr int RW_SLOT = 12544, RW_NS = 5, RW_PF = 4;
template <int ABL>
__device__ __forceinline__ void rwkv_unit(const Params& p, const Ctx& c, bool lat, int b, int h, int dirsel) {
    const int lane = c.lane, wave = c.wave;
    const int dir = dirsel >= 0 ? dirsel : (wave >> 2), q = wave & 3, fr = lane & 15, g = lane >> 4;
    const int T = lat ? 1024 : 256, rowbase = lat ? NCTX + b * 1024 : b * 256, nchunk = T / 16;
    if (dirsel >= 0 && wave >= 4) {
        __syncthreads();
        for (int ck = 0; ck < nchunk; ++ck) { if (ABL != 2) __builtin_amdgcn_s_barrier(); }
        __syncthreads();
        return;
    }
    const unsigned char* kapg = p.ws + WS_DEC16 + (size_t)dir * NTOK * D * 2; const unsigned char* rhg = p.ws + WS_A16 + (size_t)dir * NTOK * D * 2;
    const unsigned char* vg = p.ws + WS_V16;
    h16* y16 = (h16*)(p.ws + WS_Y16) + (size_t)dir * NTOK * D;
    LAS unsigned char* ring = c.lds + dir * (RW_NS * RW_SLOT);
    f32x4 St[4];
    const size_t soff = ((size_t)(b * 16 + h) * 64 + 16 * q + fr) * 64 + 4 * g;
#pragma unroll
    for (int f = 0; f < 4; ++f) St[f] = lat ? *(const f32x4*)((dir ? p.in[I_RWB] : p.in[I_RWF]) + soff + 16 * f) : (f32x4){0.f, 0.f, 0.f, 0.f};
    const int e0 = q * 64 + lane;
    auto issue = [&](int ck) {
        const int rbg = (rowbase >> 4) + (dir ? nchunk - 1 - ck : ck), row0 = rbg * 16;
        LAS unsigned char* slot = ring + (ck % RW_NS) * RW_SLOT;
        const unsigned char* item = p.ws + WS_OPS2 + (size_t)((dir * 384 + rbg) * 16 + h) * OPS2_ITEM;
        {
            const int e = e0 & 127, t = e >> 3, pc = e & 7;
            const unsigned char* s_ = (e0 < 128 ? kapg : rhg) + ((size_t)(row0 + t) * D + h * 64) * 2 + pc * 16;
            __builtin_amdgcn_global_load_lds((const unsigned*)s_, (LAS unsigned*)(slot + q * 1024), 16, 0, 0);
        }
        __builtin_amdgcn_global_load_lds((const unsigned*)(item + e0 * 16), (LAS unsigned*)(slot + 4096 + q * 1024), 16, 0, 0);
        {
            const int e = e0;
            const unsigned char* s_;
            if (e < 144) s_ = item + 4096 + e * 16;
            else { const int ve = e - 144, t = ve >> 3, pc = ve & 7; s_ = vg + ((size_t)(row0 + (dir ? 15 - t : t)) * D + h * 64) * 2 + pc * 16; }
            __builtin_amdgcn_global_load_lds((const unsigned*)s_, (LAS unsigned*)(slot + 8192 + q * 1024), 16, 0, 0);
        }
        if (q == 0 && lane < 16) {
            const int ve = 112 + lane, t = ve >> 3, pc = ve & 7;
            const unsigned char* s_ = vg + ((size_t)(row0 + (dir ? 15 - t : t)) * D + h * 64) * 2 + pc * 16;
            __builtin_amdgcn_global_load_lds((const unsigned*)s_, (LAS unsigned*)(slot + 12288), 16, 0, 0);
        }
    };
    __syncthreads();
    if (ABL != 1 && ABL != 2) for (int ck = 0; ck < RW_PF && ck < nchunk; ++ck) issue(ck);
    for (int ck = 0; ck < nchunk; ++ck) {
        if (ck + RW_PF > nchunk) asm volatile("s_waitcnt vmcnt(0)" ::: "memory");
        else if (q == 0) asm volatile("s_waitcnt vmcnt(12)" ::: "memory");
        else asm volatile("s_waitcnt vmcnt(9)" ::: "memory");
        asm volatile("s_waitcnt lgkmcnt(0)" ::: "memory");
        if (ABL != 2) __builtin_amdgcn_s_barrier();
        asm volatile("" ::: "memory");
        if (ABL != 1 && ABL != 2) if (ck + RW_PF < nchunk) issue(ck + RW_PF);
        const LAS unsigned char* slot = ring + (ck % RW_NS) * RW_SLOT;
        const int rbg = (rowbase >> 4) + (dir ? nchunk - 1 - ck : ck), row0 = rbg * 16;
        h16x8 Sh[2];
#pragma unroll
        for (int s = 0; s < 2; ++s)
#pragma unroll
            for (int r = 0; r < 4; ++r) { Sh[s][r] = (h16)St[2 * s][r]; Sh[s][4 + r] = (h16)St[2 * s + 1][r]; }
        const h16x8 ka0 = *(const LAS h16x8*)(slot + (fr * 4 + g) * 32), ka1 = *(const LAS h16x8*)(slot + (fr * 4 + g) * 32 + 16);
        const h16x8 rh0 = *(const LAS h16x8*)(slot + 2048 + (fr * 4 + g) * 32), rh1 = *(const LAS h16x8*)(slot + 2048 + (fr * 4 + g) * 32 + 16);
        const h16x4 a1 = *(const LAS h16x4*)(slot + 8192 + (fr * 4 + g) * 8), t4 = *(const LAS h16x4*)(slot + 8704 + (fr * 4 + g) * 8);
        const h16x8 nn = *(const LAS h16x8*)(slot + 9216 + (fr * 4 + g) * 16);
        h16x8 vu, a1op, top;
#pragma unroll
        for (int jj = 0; jj < 4; ++jj) {
            vu[jj] = *(const LAS h16*)(slot + 10496 + (4 * g + jj) * 128 + (16 * q + fr) * 2);
            a1op[jj] = a1[jj]; a1op[4 + jj] = (h16)0.f; top[jj] = t4[jj]; top[4 + jj] = (h16)0.f; vu[4 + jj] = (h16)0.f;
        }
        f32x4 X = {0.f, 0.f, 0.f, 0.f};
        X = __builtin_amdgcn_mfma_f32_16x16x32_f16(ka0, Sh[0], X, 0, 0, 0);
        X = __builtin_amdgcn_mfma_f32_16x16x32_f16(ka1, Sh[1], X, 0, 0, 0);
        X = __builtin_amdgcn_mfma_f32_16x16x32_f16(a1op, vu, X, 0, 0, 0);
        h16x8 xo;
#pragma unroll
        for (int r = 0; r < 4; ++r) { xo[r] = (h16)X[r]; xo[4 + r] = (h16)0.f; }
        f32x4 U = {0.f, 0.f, 0.f, 0.f};
        U = __builtin_amdgcn_mfma_f32_16x16x32_f16(top, xo, U, 0, 0, 0);
#pragma unroll
        for (int r = 0; r < 4; ++r) vu[4 + r] = (h16)(-U[r]);
        f32x4 Y = {0.f, 0.f, 0.f, 0.f};
        Y = __builtin_amdgcn_mfma_f32_16x16x32_f16(rh0, Sh[0], Y, 0, 0, 0);
        Y = __builtin_amdgcn_mfma_f32_16x16x32_f16(rh1, Sh[1], Y, 0, 0, 0);
        Y = __builtin_amdgcn_mfma_f32_16x16x32_f16(nn, vu, Y, 0, 0, 0);
#pragma unroll
        for (int f = 0; f < 4; ++f) {
            const f32x4 gc = *(const LAS f32x4*)(slot + 10240 + (16 * f + 4 * g) * 4);
            const h16x8 kb = *(const LAS h16x8*)(slot + 4096 + ((f * 16 + fr) * 4 + g) * 16);
            St[f] = __builtin_amdgcn_mfma_f32_16x16x32_f16(kb, vu, St[f] * gc, 0, 0, 0);
        }
#pragma unroll
        for (int r = 0; r < 4; ++r) if (ABL == 3) asm volatile("" :: "v"(Y[r])); else { const int t = 4 * g + r; y16[(size_t)(row0 + (dir ? 15 - t : t)) * D + h * 64 + 16 * q + fr] = (h16)Y[r]; }
    }
    if (!lat) {
#pragma unroll
        for (int f = 0; f < 4; ++f) *(f32x4*)(p.out + (dir ? O_RWB : O_RWF) + soff + 16 * f) = St[f];
    }
    asm volatile("s_waitcnt vmcnt(0) lgkmcnt(0)" ::: "memory");
    __syncthreads();
}
template <int ABL>
__device__ __forceinline__ void phase_rwkvscan(const Params& p, const Ctx& c, int qn) {
    for (int u = next_unit(p, c, qn); u < 320; u = next_unit(p, c, qn)) {
        if (u < 64) rwkv_unit<ABL>(p, c, true, u >> 5, (u >> 1) & 15, u & 1);
        else { const int v = u - 64; rwkv_unit<ABL>(p, c, false, v >> 4, v & 15, -1); }
    }
}

__device__ __forceinline__ const float* ada_chunk(const Params& p, int layer, int row, int chunk) {
    return (const float*)(p.ws + WS_ADA) + (size_t)(layer * 3 + stream_of(row)) * 6144 + chunk * 1024;
}
__device__ __forceinline__ void phase_gemm_inproj(const Params& p, const Ctx& c) {
    float* proj = (float*)(p.ws + WS_PROJ);
    const float* rc = (const float*)(p.ws + WS_ROPE); const float* rs = rc + 32768;
    const int fr = c.lane & 15, fq = c.lane >> 4, wm = c.wave >> 1, wn = c.wave & 1;
    for (int u = c.bid; u < 24 * 17; u += c.G) {
        const int pm = u % 24, pn = u / 24;
        GemmTile g{(const h16*)(p.ws + WS_HA), D, (const h16*)(p.ws + WS_WIN), D, D, pm * 256, pn * 128};
        f32x4 acc[4][4]; gemm_tile<256>(c, g, acc);
        if (pn >= 6) {
#pragma unroll
            for (int i = 0; i < 4; ++i)
#pragma unroll
                for (int j = 0; j < 4; ++j)
                    *(f32x4*)(proj + (size_t)(g.m0 + wm * 64 + 16 * i + fr) * PROJ_LD + g.n0 + wn * 64 + 16 * j + 4 * fq) = acc[i][j];
            continue;
        }
#pragma unroll
        for (int i = 0; i < 4; ++i) {
            const int row = g.m0 + wm * 64 + 16 * i + fr;
            const bool lat = row >= NCTX;
            const int r2 = lat ? row - NCTX : row;
            const int b = lat ? (r2 >> 10) : (r2 >> 8), t = lat ? (r2 & 1023) : (r2 & 255);
            if (pn < 5) {
                float ss = 0.f;
#pragma unroll
                for (int j = 0; j < 4; ++j) ss += acc[i][j][0] * acc[i][j][0] + acc[i][j][1] * acc[i][j][1] + acc[i][j][2] * acc[i][j][2] + acc[i][j][3] * acc[i][j][3];
                ss = rowsum4(ss);
                const float rstd = rsqrtf(ss * (1.f / 64.f) + 1e-6f);
                const float* gw_ = (pn < 4) ? p.in[I_QG] : p.in[I_KG];
                f32x4 xn[4];
#pragma unroll
                for (int j = 0; j < 4; ++j) xn[j] = acc[i][j] * rstd * *(const f32x4*)(gw_ + 16 * j + 4 * fq);
                if (lat) {
#pragma unroll
                    for (int j = 0; j < 2; ++j) {
                        const f32x4 cs = *(const f32x4*)(rc + t * 32 + 16 * j + 4 * fq), sn = *(const f32x4*)(rs + t * 32 + 16 * j + 4 * fq);
                        const f32x4 x1 = xn[j], x2 = xn[j + 2];
                        xn[j] = x1 * cs - x2 * sn; xn[j + 2] = x1 * sn + x2 * cs;
                    }
                }
                if (pn < 4) {
                    h16* q16 = (h16*)(p.ws + WS_Q16) + (size_t)row * 512 + (2 * pn + wn) * 64 + 4 * fq;
#pragma unroll
                    for (int j = 0; j < 4; ++j) *(h16x4*)(q16 + 16 * j) = cvt4(xn[j] * 0.125f);
                } else {
                    h16* kd = lat ? (h16*)(p.ws + WS_K16L) + ((size_t)(b * 2 + wn) * 1280 + 256 + t) * 64 + 4 * fq
                                  : (h16*)(p.ws + WS_K16C) + ((size_t)(b * 2 + wn) * 256 + t) * 64 + 4 * fq;
#pragma unroll
                    for (int j = 0; j < 4; ++j) {
                        *(h16x4*)(kd + 16 * j) = cvt4(xn[j]);
                        if (!lat) *(f32x4*)(p.out + O_K + (size_t)row * 128 + wn * 64 + 16 * j + 4 * fq) = xn[j];
                    }
                }
            } else {
                h16* vt = lat ? (h16*)(p.ws + WS_VT16L) + (size_t)(b * 2 + wn) * 64 * 1280 + 256 + t
                              : (h16*)(p.ws + WS_VT16C) + (size_t)(b * 2 + wn) * 64 * 256 + t;
                const int ld = lat ? 1280 : 256;
#pragma unroll
                for (int j = 0; j < 4; ++j) {
#pragma unroll
                    for (int r = 0; r < 4; ++r) vt[(size_t)(16 * j + 4 * fq + r) * ld] = (h16)acc[i][j][r];
                    if (!lat) *(f32x4*)(p.out + O_V + (size_t)row * 128 + wn * 64 + 16 * j + 4 * fq) = acc[i][j];
                }
            }
        }
    }
}
__device__ __forceinline__ void phase_gemm_res(const Params& p, const Ctx& c, const h16* A, int lda, const h16* Bt, int K, int layer, int gate_chunk, bool init, bool dry, bool ffn_pre) {
    float* X = (float*)(p.ws + WS_X);
    float* Xw = dry ? (float*)(p.ws + WS_PROJ) : X;
    const int fr = c.lane & 15, fq = c.lane >> 4, wm = c.wave >> 1, wn = c.wave & 1;
    for (int u = c.bid; u < 32 * 8; u += c.G) {
        const int pm = u & 31, pn = u >> 5;
        GemmTile g{A, lda, Bt, K, K, pm * 192, pn * 128};
        f32x4 acc[3][4]; gemm_tile<192>(c, g, acc);
#pragma unroll
        for (int i = 0; i < 3; ++i) {
            const int row = g.m0 + wm * 48 + 16 * i + fr;
            const float* gt = ada_chunk(p, layer, row, gate_chunk);
            const float* base = init ? xin_row(p, row) : X + (size_t)row * D;
            float ss = 0.f;
            const float* scp = ada_chunk(p, layer, row, 4);
#pragma unroll
            for (int j = 0; j < 4; ++j) {
                const int col = g.n0 + wn * 64 + 16 * j + 4 * fq;
                const f32x4 xn = *(const f32x4*)(base + col) + *(const f32x4*)(gt + col) * acc[i][j];
                *(f32x4*)(Xw + (size_t)row * D + col) = xn;
                if (ffn_pre) {
                    ss += xn[0] * xn[0] + xn[1] * xn[1] + xn[2] * xn[2] + xn[3] * xn[3];
                    const f32x4 pre = xn * *(const f32x4*)(p.in[I_NFG] + layer * 1024 + col) * (*(const f32x4*)(scp + col) + 1.f);
                    *(h16x4*)((h16*)(p.ws + (layer ? WS_XMIX : WS_HA)) + (size_t)row * D + col) = cvt4(pre);
                }
            }
            if (ffn_pre) { ss = rowsum4(ss); if (fq == 0 && !dry) atomicAdd((float*)(p.ws + WS_ROWSS) + layer * NTOK + row, ss); }
        }
    }
}
__device__ __forceinline__ void phase_gemm_gu(const Params& p, const Ctx& c, int layer) {
    h16* hid = (h16*)(p.ws + WS_HID);
    const int fr = c.lane & 15, fq = c.lane >> 4, wm = c.wave >> 1, wn = c.wave & 1;
    for (int u = c.bid; u < 32 * 22; u += c.G) {
        const int pm = u & 31, pn = u >> 5;
        GemmTile g{(const h16*)(p.ws + (layer ? WS_XMIX : WS_HA)), D, (const h16*)(p.ws + WS_WGU) + (size_t)layer * 5632 * 1024, D, D, pm * 192, pn * 256};
        f32x4 acc[3][8]; gemm_tile_wide(c, g, acc);
#pragma unroll
        for (int i = 0; i < 3; ++i) {
            const int row = g.m0 + wm * 48 + 16 * i + fr;
            const float rstd = rsqrtf(((const float*)(p.ws + WS_ROWSS))[layer * NTOK + row] * (1.f / 1024.f) + 1e-6f);
#pragma unroll
            for (int cc = 0; cc < 2; ++cc) {
                const int nb0 = g.n0 + wn * 128 + 64 * cc + 4 * fq, hc0 = (g.n0 + wn * 128 + 64 * cc) / 2 + 4 * fq;
                const float* fb = (const float*)(p.ws + WS_FBIAS) + (size_t)(layer * 3 + stream_of(row)) * 5632 + nb0;
#pragma unroll
                for (int j = 0; j < 2; ++j) {
                    const f32x4 bg = *(const f32x4*)(fb + 16 * j), bu = *(const f32x4*)(fb + 16 * (j + 2));
                    f32x4 o;
#pragma unroll
                    for (int r = 0; r < 4; ++r) o[r] = silu_f(acc[i][4 * cc + j][r] * rstd + bg[r]) * (acc[i][4 * cc + j + 2][r] * rstd + bu[r]);
                    *(h16x4*)(hid + (size_t)row * FF + hc0 + 16 * j) = cvt4(o);
                }
            }
        }
    }
}
__device__ __forceinline__ void phase_gemm_rkv(const Params& p, const Ctx& c) {
    h16* lora = (h16*)(p.ws + WS_LORA16);
    const h16* xm = (const h16*)(p.ws + WS_XMIX);
    const int fr = c.lane & 15, fq = c.lane >> 4, wm = c.wave >> 1, wn = c.wave & 1;
    for (int u = c.bid; u < 24 * 27; u += c.G) {
        const int pm = u % 24, pn = u / 24;
        const int ai = pn < 8 ? 0 : pn < 16 ? 2 : pn < 24 ? 3 : pn == 24 ? 1 : pn == 25 ? 4 : 5;
        GemmTile g{xm + (size_t)ai * NTOK * D, D, (const h16*)(p.ws + WS_WRKV), D, D, pm * 256, pn * 128};
        f32x4 acc[4][4]; gemm_tile<256>(c, g, acc);
#pragma unroll
        for (int i = 0; i < 4; ++i) {
            const int row = g.m0 + wm * 64 + 16 * i + fr;
#pragma unroll
            for (int j = 0; j < 4; ++j) {
                const int col = g.n0 + wn * 64 + 16 * j + 4 * fq;
                f32x4 v = acc[i][j];
                if (pn < 24) *(h16x4*)((h16*)(p.ws + (pn < 8 ? WS_R16 : pn < 16 ? WS_K16 : WS_V16)) + (size_t)row * D + (col & 1023)) = cvt4(v);
                else {
                    if (pn == 24) { for (int r = 0; r < 4; ++r) v[r] = 2.f * sigmoid_f(2.f * v[r]) - 1.f; }
                    else if (pn == 26) { for (int r = 0; r < 4; ++r) v[r] = sigmoid_f(v[r]); }
                    *(h16x4*)(lora + (size_t)row * 384 + col - 3072) = cvt4(v);
                }
            }
        }
    }
}
__device__ __forceinline__ void phase_gemm_lora2(const Params& p, const Ctx& c) {
    const h16* lora = (const h16*)(p.ws + WS_LORA16);
    h16* dec16 = (h16*)(p.ws + WS_DEC16); h16* a16 = (h16*)(p.ws + WS_A16); h16* g16 = (h16*)(p.ws + WS_G16);
    const int fr = c.lane & 15, fq = c.lane >> 4, wm = c.wave >> 1, wn = c.wave & 1;
    for (int u = c.bid; u < 24 * 40; u += c.G) {
        const int pm = u % 24, pn = u / 24, gq = pn >> 3, n0 = (pn & 7) * 128;
        const int K = gq < 4 ? 64 : 128;
        const h16* A = lora + (gq < 2 ? 64 * gq : gq < 4 ? 128 + 64 * (gq - 2) : 256);
        const h16* Bt = gq < 2 ? (const h16*)(p.ws + WS_W2T) + (size_t)gq * 65536 : gq < 4 ? (const h16*)(p.ws + WS_A2T) + (size_t)(gq - 2) * 65536 : (const h16*)(p.ws + WS_G2T);
        GemmTile g{A, 384, Bt, K, K, pm * 256, n0};
        f32x4 acc[4][4]; gemm_tile<256>(c, g, acc);
#pragma unroll
        for (int i = 0; i < 4; ++i) {
            const int row = g.m0 + wm * 64 + 16 * i + fr;
#pragma unroll
            for (int j = 0; j < 4; ++j) {
                const int col = n0 + wn * 64 + 16 * j + 4 * fq;
                f32x4 v = acc[i][j];
                if (gq < 2) {
                    const f32x4 w0 = *(const f32x4*)(p.in[I_W0] + gq * 1024 + col);
                    for (int r = 0; r < 4; ++r) { const float wl = w0[r] + v[r]; const float uu = 0.60653066f * sigmoid_f(wl); v[r] = 1.f - __expf(-uu); }
                    *(h16x4*)(dec16 + ((size_t)gq * NTOK + row) * D + col) = cvt4(v);
                } else if (gq < 4) {
                    const f32x4 a0 = *(const f32x4*)(p.in[I_A0] + (gq - 2) * 1024 + col);
                    for (int r = 0; r < 4; ++r) v[r] = sigmoid_f(a0[r] + v[r]);
                    *(h16x4*)(a16 + ((size_t)(gq - 2) * NTOK + row) * D + col) = cvt4(v);
                } else *(h16x4*)(g16 + (size_t)row * D + col) = cvt4(v);
            }
        }
    }
}

#ifdef ONLY_PHASE
#define PH_ON(k) ((k) == ONLY_PHASE)
#else
#define PH_ON(k) true
#endif
#ifndef ABL_MODE
#define ABL_MODE 0
#endif
#ifndef REP_MASK
#define REP_MASK 0u
#endif
#define NREP(k) (((REP_MASK >> (k)) & 1u) ? 2 : 1)
#define PHASE(k, call) do { if (PH_ON(k) && lo <= (k) && (k) < hi) { _Pragma("unroll") for (int rep = NREP(k) - 1; rep >= 0; --rep) { const bool dry = rep > 0; (void)dry; call; if ((k) + 1 < hi || dry) xcd_barrier(bar); } } } while (0)

__global__ void __launch_bounds__(NTHREADS, 2) mk_fwd(Params p) {
    extern __shared__ __attribute__((aligned(16))) unsigned char lds_raw[];
    Ctx c;
    c.lds = (LAS unsigned char*)lds_raw;
    c.tid = threadIdx.x; c.lane = c.tid & 63; c.wave = __builtin_amdgcn_readfirstlane(c.tid >> 6);
    c.bid = blockIdx.x; c.G = gridDim.x;
    volatile LAS unsigned* misc = (volatile LAS unsigned*)(c.lds + LDS_MISC);
    if (c.tid < 64) misc[c.tid] = 0u;
    __syncthreads();
    const int lo = p.ph_lo, hi = p.ph_hi;
    XcdBarrier bar; bar.bar = (unsigned*)(p.ws + WS_CTL); bar.x = 0; bar.st = nullptr;
    if (hi - lo > 1) bar = xcd_barrier_post((unsigned*)(p.ws + WS_CTL), misc + 8);
    PHASE(0, phase0(p, c));
    PHASE(1, phase_normmod(p, c, true, p.in[I_NMG], 0, 0, 1));
    PHASE(2, phase_gemm_inproj(p, c));
    PHASE(3, phase_postproj(p, c));
    PHASE(4, phase_mix0(p, c, dry ? 2 : 0));
    PHASE(5, phase_ssdcombine(p, c));
    PHASE(6, phase_gemm_res(p, c, (const h16*)(p.ws + WS_CAT), D, (const h16*)(p.ws + WS_WOUT), D, 0, 2, true, dry, true));
    PHASE(8, phase_gemm_gu(p, c, 0));
    PHASE(9, phase_gemm_res(p, c, (const h16*)(p.ws + WS_HID), FF, (const h16*)(p.ws + WS_WDN), FF, 0, 5, false, dry, false));
    PHASE(10, phase_rwkvmix(p, c));
    PHASE(11, phase_gemm_rkv(p, c));
    PHASE(12, phase_gemm_lora2(p, c));
    PHASE(13, phase_rwkvprep(p, c, dry));
    PHASE(14, if (dry) phase_rwkvscan<ABL_MODE>(p, c, 3); else phase_rwkvscan<0>(p, c, 1));
    PHASE(15, phase_rwkvpost(p, c));
    PHASE(16, phase_gemm_res(p, c, (const h16*)(p.ws + WS_HA), D, (const h16*)(p.ws + WS_WO), D, 1, 2, false, dry, true));
    PHASE(18, phase_gemm_gu(p, c, 1));
    PHASE(19, phase_gemm_res(p, c, (const h16*)(p.ws + WS_HID), FF, (const h16*)(p.ws + WS_WDN) + (size_t)1024 * 2816, FF, 1, 5, false, dry, false));
    PHASE(20, phase_final(p, c));
}

extern "C" void kernel_launch(void* const* d_in, const int* in_sizes, int n_in, void* d_out, int out_size, void* d_ws, size_t ws_size, hipStream_t stream) {
    static int grid = 0;
    if (grid == 0) {
        if (n_in != 46 || ws_size < WS_END) { fprintf(stderr, "kernel_launch: unexpected n_in %d or ws_size %zu\n", n_in, ws_size); grid = -1; return; }
        int dev = 0, cus = 0, per_cu = 0;
        (void)hipGetDevice(&dev);
        (void)hipDeviceGetAttribute(&cus, hipDeviceAttributeMultiprocessorCount, dev);
        if (hipFuncSetAttribute((const void*)mk_fwd, hipFuncAttributeMaxDynamicSharedMemorySize, LDS_BYTES) != hipSuccess) { fprintf(stderr, "kernel_launch: hipFuncSetAttribute failed\n"); grid = -1; return; }
        if (hipOccupancyMaxActiveBlocksPerMultiprocessor(&per_cu, (const void*)mk_fwd, NTHREADS, LDS_BYTES) != hipSuccess || per_cu < 1) { fprintf(stderr, "kernel_launch: occupancy query says %d\n", per_cu); }
        (void)hipGetLastError();
        grid = cus;
    }
    if (grid < 0) return;
    (void)hipMemsetAsync((char*)d_ws + WS_CTL, 0, CTL_ZERO_BYTES, stream);
    Params p{};
    for (int i = 0; i < 46; ++i) p.in[i] = (const float*)d_in[i];
    p.out = (float*)d_out; p.ws = (unsigned char*)d_ws;
#if MK_N_LAUNCHES == 1
    p.ph_lo = 0; p.ph_hi = NPH;
    hipLaunchKernelGGL(mk_fwd, dim3(grid), dim3(NTHREADS), LDS_BYTES, stream, p);
#else
    for (int ph = 0; ph < NPH; ++ph) { p.ph_lo = ph; p.ph_hi = ph + 1; hipLaunchKernelGGL(mk_fwd, dim3(grid), dim3(NTHREADS), LDS_BYTES, stream, p); }
#endif
}
```
